# Optimizing an MI355X kernel written in HIP

```python
import math
import jax, jax.numpy as jnp
from jax import lax
import numpy as np

D_MODEL = 2048
BATCH = 4
SEQ = 2048
DEPTH = 1
DEC_BATCH = 16
DEC_SEQ = 16
PAST_LEN = 2048

CHUNK = 64
N_META = 16
PROMPT_PAD = (-N_META) % CHUNK
RW_HEAD = 64
RW_DIM = D_MODEL // 2
RW_HEADS = RW_DIM // RW_HEAD
RW_DECAY_LORA = 96
RW_AAA_LORA = 96
RW_GATE_LORA = 256
RW_SHIFT_COLS = 3 * RW_DIM + RW_DECAY_LORA + RW_AAA_LORA + RW_GATE_LORA
RW_SPLITS = (RW_DIM, 2 * RW_DIM, 3 * RW_DIM, 3 * RW_DIM + RW_DECAY_LORA, 3 * RW_DIM + RW_DECAY_LORA + RW_AAA_LORA)
RW_GN_EPS = 64e-5
SSM_HEAD = 64
SSM_DIM = D_MODEL
SSM_HEADS = SSM_DIM // SSM_HEAD
SSM_GROUPS = 4
SSM_HPG = SSM_HEADS // SSM_GROUPS
SSM_STATE = 128
CONV_W = 4
CONV_DIM = SSM_DIM + 2 * SSM_GROUPS * SSM_STATE
RMS_EPS = 1e-5
N_IN = RW_SHIFT_COLS + SSM_DIM + CONV_DIM + SSM_HEADS + 2 * D_MODEL
IN_SPLITS = (RW_SHIFT_COLS, RW_SHIFT_COLS + SSM_DIM, RW_SHIFT_COLS + SSM_DIM + CONV_DIM, RW_SHIFT_COLS + SSM_DIM + CONV_DIM + SSM_HEADS)
D_FF = 5632
LN_EPS = 1e-5
ALPHA = (2 * DEPTH) ** 0.25
BETA = (8 * DEPTH) ** -0.25

kernel_name = 'rwkv7_mamba2_gated_hybrid_stream_step'


def layer_norm(x, g, b):
    xf = x.astype(jnp.float32)
    mu = jnp.mean(xf, axis=-1, keepdims=True)
    var = jnp.mean(jnp.square(xf - mu), axis=-1, keepdims=True)
    return ((xf - mu) * lax.rsqrt(var + LN_EPS) * g + b).astype(x.dtype)


def swiglu(x, w_gu, w_dn):
    g, u = jnp.split(x @ w_gu, 2, axis=-1)
    return (jax.nn.silu(g) * u) @ w_dn


def token_shift(p, hist, mu):
    prev = jnp.concatenate([hist.astype(p.dtype), p[:, :-1]], axis=1)
    return p + (prev - p) * mu, p[:, -1:]


def causal_dwconv(u, hist, w, b):
    l = u.shape[1]
    full = jnp.concatenate([hist.astype(u.dtype), u], axis=1)
    out = b + sum(full[:, i:i + l] * w[i] for i in range(CONV_W))
    return out, full[:, l:]


def rwkv7_mix(p_rw, shift_hist, wkv0, rw_mu, rw_w0, rw_w2, rw_a0, rw_a2, rw_g2, rw_kk, rw_ka, rw_rk, rw_gn_w, rw_gn_b):
    f32 = jnp.float32
    ps, new_shift = token_shift(p_rw, shift_hist, rw_mu)
    r, k, v, wd, ad, gd = jnp.split(ps, RW_SPLITS, axis=-1)
    b, l = r.shape[:2]
    w_log = -jax.nn.softplus(-(rw_w0 + jnp.tanh(wd) @ rw_w2).astype(f32)) - 0.5
    decay = jnp.exp(-jnp.exp(w_log))
    a = jax.nn.sigmoid((rw_a0 + ad @ rw_a2).astype(f32))
    g = jax.nn.sigmoid(gd) @ rw_g2
    hd = lambda t: t.reshape(b, l, RW_HEADS, RW_HEAD).astype(f32)
    r, k, v, decay, a = hd(r), hd(k), hd(v), hd(decay), hd(a)
    kk = k * rw_kk
    kk = kk / jnp.maximum(jnp.linalg.norm(kk, axis=-1, keepdims=True), 1e-12)
    k = k * (1.0 + (a - 1.0) * rw_ka)

    def step(S, inp):
        r_t, w_t, k_t, v_t, kk_t, a_t = inp
        sa = jnp.einsum('bhvk,bhk->bhv', S, -kk_t)
        S = S * w_t[:, :, None, :] + sa[..., None] * (kk_t * a_t)[:, :, None, :] + v_t[..., None] * k_t[:, :, None, :]
        return S, jnp.einsum('bhvk,bhk->bhv', S, r_t)

    tm = lambda t: jnp.moveaxis(t, 1, 0)
    wkv_t, y = lax.scan(step, wkv0.astype(f32), (tm(r), tm(decay), tm(k), tm(v), tm(kk), tm(a)))
    y = jnp.moveaxis(y, 0, 1)
    mu = jnp.mean(y, axis=-1, keepdims=True)
    var = jnp.mean(jnp.square(y - mu), axis=-1, keepdims=True)
    yn = ((y - mu) * lax.rsqrt(var + RW_GN_EPS)).reshape(b, l, RW_DIM) * rw_gn_w + rw_gn_b
    bonus = (jnp.sum(r * k * rw_rk, axis=-1, keepdims=True) * v).reshape(b, l, RW_DIM)
    out = ((yn + bonus) * g).astype(p_rw.dtype)
    return out, new_shift, wkv_t.astype(wkv0.dtype)


def ssd_scan(x, dt, a, bm, cm, h0, chunk):
    b, l = x.shape[:2]
    nc = l // chunk
    x = x.reshape(b, nc, chunk, SSM_GROUPS, SSM_HPG, SSM_HEAD)
    dt = dt.reshape(b, nc, chunk, SSM_GROUPS, SSM_HPG)
    bm = bm.reshape(b, nc, chunk, SSM_GROUPS, SSM_STATE)
    cm = cm.reshape(b, nc, chunk, SSM_GROUPS, SSM_STATE)
    acs = jnp.cumsum(dt * a.reshape(SSM_GROUPS, SSM_HPG), axis=2)
    xdt = x * dt[..., None]
    causal = jnp.tril(jnp.ones((chunk, chunk), dtype=bool))[:, :, None, None]
    seg = acs[:, :, :, None] - acs[:, :, None, :]
    lmat = jnp.exp(jnp.where(causal, seg, -jnp.inf))
    cb = jnp.einsum('bcign,bcjgn->bcijg', cm, bm)
    y_diag = jnp.einsum('bcijgh,bcjghp->bcighp', cb[..., None] * lmat, xdt)
    to_end = jnp.exp(acs[:, :, -1:] - acs)
    states = jnp.einsum('bcjgn,bcjghp->bcghpn', bm, xdt * to_end[..., None])
    chunk_decay = jnp.exp(acs[:, :, -1])

    def carry(h, inp):
        st, dec = inp
        return h * dec[..., None, None] + st, h

    h0g = h0.reshape(b, SSM_GROUPS, SSM_HPG, SSM_HEAD, SSM_STATE)
    h_t, h_in = lax.scan(carry, h0g, (jnp.moveaxis(states, 1, 0), jnp.moveaxis(chunk_decay, 1, 0)))
    h_in = jnp.moveaxis(h_in, 0, 1)
    y_off = jnp.einsum('bcign,bcghpn->bcighp', cm, h_in) * jnp.exp(acs)[..., None]
    y = (y_diag + y_off).reshape(b, l, SSM_HEADS, SSM_HEAD)
    return y, h_t.reshape(b, SSM_HEADS, SSM_HEAD, SSM_STATE)


def mamba2_mix(p_z, p_xbc, p_dt, conv_hist, ssm0, pad, chunk, conv_w, conv_b, dt_bias, a_log, d_skip, ssm_norm_w):
    f32 = jnp.float32
    xbc, new_conv = causal_dwconv(p_xbc, conv_hist, conv_w, conv_b)
    xbc = jax.nn.silu(xbc)
    xs, bm, cm = jnp.split(xbc, (SSM_DIM, SSM_DIM + SSM_GROUPS * SSM_STATE), axis=-1)
    b, l = xs.shape[:2]
    dt = jax.nn.softplus((p_dt + dt_bias).astype(f32))
    a = -jnp.exp(a_log.astype(f32))
    xh = xs.reshape(b, l, SSM_HEADS, SSM_HEAD).astype(f32)
    bm = bm.reshape(b, l, SSM_GROUPS, SSM_STATE).astype(f32)
    cm = cm.reshape(b, l, SSM_GROUPS, SSM_STATE).astype(f32)
    padf = lambda t: jnp.pad(t, ((0, 0), (pad, 0)) + ((0, 0),) * (t.ndim - 2))
    y, ssm_t = ssd_scan(padf(xh), padf(dt), a, padf(bm), padf(cm), ssm0.astype(f32), chunk)
    y = y[:, pad:] + xh * d_skip[:, None]
    y = y.reshape(b, l, SSM_DIM) * jax.nn.silu(p_z.astype(f32))
    yg = y.reshape(b, l, SSM_GROUPS, SSM_DIM // SSM_GROUPS)
    yg = yg * lax.rsqrt(jnp.mean(jnp.square(yg), axis=-1, keepdims=True) + RMS_EPS)
    out = (yg.reshape(b, l, SSM_DIM) * ssm_norm_w).astype(p_z.dtype)
    return out, new_conv, ssm_t.astype(ssm0.dtype)


def trunk_layer(x, shift_hist, wkv0, conv_hist, ssm0, pad, chunk, lw):
    x = layer_norm(ALPHA * x + 0.5 * swiglu(x, lw['ffn1_gu'], lw['ffn1_dn']), lw['ln1_g'], lw['ln1_b'])
    proj = x @ lw['w_in']
    p_rw, p_z, p_xbc, p_dt, p_gate = jnp.split(proj, IN_SPLITS, axis=-1)
    y_rw, new_shift, wkv_t = rwkv7_mix(p_rw, shift_hist, wkv0, lw['rw_mu'], lw['rw_w0'], lw['rw_w2'], lw['rw_a0'], lw['rw_a2'], lw['rw_g2'], lw['rw_kk'], lw['rw_ka'], lw['rw_rk'], lw['rw_gn_w'], lw['rw_gn_b'])
    y_ssm, new_conv, ssm_t = mamba2_mix(p_z, p_xbc, p_dt, conv_hist, ssm0, pad, chunk, lw['conv_w'], lw['conv_b'], lw['dt_bias'], lw['a_log'], lw['d_skip'], lw['ssm_norm_w'])
    g_a, g_b = jnp.split(jax.nn.sigmoid(p_gate + lw['b_gate']), 2, axis=-1)
    merged = g_a * (y_rw @ lw['w_rw_out']) + g_b * (y_ssm @ lw['w_ssm_out'])
    x = layer_norm(ALPHA * x + merged @ lw['w_out'], lw['ln2_g'], lw['ln2_b'])
    x = layer_norm(ALPHA * x + 0.5 * swiglu(x, lw['ffn2_gu'], lw['ffn2_dn']), lw['ln3_g'], lw['ln3_b'])
    return x, new_shift, wkv_t, new_conv, ssm_t


def setup_inputs(seed: int = 0) -> dict:
    key = jax.random.key(seed)
    ks = iter(jax.random.split(key, 64))

    def nrm(shape, scale):
        return jax.random.normal(next(ks), shape, jnp.float32) * scale

    def unif(shape, lo, hi):
        return jax.random.uniform(next(ks), shape, jnp.float32, lo, hi)

    L = DEPTH
    dt0 = jnp.exp(unif((L, SSM_HEADS), math.log(1e-3), math.log(1e-1)))
    return {
        'x_prompt': nrm((BATCH, SEQ, D_MODEL), 1.0),
        'x_sample': nrm((DEC_BATCH, DEC_SEQ, D_MODEL), 1.0),
        'state_rwkv_shift': nrm((L, DEC_BATCH, 1, RW_SHIFT_COLS), 1.0),
        'state_wkv': nrm((L, DEC_BATCH, RW_HEADS, RW_HEAD, RW_HEAD), 0.3),
        'state_conv': nrm((L, DEC_BATCH, CONV_W - 1, CONV_DIM), 1.0),
        'state_ssm': nrm((L, DEC_BATCH, SSM_HEADS, SSM_HEAD, SSM_STATE), 0.1),
        'meta_tokens': nrm((N_META, D_MODEL), 1.0),
        'ffn1_gu': nrm((L, D_MODEL, 2 * D_FF), D_MODEL ** -0.5),
        'ffn1_dn': nrm((L, D_FF, D_MODEL), BETA * D_FF ** -0.5),
        'ln1_g': 1.0 + nrm((L, D_MODEL), 0.02),
        'ln1_b': nrm((L, D_MODEL), 0.02),
        'w_in': nrm((L, D_MODEL, N_IN), D_MODEL ** -0.5),
        'b_gate': nrm((L, 2 * D_MODEL), 0.1),
        'rw_mu': unif((L, RW_SHIFT_COLS), 0.0, 1.0),
        'rw_w0': unif((L, RW_DIM), -6.0, -1.0),
        'rw_w2': nrm((L, RW_DECAY_LORA, RW_DIM), 0.1 * RW_DECAY_LORA ** -0.5),
        'rw_a0': nrm((L, RW_DIM), 0.1),
        'rw_a2': nrm((L, RW_AAA_LORA, RW_DIM), RW_AAA_LORA ** -0.5),
        'rw_g2': nrm((L, RW_GATE_LORA, RW_DIM), RW_GATE_LORA ** -0.5),
        'rw_kk': 0.85 + nrm((L, RW_HEADS, RW_HEAD), 0.02),
        'rw_ka': 1.0 + nrm((L, RW_HEADS, RW_HEAD), 0.02),
        'rw_rk': nrm((L, RW_HEADS, RW_HEAD), 0.1),
        'rw_gn_w': 1.0 + nrm((L, RW_DIM), 0.02),
        'rw_gn_b': nrm((L, RW_DIM), 0.02),
        'conv_w': nrm((L, CONV_W, CONV_DIM), CONV_W ** -0.5),
        'conv_b': nrm((L, CONV_DIM), 0.02),
        'dt_bias': dt0 + jnp.log(-jnp.expm1(-dt0)),
        'a_log': jnp.log(unif((L, SSM_HEADS), 1.0, 16.0)),
        'd_skip': 1.0 + nrm((L, SSM_HEADS), 0.1),
        'ssm_norm_w': 1.0 + nrm((L, SSM_DIM), 0.02),
        'w_rw_out': nrm((L, RW_DIM, D_MODEL), RW_DIM ** -0.5),
        'w_ssm_out': nrm((L, SSM_DIM, D_MODEL), SSM_DIM ** -0.5),
        'w_out': nrm((L, D_MODEL, D_MODEL), BETA * D_MODEL ** -0.5),
        'ln2_g': 1.0 + nrm((L, D_MODEL), 0.02),
        'ln2_b': nrm((L, D_MODEL), 0.02),
        'ffn2_gu': nrm((L, D_MODEL, 2 * D_FF), D_MODEL ** -0.5),
        'ffn2_dn': nrm((L, D_FF, D_MODEL), BETA * D_FF ** -0.5),
        'ln3_g': 1.0 + nrm((L, D_MODEL), 0.02),
        'ln3_b': nrm((L, D_MODEL), 0.02),
    }


def reference(x_prompt, x_sample, state_rwkv_shift, state_wkv, state_conv, state_ssm, meta_tokens,
              ffn1_gu, ffn1_dn, ln1_g, ln1_b, w_in, b_gate, rw_mu, rw_w0, rw_w2, rw_a0, rw_a2, rw_g2,
              rw_kk, rw_ka, rw_rk, rw_gn_w, rw_gn_b, conv_w, conv_b, dt_bias, a_log, d_skip, ssm_norm_w,
              w_rw_out, w_ssm_out, w_out, ln2_g, ln2_b, ffn2_gu, ffn2_dn, ln3_g, ln3_b):
    weights = {
        'ffn1_gu': ffn1_gu, 'ffn1_dn': ffn1_dn, 'ln1_g': ln1_g, 'ln1_b': ln1_b, 'w_in': w_in, 'b_gate': b_gate,
        'rw_mu': rw_mu, 'rw_w0': rw_w0, 'rw_w2': rw_w2, 'rw_a0': rw_a0, 'rw_a2': rw_a2, 'rw_g2': rw_g2,
        'rw_kk': rw_kk, 'rw_ka': rw_ka, 'rw_rk': rw_rk, 'rw_gn_w': rw_gn_w, 'rw_gn_b': rw_gn_b,
        'conv_w': conv_w, 'conv_b': conv_b, 'dt_bias': dt_bias, 'a_log': a_log, 'd_skip': d_skip,
        'ssm_norm_w': ssm_norm_w, 'w_rw_out': w_rw_out, 'w_ssm_out': w_ssm_out, 'w_out': w_out,
        'ln2_g': ln2_g, 'ln2_b': ln2_b, 'ffn2_gu': ffn2_gu, 'ffn2_dn': ffn2_dn, 'ln3_g': ln3_g, 'ln3_b': ln3_b,
    }
    b = x_prompt.shape[0]
    dtp = x_prompt.dtype
    xp = jnp.concatenate([jnp.broadcast_to(meta_tokens.astype(dtp)[None], (b, N_META, D_MODEL)), x_prompt], axis=1)
    xs = x_sample
    p_shift, p_wkv, p_conv, p_ssm = [], [], [], []
    s_shift, s_wkv, s_conv, s_ssm = [], [], [], []
    for layer in range(DEPTH):
        lw = {name: w[layer] for name, w in weights.items()}
        xp, ps_, pw_, pc_, pm_ = trunk_layer(
            xp,
            jnp.zeros((b, 1, RW_SHIFT_COLS), dtp),
            jnp.zeros((b, RW_HEADS, RW_HEAD, RW_HEAD), dtp),
            jnp.zeros((b, CONV_W - 1, CONV_DIM), dtp),
            jnp.zeros((b, SSM_HEADS, SSM_HEAD, SSM_STATE), dtp),
            PROMPT_PAD, CHUNK, lw)
        xs, ss_, sw_, sc_, sm_ = trunk_layer(
            xs, state_rwkv_shift[layer], state_wkv[layer], state_conv[layer], state_ssm[layer],
            0, xs.shape[1], lw)
        p_shift.append(ps_); p_wkv.append(pw_); p_conv.append(pc_); p_ssm.append(pm_)
        s_shift.append(ss_); s_wkv.append(sw_); s_conv.append(sc_); s_ssm.append(sm_)
    y_prompt = xp[:, N_META:]
    return (y_prompt, xs, jnp.stack(p_shift), jnp.stack(p_wkv), jnp.stack(p_conv), jnp.stack(p_ssm),
            jnp.stack(s_shift), jnp.stack(s_wkv), jnp.stack(s_conv), jnp.stack(s_ssm))
```

```cpp
#include <hip/hip_runtime.h>
#include <hip/hip_cooperative_groups.h>
#include <cstdio>
#include <cstdint>
namespace cg = cooperative_groups;

#ifndef MK_SINGLE_LAUNCH
#define MK_SINGLE_LAUNCH 0
#endif

namespace pg8 {
#define PG8_LAS __attribute__((address_space(3)))
typedef unsigned short bf16_t;
typedef short bf16x8 __attribute__((ext_vector_type(8)));
typedef float f32x4 __attribute__((ext_vector_type(4)));
typedef unsigned u32x4 __attribute__((ext_vector_type(4)));
constexpr int BM = 256, BK = 64, HALF = 128, HTB = HALF * BK * 2  , STAGE_BYTES = 8 * HTB, NXCD = 8, WGM = 8;

__host__ __device__ __forceinline__ int lds_byte(int r, int c) { const int st = (r >> 4) * 2 + (c >> 5), rr = r & 15, cc = c & 31, ob = rr * 64 + cc * 2; return st * 1024 + (ob ^ (((ob >> 9) & 1) << 5)); }
__host__ __device__ __forceinline__ void stage_rc(int b, int& R, int& C) { const int st = b / 1024, sb = b % 1024, swz = sb ^ (((sb >> 9) & 1) << 5); R = (st >> 1) * 16 + swz / 64; C = (st & 1) * 32 + (swz % 64) / 2; }
__host__ __device__ __forceinline__ int perm32(int rho) { const int n = rho >> 4, i = rho & 15; return 8 * (i >> 2) + 4 * n + (i & 3); }

struct Unit { int pm, pn; };
struct Gemm { const bf16_t* A; const bf16_t* Bt; int M, N, K; };

struct StaticOrder {
    int nM, nN, nwg, G, c;
    __host__ __device__ void init(int M, int N, int G_, int c_) { nM = M / BM; nN = N / BM; nwg = nM * nN; G = G_; c = c_; }
    __host__ __device__ bool next(int i, Unit& u) const {
        const long L = (long)i * G + c; if (L >= nwg) return false;
        int wgid = (int)L; { const int q = nwg / NXCD, r = nwg % NXCD, xcd = wgid % NXCD, off = wgid / NXCD; wgid = (xcd < r ? xcd * (q + 1) : r * (q + 1) + (xcd - r) * q) + off; }
        const int nig = WGM * nN, gid = wgid / nig, fm = gid * WGM, gsz = (nM - fm) < WGM ? (nM - fm) : WGM;
        u.pm = fm + ((wgid % nig) % gsz); u.pn = (wgid % nig) / gsz; return true;
    }
    __device__ __forceinline__ void a_ready(const Unit&) const {}
    __device__ __forceinline__ void done(const Unit&) const {}
};

__device__ __forceinline__ unsigned cvt_pk_bf16(float lo, float hi) { unsigned r; asm volatile("v_cvt_pk_bf16_f32 %0, %1, %2" : "=v"(r) : "v"(lo), "v"(hi)); return r; }

__device__ __forceinline__ float bf2f(unsigned short h) { return __uint_as_float(((unsigned)h) << 16); }
__device__ __forceinline__ float bflo(unsigned w) { return __uint_as_float(w << 16); }
__device__ __forceinline__ float bfhi(unsigned w) { return __uint_as_float(w & 0xffff0000u); }
__device__ __forceinline__ float sigm(float x) { return 1.0f / (1.0f + __expf(-x)); }
__device__ __forceinline__ float silu_(float x) { return x / (1.0f + __expf(-x)); }
typedef unsigned u32x2 __attribute__((ext_vector_type(2)));

enum { EM_SWIGLU = 0, EM_RESID = 1, EM_WIN = 2, EM_LORA = 3, EM_M1 = 4, EM_M2 = 5 };
struct EpiGen {
    static constexpr bool AFTER_DRAIN = false;
    int mode; bool PERM;
    void* o0; void* o1; void* o2; const void* i0; const void* i1; const float* f0; const float* f1;
    float alpha, scale;
    __device__ __forceinline__ void operator()(const f32x4 (&acc)[2][2][4][2], const Unit& u, int wr, int wc, int fr, int fq) const {
        const int row0 = u.pm * BM + wr * 64 + fr;
        if (mode == EM_SWIGLU) {
            bf16_t* O = (bf16_t*)o0; const int col0 = u.pn * 128 + wc * 32 + 8 * fq;
#pragma unroll
            for (int ai = 0; ai < 2; ++ai)
#pragma unroll
                for (int m = 0; m < 4; ++m) { bf16_t* rowp = O + (size_t)(row0 + ai * HALF + m * 16) * 5632 + col0;
                    const f32x4 g0 = acc[ai][0][m][0], g1 = acc[ai][0][m][1], u0 = acc[ai][1][m][0], u1 = acc[ai][1][m][1];
                    f32x4 v0, v1;
#pragma unroll
                    for (int j = 0; j < 4; ++j) { v0[j] = silu_(g0[j]) * u0[j]; v1[j] = silu_(g1[j]) * u1[j]; }
                    u32x4 w; w.x = cvt_pk_bf16(v0[0], v0[1]); w.y = cvt_pk_bf16(v0[2], v0[3]); w.z = cvt_pk_bf16(v1[0], v1[1]); w.w = cvt_pk_bf16(v1[2], v1[3]);
                    *(u32x4*)rowp = w; }
        } else if (mode == EM_RESID) {
            float* C = (float*)o0; const bf16_t* R = (const bf16_t*)i0; const int col0 = u.pn * BM + wc * 32 + 4 * fq;
#pragma unroll
            for (int ai = 0; ai < 2; ++ai)
#pragma unroll
                for (int m = 0; m < 4; ++m) { const size_t off = (size_t)(row0 + ai * HALF + m * 16) * 2048 + col0;
#pragma unroll
                    for (int bj = 0; bj < 2; ++bj)
#pragma unroll
                        for (int n = 0; n < 2; ++n) { const u32x2 rv = *(const u32x2*)(R + off + bj * HALF + n * 16);
                            f32x4 o; o[0] = alpha * bflo(rv.x) + scale * acc[ai][bj][m][n][0]; o[1] = alpha * bfhi(rv.x) + scale * acc[ai][bj][m][n][1];
                            o[2] = alpha * bflo(rv.y) + scale * acc[ai][bj][m][n][2]; o[3] = alpha * bfhi(rv.y) + scale * acc[ai][bj][m][n][3];
                            *(f32x4*)(C + off + bj * HALF + n * 16) = o; } }
        } else if (mode == EM_WIN) {
            const int pn = u.pn; bf16_t* O; int ld, colt, act;
            if (pn < 14) { O = (bf16_t*)o0; ld = 3584; colt = pn * BM; act = 0; }
            else if (pn < 22) { O = (bf16_t*)o0 + (size_t)8704 * 3584; ld = 2048; colt = (pn - 14) * BM; act = 1; }
            else if (pn < 34) { O = (bf16_t*)o0 + (size_t)8704 * (3584 + 2048); ld = 3072; colt = (pn - 22) * BM; act = 0; }
            else { O = (bf16_t*)o0 + (size_t)8704 * (3584 + 2048 + 3072); ld = 4096; colt = (pn - 34) * BM; act = 2; }
            const int col0 = colt + wc * 32 + 8 * fq;
            f32x4 bv[2][2];
#pragma unroll
            for (int bj = 0; bj < 2; ++bj)
#pragma unroll
                for (int n = 0; n < 2; ++n) bv[bj][n] = (act == 2) ? *(const f32x4*)(f0 + col0 + bj * HALF + 4 * n) : (f32x4){0.f, 0.f, 0.f, 0.f};
#pragma unroll
            for (int ai = 0; ai < 2; ++ai)
#pragma unroll
                for (int m = 0; m < 4; ++m) { bf16_t* rowp = O + (size_t)(row0 + ai * HALF + m * 16) * ld + col0;
#pragma unroll
                    for (int bj = 0; bj < 2; ++bj) { f32x4 v0 = acc[ai][bj][m][0] + bv[bj][0], v1 = acc[ai][bj][m][1] + bv[bj][1];
                        if (act == 1) {
#pragma unroll
                            for (int j = 0; j < 4; ++j) { v0[j] = silu_(v0[j]); v1[j] = silu_(v1[j]); } }
                        else if (act == 2) {
#pragma unroll
                            for (int j = 0; j < 4; ++j) { v0[j] = sigm(v0[j]); v1[j] = sigm(v1[j]); } }
                        u32x4 w; w.x = cvt_pk_bf16(v0[0], v0[1]); w.y = cvt_pk_bf16(v0[2], v0[3]); w.z = cvt_pk_bf16(v1[0], v1[1]); w.w = cvt_pk_bf16(v1[2], v1[3]);
                        *(u32x4*)(rowp + bj * HALF) = w; } }
        } else if (mode == EM_LORA) {
            const int pn = u.pn; const int col0 = (pn & 3) * BM + wc * 32 + 4 * fq;
            if (pn < 4) {
#pragma unroll
                for (int ai = 0; ai < 2; ++ai)
#pragma unroll
                    for (int m = 0; m < 4; ++m) { const size_t off = (size_t)(row0 + ai * HALF + m * 16) * 1024 + col0;
#pragma unroll
                        for (int bj = 0; bj < 2; ++bj)
#pragma unroll
                            for (int n = 0; n < 2; ++n) { const int c = col0 + bj * HALF + n * 16; const f32x4 a = acc[ai][bj][m][n]; const f32x4 b = *(const f32x4*)(f0 + c); f32x4 o;
#pragma unroll
                                for (int j = 0; j < 4; ++j) o[j] = __expf(-0.6065306597f * sigm(a[j] + b[j]));
                                *(f32x4*)((float*)o0 + off + bj * HALF + n * 16) = o; } }
            } else if (pn < 8) {
#pragma unroll
                for (int ai = 0; ai < 2; ++ai)
#pragma unroll
                    for (int m = 0; m < 4; ++m) { const size_t off = (size_t)(row0 + ai * HALF + m * 16) * 1024 + col0;
#pragma unroll
                        for (int bj = 0; bj < 2; ++bj)
#pragma unroll
                            for (int n = 0; n < 2; ++n) { const int c = col0 + bj * HALF + n * 16; const f32x4 a = acc[ai][bj][m][n]; const f32x4 b = *(const f32x4*)(f1 + c);
                                u32x2 w; w.x = cvt_pk_bf16(sigm(a[0] + b[0]), sigm(a[1] + b[1])); w.y = cvt_pk_bf16(sigm(a[2] + b[2]), sigm(a[3] + b[3]));
                                *(u32x2*)((bf16_t*)o1 + off + bj * HALF + n * 16) = w; } }
            } else {
#pragma unroll
                for (int ai = 0; ai < 2; ++ai)
#pragma unroll
                    for (int m = 0; m < 4; ++m) { const size_t off = (size_t)(row0 + ai * HALF + m * 16) * 1024 + col0;
#pragma unroll
                        for (int bj = 0; bj < 2; ++bj)
#pragma unroll
                            for (int n = 0; n < 2; ++n) { const f32x4 a = acc[ai][bj][m][n];
                                u32x2 w; w.x = cvt_pk_bf16(a[0], a[1]); w.y = cvt_pk_bf16(a[2], a[3]); *(u32x2*)((bf16_t*)o2 + off + bj * HALF + n * 16) = w; } }
            }
        } else if (mode == EM_M1) {
            float* C = (float*)o0; const bf16_t* Gt = (const bf16_t*)i0; const int col0 = u.pn * BM + wc * 32 + 4 * fq;
#pragma unroll
            for (int ai = 0; ai < 2; ++ai)
#pragma unroll
                for (int m = 0; m < 4; ++m) { const size_t r = (size_t)(row0 + ai * HALF + m * 16);
#pragma unroll
                    for (int bj = 0; bj < 2; ++bj)
#pragma unroll
                        for (int n = 0; n < 2; ++n) { const int c = col0 + bj * HALF + n * 16; const u32x2 gv = *(const u32x2*)(Gt + r * 4096 + c); const f32x4 a = acc[ai][bj][m][n];
                            f32x4 o; o[0] = bflo(gv.x) * a[0]; o[1] = bfhi(gv.x) * a[1]; o[2] = bflo(gv.y) * a[2]; o[3] = bfhi(gv.y) * a[3];
                            *(f32x4*)(C + r * 2048 + c) = o; } }
        } else {
            bf16_t* O = (bf16_t*)o0; const bf16_t* Gt = (const bf16_t*)i0; const float* T1 = (const float*)i1; const int col0 = u.pn * BM + wc * 32 + 8 * fq;
#pragma unroll
            for (int ai = 0; ai < 2; ++ai)
#pragma unroll
                for (int m = 0; m < 4; ++m) { const size_t r = (size_t)(row0 + ai * HALF + m * 16);
#pragma unroll
                    for (int bj = 0; bj < 2; ++bj) { const int c = col0 + bj * HALF; const u32x4 gv = *(const u32x4*)(Gt + r * 4096 + 2048 + c);
                        const f32x4 t0 = *(const f32x4*)(T1 + r * 2048 + c), t1 = *(const f32x4*)(T1 + r * 2048 + c + 4); const f32x4 a0 = acc[ai][bj][m][0], a1 = acc[ai][bj][m][1];
                        u32x4 w; w.x = cvt_pk_bf16(t0[0] + bflo(gv.x) * a0[0], t0[1] + bfhi(gv.x) * a0[1]); w.y = cvt_pk_bf16(t0[2] + bflo(gv.y) * a0[2], t0[3] + bfhi(gv.y) * a0[3]);
                        w.z = cvt_pk_bf16(t1[0] + bflo(gv.z) * a1[0], t1[1] + bfhi(gv.z) * a1[1]); w.w = cvt_pk_bf16(t1[2] + bflo(gv.w) * a1[2], t1[3] + bfhi(gv.w) * a1[3]);
                        *(u32x4*)(O + r * 2048 + c) = w; } }
        }
    }
};
template <class Epi, class Sched, bool ALIGN_EPI = false, bool SP2 = false>
__device__ __forceinline__ void gemm_phase(PG8_LAS unsigned char* lds, const Gemm g, const Sched& S, const Epi& E) {
    const int tid = threadIdx.x, wid = __builtin_amdgcn_readfirstlane(tid >> 6), lane = tid & 63, wr = wid >> 2, wc = wid & 3, fr = lane & 15, fq = lane >> 4;
    const int K = g.K, nt = K / BK;
    unsigned voffA[2], voffB[2];
#pragma unroll
    for (int i = 0; i < 2; ++i) { int R, C; stage_rc(tid * 16 + i * 8192, R, C); const int Rb = E.PERM ? ((R & ~31) + perm32(R & 31)) : R;
        voffA[i] = (unsigned)(R * K + C) * 2u; voffB[i] = (unsigned)(Rb * K + C) * 2u; }
    const size_t kstep = (size_t)(BK * 2);
    const size_t hstep = (size_t)HALF * K * 2;
    const size_t tstep = 2 * hstep;
    const unsigned ldsw = (unsigned)wid * 1024u;
    const int aoff = lds_byte(wr * 64 + fr, fq * 8), boff = lds_byte(wc * 32 + fr, fq * 8);
#define PG8_SA(b, h) (((b) * 2 + (h)) * HTB)
#define PG8_SB(b, h) ((4 + (b) * 2 + (h)) * HTB)
#define PG8_STAGE(bufoff, gbase, voff) do { _Pragma("unroll") for (int _i = 0; _i < 2; ++_i) \
        __builtin_amdgcn_global_load_lds((const unsigned*)((const char*)(gbase) + (voff)[_i]), (PG8_LAS unsigned*)(lds + (bufoff) + ldsw + _i * 8192), 16, 0, 0); } while (0)
#define PG8_LDA(dst, b, h) do { _Pragma("unroll") for (int m = 0; m < 4; ++m) _Pragma("unroll") for (int k = 0; k < 2; ++k) dst[m][k] = *(const PG8_LAS bf16x8*)(lds + PG8_SA(b, h) + aoff + m * 2048 + k * 1024); } while (0)
#define PG8_LDB(dst, b, h) do { _Pragma("unroll") for (int n = 0; n < 2; ++n) _Pragma("unroll") for (int k = 0; k < 2; ++k) dst[n][k] = *(const PG8_LAS bf16x8*)(lds + PG8_SB(b, h) + boff + n * 2048 + k * 1024); } while (0)
#define PG8_MMA(ai, bj, At, Bt) do { __builtin_amdgcn_s_setprio(1); _Pragma("unroll") for (int m = 0; m < 4; ++m) _Pragma("unroll") for (int n = 0; n < 2; ++n) _Pragma("unroll") for (int k = 0; k < 2; ++k) \
        acc[ai][bj][m][n] = __builtin_amdgcn_mfma_f32_16x16x32_bf16(Bt[n][k], At[m][k], acc[ai][bj][m][n], 0, 0, 0); __builtin_amdgcn_s_setprio(0); } while (0)
#define PG8_WAIT_V(n) asm volatile("s_waitcnt vmcnt(" #n ")" ::: "memory")
#define PG8_WAIT_L(n) asm volatile("s_waitcnt lgkmcnt(" #n ")" ::: "memory")
#define PG8_BAR __builtin_amdgcn_s_barrier()
#define PG8_SCHED __builtin_amdgcn_sched_barrier(0)
    Unit cur, nxt; int ui = 0;
    if (!S.next(0, cur)) return;
    f32x4 acc[2][2][4][2];
#pragma unroll
    for (int a = 0; a < 2; ++a)
#pragma unroll
        for (int b = 0; b < 2; ++b)
#pragma unroll
            for (int m = 0; m < 4; ++m)
#pragma unroll
                for (int n = 0; n < 2; ++n) acc[a][b][m][n] = (f32x4){0.f, 0.f, 0.f, 0.f};
    bf16x8 At[4][2], B0[2][2], B1[2][2];
    const char* cA = (const char*)g.A + (size_t)cur.pm * tstep; const char* cB = (const char*)g.Bt + (size_t)cur.pn * tstep;
    S.a_ready(cur);
    if constexpr (SP2) {
        PG8_STAGE(PG8_SB(0, 0), cB, voffB); PG8_STAGE(PG8_SB(0, 1), cB + hstep, voffB); PG8_STAGE(PG8_SA(0, 0), cA, voffA); PG8_STAGE(PG8_SA(0, 1), cA + hstep, voffA);
        if (wr == 1) PG8_BAR;
        PG8_WAIT_V(2); PG8_BAR;
        PG8_STAGE(PG8_SB(1, 0), cB + kstep, voffB); PG8_STAGE(PG8_SA(1, 0), cA + kstep, voffA); PG8_STAGE(PG8_SB(1, 1), cB + hstep + kstep, voffB);
        PG8_WAIT_V(6); PG8_BAR;
    } else {
        PG8_STAGE(PG8_SB(0, 0), cB, voffB); PG8_STAGE(PG8_SA(0, 0), cA, voffA); PG8_STAGE(PG8_SB(0, 1), cB + hstep, voffB); PG8_STAGE(PG8_SA(0, 1), cA + hstep, voffA);
        if (wr == 1) PG8_BAR;
        PG8_WAIT_V(4); PG8_BAR;
        PG8_STAGE(PG8_SB(1, 0), cB + kstep, voffB); PG8_STAGE(PG8_SA(1, 0), cA + kstep, voffA); PG8_STAGE(PG8_SB(1, 1), cB + hstep + kstep, voffB);
        PG8_WAIT_V(6); PG8_BAR;
    }
    for (;;) {
        const bool has_next = S.next(ui + 1, nxt);
        const char* nA = has_next ? (const char*)g.A + (size_t)nxt.pm * tstep : cA; const char* nB = has_next ? (const char*)g.Bt + (size_t)nxt.pn * tstep : cB;
        for (int t = 0; t < nt; t += 2) {
            const bool last = (t == nt - 2);
            const char* a1 = cA + (size_t)(t + 1) * kstep;
            const char* a2 = last ? nA : cA + (size_t)(t + 2) * kstep; const char* b2 = last ? nB : cB + (size_t)(t + 2) * kstep;
            const char* a3 = a2 + kstep; const char* b3 = b2 + kstep;
            if (last && has_next) S.a_ready(nxt);
            if constexpr (SP2) {
            PG8_LDB(B0, 0, 0); PG8_LDB(B1, 0, 1); PG8_SCHED; PG8_LDA(At, 0, 0); PG8_STAGE(PG8_SA(1, 1), a1 + hstep, voffA);
            PG8_WAIT_V(8); PG8_WAIT_L(0); PG8_BAR; PG8_MMA(0, 0, At, B0); PG8_MMA(0, 1, At, B1); PG8_BAR; PG8_SCHED;
            PG8_LDA(At, 0, 1); PG8_STAGE(PG8_SB(0, 0), b2, voffB); PG8_STAGE(PG8_SB(0, 1), b2 + hstep, voffB); PG8_STAGE(PG8_SA(0, 0), a2, voffA);
            PG8_WAIT_V(8); PG8_WAIT_L(0); PG8_BAR; PG8_MMA(1, 0, At, B0); PG8_MMA(1, 1, At, B1); PG8_BAR; PG8_SCHED;
            PG8_LDB(B0, 1, 0); PG8_LDB(B1, 1, 1); PG8_SCHED; PG8_LDA(At, 1, 0); PG8_STAGE(PG8_SA(0, 1), a2 + hstep, voffA);
            PG8_WAIT_V(8); PG8_WAIT_L(0); PG8_BAR; PG8_MMA(0, 0, At, B0); PG8_MMA(0, 1, At, B1); PG8_BAR; PG8_SCHED;
            PG8_LDA(At, 1, 1); PG8_STAGE(PG8_SB(1, 0), b3, voffB); PG8_STAGE(PG8_SB(1, 1), b3 + hstep, voffB); PG8_STAGE(PG8_SA(1, 0), a3, voffA);
            PG8_WAIT_V(8); PG8_WAIT_L(0); PG8_BAR; PG8_MMA(1, 0, At, B0); PG8_MMA(1, 1, At, B1); PG8_BAR; PG8_SCHED;
            } else {
            PG8_LDB(B0, 0, 0); PG8_SCHED; PG8_LDA(At, 0, 0); PG8_STAGE(PG8_SA(1, 1), a1 + hstep, voffA);
            PG8_WAIT_L(8); PG8_BAR; PG8_WAIT_L(0); PG8_MMA(0, 0, At, B0); PG8_BAR; PG8_SCHED;
            PG8_LDB(B1, 0, 1); PG8_STAGE(PG8_SB(0, 0), b2, voffB);
            PG8_BAR; PG8_WAIT_L(0); PG8_MMA(0, 1, At, B1); PG8_BAR;
            PG8_LDA(At, 0, 1); PG8_STAGE(PG8_SA(0, 0), a2, voffA);
            PG8_BAR; PG8_WAIT_L(0); PG8_MMA(1, 0, At, B0); PG8_BAR; PG8_SCHED;
            PG8_STAGE(PG8_SB(0, 1), b2 + hstep, voffB);
            PG8_WAIT_V(6); PG8_BAR; PG8_MMA(1, 1, At, B1); PG8_BAR;
            PG8_LDB(B0, 1, 0); PG8_SCHED; PG8_LDA(At, 1, 0); PG8_STAGE(PG8_SA(0, 1), a2 + hstep, voffA);
            PG8_WAIT_L(8); PG8_BAR; PG8_WAIT_L(0); PG8_MMA(0, 0, At, B0); PG8_BAR; PG8_SCHED;
            PG8_LDB(B1, 1, 1); PG8_STAGE(PG8_SB(1, 0), b3, voffB);
            PG8_BAR; PG8_WAIT_L(0); PG8_MMA(0, 1, At, B1); PG8_BAR;
            PG8_LDA(At, 1, 1); PG8_STAGE(PG8_SA(1, 0), a3, voffA);
            PG8_BAR; PG8_WAIT_L(0); PG8_MMA(1, 0, At, B0); PG8_BAR; PG8_SCHED;
            PG8_STAGE(PG8_SB(1, 1), b3 + hstep, voffB);
            PG8_WAIT_V(6); PG8_BAR; PG8_MMA(1, 1, At, B1); PG8_BAR;
            }
        }
        if constexpr (ALIGN_EPI) { if (wr == 0) PG8_BAR; }
        if constexpr (!Epi::AFTER_DRAIN) { E(acc, cur, wr, wc, fr, fq); S.done(cur); }
        if (!has_next) break;
#pragma unroll
        for (int a = 0; a < 2; ++a)
#pragma unroll
            for (int b = 0; b < 2; ++b)
#pragma unroll
                for (int m = 0; m < 4; ++m)
#pragma unroll
                    for (int n = 0; n < 2; ++n) acc[a][b][m][n] = (f32x4){0.f, 0.f, 0.f, 0.f};
        cur = nxt; cA = nA; cB = nB; ++ui;
        if constexpr (ALIGN_EPI) { if (wr == 1) PG8_BAR; }
    }
    PG8_WAIT_V(0);
    if constexpr (!ALIGN_EPI) { if (wr == 0) PG8_BAR; }
    PG8_BAR;
    if constexpr (Epi::AFTER_DRAIN) { E.fused(acc, cur, wr, wc, fr, fq, lds, wid, lane); S.done(cur); }
#undef PG8_SA
#undef PG8_SB
#undef PG8_STAGE
#undef PG8_LDA
#undef PG8_LDB
#undef PG8_MMA
#undef PG8_WAIT_V
#undef PG8_WAIT_L
#undef PG8_BAR
#undef PG8_SCHED
}
}

#define LAS __attribute__((address_space(3)))
typedef unsigned short bf16;
typedef float f32x4 __attribute__((ext_vector_type(4)));
typedef unsigned u32x4 __attribute__((ext_vector_type(4)));
typedef unsigned u32x2 __attribute__((ext_vector_type(2)));
typedef short bf16x8 __attribute__((ext_vector_type(8)));
using pg8::bf2f; using pg8::bflo; using pg8::bfhi; using pg8::sigm; using pg8::silu_; using pg8::cvt_pk_bf16;

constexpr int D = 2048, FF = 5632, NB = 4, SEQ = 2048, NMETA = 16, PADR = 48, LP = 2112  , TP = 2064  ;
constexpr int SB = 16, SS = 16, MP = NB * LP  , MROWS = MP + SB * SS  ;
constexpr int RWD = 1024, RWH = 16, SHC = 3520, CONVD = 3072, SSMH = 32, SSMN = 128, NINP = 12800;
constexpr int PRW_LD = 3584, Z_LD = 2048, XBC_LD = 3072, GATE_LD = 4096;
constexpr float LN_EPS = 1e-5f, ALPHA = 1.189207115f  , GN_EPS = 64e-5f, RMS_EPS = 1e-5f;
constexpr int NPHASE = 17;
constexpr int LDS_BYTES = 147456;

enum { I_XP = 0, I_XS, I_SSH, I_SWKV, I_SCONV, I_SSSM, I_META, I_GU1, I_DN1, I_LN1G, I_LN1B, I_WIN, I_BGATE, I_MU, I_W0, I_W2, I_A0, I_A2, I_G2, I_KK, I_KA, I_RK, I_GNW, I_GNB,
       I_CONVW, I_CONVB, I_DTB, I_ALOG, I_DSKIP, I_NORMW, I_RWO, I_SSMO, I_WO, I_LN2G, I_LN2B, I_GU2, I_DN2, I_LN3G, I_LN3B, N_IN };
constexpr size_t O_YP = 0, O_YS = 16777216, O_PSH = 17301504, O_PWKV = 17315584, O_PCONV = 17577728, O_PSSM = 17614592, O_SSH = 18663168, O_SWKV = 18719488, O_SCONV = 19768064, O_SSSM = 19915520, O_END = 24109824;
constexpr size_t MiB = 1u << 20;
constexpr size_t WS_SBON = 1 * MiB, WS_RWOT = 2 * MiB, WS_SSMOT = 6 * MiB, WS_WOT = 14 * MiB, WS_LORAT = 22 * MiB, WS_WBIG = 25 * MiB, WS_XB = 91 * MiB, WS_ACT = 125 * MiB, WS_PROJ = 219 * MiB, WS_YRW = 432 * MiB, WS_END = 449 * MiB;
constexpr size_t WS_GUT = WS_WBIG, WS_DNT = WS_WBIG + 44 * MiB, WS_WINT = WS_WBIG, WS_WDEC = WS_WBIG, WS_GBUF = WS_WBIG + 34 * MiB, WS_MERGED = WS_WBIG;
constexpr size_t WS_R = WS_ACT, WS_KP = WS_ACT + 17 * MiB, WS_V = WS_ACT + 34 * MiB, WS_KK = WS_ACT + 51 * MiB, WS_BB = WS_ACT + 68 * MiB, WS_ALORA = WS_ACT + 85 * MiB, WS_T1 = WS_ACT;
constexpr size_t WS_PRW = WS_PROJ, WS_Z = WS_PRW + (size_t)MROWS * PRW_LD * 2, WS_XBC = WS_Z + (size_t)MROWS * Z_LD * 2, WS_GATE = WS_XBC + (size_t)MROWS * XBC_LD * 2, WS_PRE = WS_PROJ;
static_assert(WS_GATE + (size_t)MROWS * GATE_LD * 2 <= WS_YRW, "proj region");
static_assert(WS_ALORA + (size_t)MROWS * 512 * 2 <= WS_PROJ, "act region");

struct Params { const float* in[N_IN]; float* out; unsigned char* ws; int ph_lo, ph_hi; };

__device__ __forceinline__ int opaque_idx(int i) { asm volatile("" : "+s"(i)); return i; }
#define PIN(i) (p.in[opaque_idx(i)])
struct Ctx { int tid, lane, wave, gw, ngw; LAS unsigned char* lds; };

__device__ __forceinline__ float wave_sum(float v) {
#pragma unroll
    for (int o = 1; o < 64; o <<= 1) v += __shfl_xor(v, o);
    return v;
}
__device__ __forceinline__ unsigned pk2(float lo, float hi) { return cvt_pk_bf16(lo, hi); }
__device__ __forceinline__ float softplus_(float x) { return fmaxf(x, 0.f) + __logf(1.f + __expf(-fabsf(x))); }

__device__ __forceinline__ const float* xrow_ptr(const Params& p, int row) {
    if (row < MP) { const int b = row / LP, q = row - b * LP; if (q < PADR) return nullptr; const int t = q - PADR;
        return t < NMETA ? PIN(I_META) + (size_t)t * D : PIN(I_XP) + ((size_t)b * SEQ + (t - NMETA)) * D; }
    return PIN(I_XS) + (size_t)(row - MP) * D;
}
__device__ __forceinline__ float* yrow_ptr(const Params& p, int row) {
    if (row < MP) { const int b = row / LP, q = row - b * LP; if (q < PADR + NMETA) return nullptr; return p.out + O_YP + ((size_t)b * SEQ + (q - PADR - NMETA)) * D; }
    return p.out + O_YS + (size_t)(row - MP) * D;
}
__device__ __forceinline__ bool row_is_pad(int row) { return row < MP && (row % LP) < PADR; }

__device__ __forceinline__ void phase_convert_x(const Params& p, const Ctx& c) {
    bf16* XB = (bf16*)(p.ws + WS_XB);
    for (int row = c.gw; row < MROWS; row += c.ngw) { const float* src = xrow_ptr(p, row); u32x2* dst = (u32x2*)(XB + (size_t)row * D);
#pragma unroll
        for (int j = 0; j < 8; ++j) { f32x4 v = src ? ((const f32x4*)src)[c.lane + 64 * j] : (f32x4){0.f, 0.f, 0.f, 0.f}; u32x2 w; w.x = pk2(v[0], v[1]); w.y = pk2(v[2], v[3]); dst[c.lane + 64 * j] = w; } }
}
enum { MAP_ID = 0, MAP_GU = 1, MAP_WIN = 2 };
__device__ __forceinline__ int map_src_col(int kind, int c) {
    if (kind == MAP_ID) return c;
    if (kind == MAP_GU) { const int pn = c >> 8, bj = (c >> 7) & 1, r = c & 127; return bj * FF + 128 * pn + r; }
    if (c < 3520) return c; if (c < 3552) return 8640 + (c - 3520); if (c < 3584) return -1; if (c < 5632) return 3520 + (c - 3584); if (c < 8704) return 5568 + (c - 5632); return 8672 + (c - 8704);
}
__device__ __forceinline__ void transpose_w(const float* W, int K, int Nsrc, bf16* WT, int ndst, int kind, const Ctx& c) {
    LAS float* scr = (LAS float*)(c.lds + c.wave * 8704);
    const int nblk = ndst / 32, nitems = (K / 64) * nblk, lane = c.lane;
    for (int it = c.gw; it < nitems; it += c.ngw) {
        const int kb = it / nblk, nb = it - kb * nblk, k0 = 64 * kb, n0 = 32 * nb; const int sc = map_src_col(kind, n0);
        if (sc >= 0) {
#pragma unroll 8
            for (int i = 0; i < 32; ++i) { const int kk = 2 * i + (lane >> 5); scr[kk * 33 + (lane & 31)] = W[(size_t)(k0 + kk) * Nsrc + sc + (lane & 31)]; }
        } else {
#pragma unroll 8
            for (int i = 0; i < 32; ++i) { const int kk = 2 * i + (lane >> 5); scr[kk * 33 + (lane & 31)] = 0.f; }
        }
        asm volatile("s_waitcnt lgkmcnt(0)" ::: "memory");
        const int cc = lane & 7;
#pragma unroll
        for (int j = 0; j < 4; ++j) { const int n = (lane >> 3) + 8 * j; const LAS float* s = scr + (8 * cc) * 33 + n;
            u32x4 o; o.x = pk2(s[0 * 33], s[1 * 33]); o.y = pk2(s[2 * 33], s[3 * 33]); o.z = pk2(s[4 * 33], s[5 * 33]); o.w = pk2(s[6 * 33], s[7 * 33]);
            *(u32x4*)(WT + (size_t)(n0 + n) * K + k0 + 8 * cc) = o; }
        asm volatile("s_waitcnt lgkmcnt(0)" ::: "memory");
    }
}
__device__ __forceinline__ void build_lorat(const Params& p, const Ctx& c) {
    bf16* LT = (bf16*)(p.ws + WS_LORAT); const float* w2 = PIN(I_W2); const float* a2 = PIN(I_A2); const float* g2 = PIN(I_G2);
    const int gt = blockIdx.x * 512 + c.tid, ngt = gridDim.x * 512;
    for (int idx = gt; idx < 3072 * 512; idx += ngt) { const int k = idx / 3072, n = idx - k * 3072; float v = 0.f;
        if (n < 1024) { if (k < 96) v = w2[k * 1024 + n]; }
        else if (n < 2048) { if (k >= 96 && k < 192) v = a2[(k - 96) * 1024 + (n - 1024)]; }
        else { if (k >= 256) v = g2[(k - 256) * 1024 + (n - 2048)]; }
        LT[(size_t)n * 512 + k] = (bf16)(pk2(v, 0.f) & 0xffffu); }
}
template <bool FINAL> __device__ __forceinline__ void phase_ln(const Params& p, const Ctx& c, const float* gam, const float* bet) {
    const float* PRE = (const float*)(p.ws + WS_PRE); bf16* XB = (bf16*)(p.ws + WS_XB);
    f32x4 gv[8], bv[8];
#pragma unroll
    for (int j = 0; j < 8; ++j) { gv[j] = ((const f32x4*)gam)[c.lane + 64 * j]; bv[j] = ((const f32x4*)bet)[c.lane + 64 * j]; }
    for (int row = c.gw; row < MROWS; row += c.ngw) {
        float* yo = nullptr; if (FINAL) { yo = yrow_ptr(p, row); if (!yo) continue; }
        const f32x4* src = (const f32x4*)(PRE + (size_t)row * D); f32x4 v[8]; float s = 0.f;
#pragma unroll
        for (int j = 0; j < 8; ++j) { v[j] = src[c.lane + 64 * j]; s += (v[j][0] + v[j][1]) + (v[j][2] + v[j][3]); }
        const float mean = wave_sum(s) * (1.f / D); float q = 0.f;
#pragma unroll
        for (int j = 0; j < 8; ++j) { v[j] = v[j] - mean; q += (v[j][0] * v[j][0] + v[j][1] * v[j][1]) + (v[j][2] * v[j][2] + v[j][3] * v[j][3]); }
        const float rstd = 1.f / sqrtf(wave_sum(q) * (1.f / D) + LN_EPS);
#pragma unroll
        for (int j = 0; j < 8; ++j) { const f32x4 o = v[j] * rstd * gv[j] + bv[j];
            if (FINAL) ((f32x4*)yo)[c.lane + 64 * j] = o;
            else { u32x2 w; w.x = pk2(o[0], o[1]); w.y = pk2(o[2], o[3]); ((u32x2*)(XB + (size_t)row * D))[c.lane + 64 * j] = w; } }
    }
}
__device__ __forceinline__ void phase_prep1(const Params& p, const Ctx& c) {
    const bf16* PRW = (const bf16*)(p.ws + WS_PRW); const bf16* XBC = (const bf16*)(p.ws + WS_XBC); bf16* AL = (bf16*)(p.ws + WS_ALORA); const float* mu = PIN(I_MU);
    for (int row = c.gw; row < MROWS; row += c.ngw) {
        bf16* al = AL + (size_t)row * 512;
        if (row_is_pad(row)) {
#pragma unroll
            for (int i = 0; i < 8; ++i) al[c.lane + 64 * i] = 0; continue; }
        const bf16* cur = PRW + (size_t)row * PRW_LD; const bf16* prv = nullptr; const float* prvf = nullptr;
        if (row < MP) { if ((row % LP) != PADR) prv = cur - PRW_LD; }
        else { const int s = row - MP; if ((s & 15) != 0) prv = cur - PRW_LD; else prvf = PIN(I_SSH) + (size_t)(s >> 4) * SHC; }
#pragma unroll
        for (int i = 0; i < 7; ++i) { const int col = 3072 + c.lane + 64 * i; const float pc = bf2f(cur[col]); const float pp = prv ? bf2f(prv[col]) : (prvf ? prvf[col] : 0.f);
            const float ps = pc + (pp - pc) * mu[col]; const int lc = c.lane + 64 * i;
            if (lc < 96) al[lc] = (bf16)(pk2(tanhf(ps), 0.f) & 0xffffu);
            else if (lc < 192) al[lc] = (bf16)(pk2(ps, 0.f) & 0xffffu);
            else al[256 + (lc - 192)] = (bf16)(pk2(sigm(ps), 0.f) & 0xffffu); }
        al[192 + c.lane] = 0;
    }
    const int gt = blockIdx.x * 512 + c.tid, ngt = gridDim.x * 512;
    for (int i = gt; i < NB * SHC; i += ngt) { const int b = i / SHC, col = i - b * SHC; p.out[O_PSH + i] = bf2f(PRW[(size_t)(b * LP + LP - 1) * PRW_LD + col]); }
    for (int i = gt; i < SB * SHC; i += ngt) { const int b = i / SHC, col = i - b * SHC; p.out[O_SSH + i] = bf2f(PRW[(size_t)(MP + b * SS + SS - 1) * PRW_LD + col]); }
    for (int i = gt; i < NB * 3 * CONVD; i += ngt) { const int b = i / (3 * CONVD), r = (i / CONVD) % 3, col = i % CONVD; p.out[O_PCONV + i] = bf2f(XBC[(size_t)(b * LP + LP - 3 + r) * XBC_LD + col]); }
    for (int i = gt; i < SB * 3 * CONVD; i += ngt) { const int b = i / (3 * CONVD), r = (i / CONVD) % 3, col = i % CONVD; p.out[O_SCONV + i] = bf2f(XBC[(size_t)(MP + b * SS + SS - 3 + r) * XBC_LD + col]); }
}
__device__ __forceinline__ float sum16(float v) { v += __shfl_xor(v, 1); v += __shfl_xor(v, 2); v += __shfl_xor(v, 4); v += __shfl_xor(v, 8); return v; }
__device__ __forceinline__ void ld4bf(const bf16* ptr, float (&o)[4]) { const u32x2 w = *(const u32x2*)ptr; o[0] = bflo(w.x); o[1] = bfhi(w.x); o[2] = bflo(w.y); o[3] = bfhi(w.y); }
__device__ __forceinline__ void st4bf(bf16* ptr, const float (&v)[4]) { u32x2 w; w.x = pk2(v[0], v[1]); w.y = pk2(v[2], v[3]); *(u32x2*)ptr = w; }
__device__ __forceinline__ void shifted4(const bf16* cur, const bf16* prv, const float* prvf, int col, const float* mu, float (&o)[4]) {
    float pc[4], pp[4]; ld4bf(cur + col, pc);
    if (prv) ld4bf(prv + col, pp); else if (prvf) { const f32x4 t = *(const f32x4*)(prvf + col); pp[0] = t[0]; pp[1] = t[1]; pp[2] = t[2]; pp[3] = t[3]; } else { pp[0] = pp[1] = pp[2] = pp[3] = 0.f; }
    const f32x4 m = *(const f32x4*)(mu + col);
#pragma unroll
    for (int j = 0; j < 4; ++j) o[j] = pc[j] + (pp[j] - pc[j]) * m[j];
}
__device__ __forceinline__ void phase_prep2(const Params& p, const Ctx& c) {
    const bf16* PRW = (const bf16*)(p.ws + WS_PRW); bf16* R = (bf16*)(p.ws + WS_R); bf16* KP = (bf16*)(p.ws + WS_KP); bf16* V = (bf16*)(p.ws + WS_V); bf16* KK = (bf16*)(p.ws + WS_KK); bf16* BB = (bf16*)(p.ws + WS_BB);
    float* SBON = (float*)(p.ws + WS_SBON); const float* mu = PIN(I_MU);
    const int t4 = c.tid & 255, ch = 4 * t4, head = t4 >> 4;
    const f32x4 wkk = *(const f32x4*)(PIN(I_KK) + ch), wka = *(const f32x4*)(PIN(I_KA) + ch), wrk = *(const f32x4*)(PIN(I_RK) + ch);
    for (int row = blockIdx.x * 2 + (c.tid >> 8); row < MROWS; row += gridDim.x * 2) {
        if (row_is_pad(row)) continue;
        const bf16* cur = PRW + (size_t)row * PRW_LD; const bf16* prv = nullptr; const float* prvf = nullptr;
        if (row < MP) { if ((row % LP) != PADR) prv = cur - PRW_LD; }
        else { const int s = row - MP; if ((s & 15) != 0) prv = cur - PRW_LD; else prvf = PIN(I_SSH) + (size_t)(s >> 4) * SHC; }
        float r[4], k[4], v[4], a[4];
        shifted4(cur, prv, prvf, ch, mu, r); shifted4(cur, prv, prvf, 1024 + ch, mu, k); shifted4(cur, prv, prvf, 2048 + ch, mu, v);
        ld4bf(BB + (size_t)row * RWD + ch, a);
        float kk[4], ss = 0.f;
#pragma unroll
        for (int j = 0; j < 4; ++j) { kk[j] = k[j] * wkk[j]; ss += kk[j] * kk[j]; }
        ss = sum16(ss); const float inv = 1.f / fmaxf(sqrtf(ss), 1e-12f);
        float kp[4], bb[4], sb = 0.f;
#pragma unroll
        for (int j = 0; j < 4; ++j) { kk[j] *= inv; kp[j] = k[j] * (1.f + (a[j] - 1.f) * wka[j]); bb[j] = kk[j] * a[j]; sb += r[j] * kp[j] * wrk[j]; }
        sb = sum16(sb);
        const size_t o = (size_t)row * RWD + ch;
        st4bf(R + o, r); st4bf(KP + o, kp); st4bf(V + o, v); st4bf(KK + o, kk); st4bf(BB + o, bb);
        if ((t4 & 15) == 0) SBON[(size_t)row * RWH + head] = sb;
    }
}
__device__ __forceinline__ void phase_post(const Params& p, const Ctx& c) {
    const float* YRAW = p.out; const bf16* V = (const bf16*)(p.ws + WS_V); const bf16* G = (const bf16*)(p.ws + WS_GBUF); const float* SBON = (const float*)(p.ws + WS_SBON); bf16* YRW = (bf16*)(p.ws + WS_YRW);
    { const int t4 = c.tid & 255, ch = 4 * t4, head = t4 >> 4;
      const f32x4 gw = *(const f32x4*)(PIN(I_GNW) + ch), gb = *(const f32x4*)(PIN(I_GNB) + ch);
      for (int row = blockIdx.x * 2 + (c.tid >> 8); row < MROWS; row += gridDim.x * 2) {
        const size_t o = (size_t)row * RWD + ch;
        if (row_is_pad(row)) { u32x2 z; z.x = 0; z.y = 0; *(u32x2*)(YRW + o) = z; continue; }
        const f32x4 y = *(const f32x4*)(YRAW + o); float v[4], g[4]; ld4bf(V + o, v); ld4bf(G + o, g);
        const float mean = sum16((y[0] + y[1]) + (y[2] + y[3])) * (1.f / 64.f);
        float d[4], q = 0.f;
#pragma unroll
        for (int j = 0; j < 4; ++j) { d[j] = y[j] - mean; q += d[j] * d[j]; }
        const float rstd = 1.f / sqrtf(sum16(q) * (1.f / 64.f) + GN_EPS); const float sb = SBON[(size_t)row * RWH + head];
        float ov[4];
#pragma unroll
        for (int j = 0; j < 4; ++j) ov[j] = (d[j] * rstd * gw[j] + gb[j] + sb * v[j]) * g[j];
        st4bf(YRW + o, ov);
      } }
    { bf16* Z = (bf16*)(p.ws + WS_Z); const float* nw = PIN(I_NORMW);
      for (int it = c.gw; it < MROWS * 4; it += c.ngw) { const int row = it >> 2, g = it & 3; bf16* ptr = Z + (size_t)row * Z_LD + g * 512 + c.lane * 8;
        const u32x4 w = *(const u32x4*)ptr; float v[8] = {bflo(w.x), bfhi(w.x), bflo(w.y), bfhi(w.y), bflo(w.z), bfhi(w.z), bflo(w.w), bfhi(w.w)};
        float ss = 0.f;
#pragma unroll
        for (int j = 0; j < 8; ++j) ss += v[j] * v[j];
        const float rs = 1.f / sqrtf(wave_sum(ss) * (1.f / 512.f) + RMS_EPS);
        const f32x4 n0 = *(const f32x4*)(nw + g * 512 + c.lane * 8), n1 = *(const f32x4*)(nw + g * 512 + c.lane * 8 + 4);
        u32x4 o; o.x = pk2(v[0] * rs * n0[0], v[1] * rs * n0[1]); o.y = pk2(v[2] * rs * n0[2], v[3] * rs * n0[3]); o.z = pk2(v[4] * rs * n1[0], v[5] * rs * n1[1]); o.w = pk2(v[6] * rs * n1[2], v[7] * rs * n1[3]);
        *(u32x4*)ptr = o; } }
}

constexpr int SC_CH = 32;
constexpr int SC_BUF = 6 * SC_CH * 64 * 4;
__device__ __forceinline__ float dpp_sum8(float x) {
    x += __builtin_bit_cast(float, __builtin_amdgcn_update_dpp(0, __builtin_bit_cast(int, x), 0xB1, 0xF, 0xF, true));
    x += __builtin_bit_cast(float, __builtin_amdgcn_update_dpp(0, __builtin_bit_cast(int, x), 0x4E, 0xF, 0xF, true));
    x += __builtin_bit_cast(float, __builtin_amdgcn_update_dpp(0, __builtin_bit_cast(int, x), 0x141, 0xF, 0xF, true));
    return x;
}
__device__ __forceinline__ void scan_stage(const Params& p, const Ctx& c, LAS float* buf, int row0, int h, int steps, int lt  ) {
    const int i = lt >> 3, ch0 = (lt & 7) * 8;
    if (i < steps) {
        const size_t o = (size_t)(row0 + i) * RWD + h * 64 + ch0;
        const u32x4 wr = *(const u32x4*)((const bf16*)(p.ws + WS_R) + o), wk = *(const u32x4*)((const bf16*)(p.ws + WS_KP) + o), wv = *(const u32x4*)((const bf16*)(p.ws + WS_V) + o),
                    wkk = *(const u32x4*)((const bf16*)(p.ws + WS_KK) + o), wb = *(const u32x4*)((const bf16*)(p.ws + WS_BB) + o);
        const f32x4 d0 = *(const f32x4*)((const float*)(p.ws + WS_WDEC) + o), d1 = *(const f32x4*)((const float*)(p.ws + WS_WDEC) + o + 4);
        LAS f32x4* dst = (LAS f32x4*)(buf + i * 64 + ch0);
#define SC_PUT(arr, V_) do { dst[(arr) * (SC_CH * 16)] = (f32x4){bflo(V_.x), bfhi(V_.x), bflo(V_.y), bfhi(V_.y)}; dst[(arr) * (SC_CH * 16) + 1] = (f32x4){bflo(V_.z), bfhi(V_.z), bflo(V_[3]), bfhi(V_[3])}; } while (0)
        SC_PUT(0, wr); dst[1 * (SC_CH * 16)] = d0; dst[1 * (SC_CH * 16) + 1] = d1; SC_PUT(2, wk); SC_PUT(3, wkk); SC_PUT(4, wb); SC_PUT(5, wv);
#undef SC_PUT
    }
}
__device__ __forceinline__ void rwkv_scan_unit(const Params& p, const Ctx& c, int s, int h, int hf) {
    const bool prompt = s < NB; const int row_base = prompt ? s * LP + PADR : MP + (s - NB) * SS; const int T = prompt ? TP : SS;
    const int nch = (T + SC_CH - 1) / SC_CH;
    LAS float* buf0 = (LAS float*)c.lds; LAS float* buf1 = (LAS float*)(c.lds + SC_BUF);
    const bool comp = c.wave < 4; const int lane = c.lane, ks = lane & 7, vrow = 32 * hf + 8 * (c.wave & 3) + (lane >> 3);
    float S[8];
#pragma unroll
    for (int j = 0; j < 8; ++j) S[j] = 0.f;
    if (comp && !prompt) { const float* st = PIN(I_SWKV) + (((size_t)(s - NB) * RWH + h) * 64 + vrow) * 64 + ks * 8;
        const f32x4 a = *(const f32x4*)st, b = *(const f32x4*)(st + 4); S[0] = a[0]; S[1] = a[1]; S[2] = a[2]; S[3] = a[3]; S[4] = b[0]; S[5] = b[1]; S[6] = b[2]; S[7] = b[3]; }
    __syncthreads();
    scan_stage(p, c, buf0, row_base, h, T < SC_CH ? T : SC_CH, c.tid & 255);
    __syncthreads();
    float* yout = p.out;
    for (int cix = 0; cix < nch; ++cix) {
        LAS float* cur = (cix & 1) ? buf1 : buf0; LAS float* nxt = (cix & 1) ? buf0 : buf1;
        const int t0 = cix * SC_CH; const int steps = (T - t0) < SC_CH ? (T - t0) : SC_CH;
        if (!comp) { if (cix + 1 < nch) { const int t1 = t0 + SC_CH; scan_stage(p, c, nxt, row_base + t1, h, (T - t1) < SC_CH ? (T - t1) : SC_CH, c.tid - 256); } }
        else {
            const LAS float* bR = cur + ks * 8;
            f32x4 r0, r1, w0, w1, k0, k1, q0, q1, b0, b1; float vv;
#define SC_LOAD(i) do { const LAS float* bp = bR + (i) * 64; r0 = *(const LAS f32x4*)bp; r1 = *(const LAS f32x4*)(bp + 4); w0 = *(const LAS f32x4*)(bp + SC_CH * 64); w1 = *(const LAS f32x4*)(bp + SC_CH * 64 + 4); \
        k0 = *(const LAS f32x4*)(bp + 2 * SC_CH * 64); k1 = *(const LAS f32x4*)(bp + 2 * SC_CH * 64 + 4); q0 = *(const LAS f32x4*)(bp + 3 * SC_CH * 64); q1 = *(const LAS f32x4*)(bp + 3 * SC_CH * 64 + 4); \
        b0 = *(const LAS f32x4*)(bp + 4 * SC_CH * 64); b1 = *(const LAS f32x4*)(bp + 4 * SC_CH * 64 + 4); vv = cur[5 * SC_CH * 64 + (i) * 64 + vrow]; } while (0)
            SC_LOAD(0);
            for (int i = 0; i < steps; ++i) {
                const f32x4 cr0 = r0, cr1 = r1, cw0 = w0, cw1 = w1, ck0 = k0, ck1 = k1, cq0 = q0, cq1 = q1, cb0 = b0, cb1 = b1; const float cv = vv;
                const int in = (i + 1 < steps) ? i + 1 : i; SC_LOAD(in);
                float pa = S[0] * cq0[0] + S[1] * cq0[1], pb = S[2] * cq0[2] + S[3] * cq0[3]; pa += S[4] * cq1[0] + S[5] * cq1[1]; pb += S[6] * cq1[2] + S[7] * cq1[3];
                const float sa = -dpp_sum8(pa + pb);
                S[0] = S[0] * cw0[0] + (sa * cb0[0] + cv * ck0[0]); S[1] = S[1] * cw0[1] + (sa * cb0[1] + cv * ck0[1]); S[2] = S[2] * cw0[2] + (sa * cb0[2] + cv * ck0[2]); S[3] = S[3] * cw0[3] + (sa * cb0[3] + cv * ck0[3]);
                S[4] = S[4] * cw1[0] + (sa * cb1[0] + cv * ck1[0]); S[5] = S[5] * cw1[1] + (sa * cb1[1] + cv * ck1[1]); S[6] = S[6] * cw1[2] + (sa * cb1[2] + cv * ck1[2]); S[7] = S[7] * cw1[3] + (sa * cb1[3] + cv * ck1[3]);
                float ya = S[0] * cr0[0] + S[1] * cr0[1], yb = S[2] * cr0[2] + S[3] * cr0[3]; ya += S[4] * cr1[0] + S[5] * cr1[1]; yb += S[6] * cr1[2] + S[7] * cr1[3];
                const float y = dpp_sum8(ya + yb);
                if (ks == 0) yout[(size_t)(row_base + t0 + i) * RWD + h * 64 + vrow] = y;
            }
#undef SC_LOAD
        }
        __syncthreads();
    }
    if (comp) { float* so = p.out + (prompt ? O_PWKV + (((size_t)s * RWH + h) * 64 + vrow) * 64 : O_SWKV + (((size_t)(s - NB) * RWH + h) * 64 + vrow) * 64) + ks * 8;
        *(f32x4*)so = (f32x4){S[0], S[1], S[2], S[3]}; *(f32x4*)(so + 4) = (f32x4){S[4], S[5], S[6], S[7]}; }
}

constexpr int SD_RAW = 0, SD_G = 0, SD_CM = 43008, SD_BM = 60416, SD_HB = 77824, SD_BT = 95232, SD_XT = 113664, SD_XD = 122880, SD_XC = 132096, SD_DT = 141312, SD_ACS = 141568;
constexpr int RAW_LD = 320, CM_LD = 136, BT_LD = 72, XT_LD = 72;
__device__ __forceinline__ f32x4 mfma16(bf16x8 a, bf16x8 b, f32x4 c) { return __builtin_amdgcn_mfma_f32_16x16x32_bf16(a, b, c, 0, 0, 0); }
__device__ __forceinline__ void ssd_unit(const Params& p, const Ctx& c, int s, int hd) {
    const bool prompt = s < NB; const int row_base = prompt ? s * LP : MP + (s - NB) * SS; const int nchunks = prompt ? LP / 64 : 1; const int g = hd >> 3;
    const int tid = c.tid, lane = c.lane, w = c.wave, fr = lane & 15, fq = lane >> 4;
    const bf16* XBC = (const bf16*)(p.ws + WS_XBC); const bf16* PRW = (const bf16*)(p.ws + WS_PRW); bf16* Z = (bf16*)(p.ws + WS_Z);
    LAS bf16* RAW = (LAS bf16*)(c.lds + SD_RAW); LAS bf16* Gm = (LAS bf16*)(c.lds + SD_G); LAS bf16* CM = (LAS bf16*)(c.lds + SD_CM); LAS bf16* BM = (LAS bf16*)(c.lds + SD_BM); LAS bf16* HB = (LAS bf16*)(c.lds + SD_HB);
    LAS bf16* BT = (LAS bf16*)(c.lds + SD_BT); LAS bf16* XT = (LAS bf16*)(c.lds + SD_XT); LAS bf16* XD = (LAS bf16*)(c.lds + SD_XD); LAS bf16* XC = (LAS bf16*)(c.lds + SD_XC);
    LAS float* DT = (LAS float*)(c.lds + SD_DT); LAS float* ACS = (LAS float*)(c.lds + SD_ACS);
    const float* convw = PIN(I_CONVW); const float* convb = PIN(I_CONVB);
    const int xp = tid & 63, xch = hd * 64 + xp; float xw[4], xb = convb[xch];
#pragma unroll
    for (int i = 0; i < 4; ++i) xw[i] = convw[i * CONVD + xch];
    const int bn = tid & 127, bch = 2048 + g * 128 + bn, cch = 2560 + g * 128 + bn; float bw[4], cw[4], bb = convb[bch], cb = convb[cch];
#pragma unroll
    for (int i = 0; i < 4; ++i) { bw[i] = convw[i * CONVD + bch]; cw[i] = convw[i * CONVD + cch]; }
    const float dtb = PIN(I_DTB)[hd], aneg = -__expf(PIN(I_ALOG)[hd]), dsk = PIN(I_DSKIP)[hd];
    const int hpt = w & 3, hnt0 = (w >> 2) * 4;
    f32x4 hacc[4];
#pragma unroll
    for (int j = 0; j < 4; ++j) hacc[j] = (f32x4){0.f, 0.f, 0.f, 0.f};
    if (!prompt) { const float* st = PIN(I_SSSM) + ((size_t)(s - NB) * SSMH + hd) * 64 * 128;
#pragma unroll
        for (int j = 0; j < 4; ++j)
#pragma unroll
            for (int r = 0; r < 4; ++r) hacc[j][r] = st[(size_t)(hpt * 16 + fq * 4 + r) * 128 + (hnt0 + j) * 16 + fr]; }
    const int yit = w >> 1, ypt0 = (w & 1) * 2;
    __syncthreads();
    for (int cix = 0; cix < nchunks; ++cix) {
        for (int idx = tid; idx < 67 * 40; idx += 512) { const int rr = idx / 40, cc = idx - rr * 40; const int q = cix * 64 + rr - 3;
            const int col = cc < 8 ? hd * 64 + cc * 8 : (cc < 24 ? 2048 + g * 128 + (cc - 8) * 8 : 2560 + g * 128 + (cc - 24) * 8);
            u32x4 v = (u32x4){0u, 0u, 0u, 0u};
            if (prompt) { if (q >= PADR) v = *(const u32x4*)(XBC + (size_t)(row_base + q) * XBC_LD + col); }
            else { if (q >= 0 && q < SS) v = *(const u32x4*)(XBC + (size_t)(row_base + q) * XBC_LD + col);
                   else if (q < 0) { const float* hs = PIN(I_SCONV) + ((size_t)(s - NB) * 3 + (3 + q)) * CONVD + col; const f32x4 a = *(const f32x4*)hs, b = *(const f32x4*)(hs + 4);
                       v.x = pk2(a[0], a[1]); v.y = pk2(a[2], a[3]); v.z = pk2(b[0], b[1]); v.w = pk2(b[2], b[3]); } }
            *(LAS u32x4*)(RAW + rr * RAW_LD + cc * 8) = v; }
        if (w == 0) { const int q = cix * 64 + lane; const bool valid = prompt ? (q >= PADR) : (q < SS);
            float dtv = 0.f; if (valid) dtv = softplus_(bf2f(PRW[(size_t)(row_base + q) * PRW_LD + SHC + hd]) + dtb);
            float a = dtv * aneg;
#pragma unroll
            for (int o = 1; o < 64; o <<= 1) { const float t = __shfl_up(a, o); if (lane >= o) a += t; }
            DT[lane] = dtv; ACS[lane] = a; }
#pragma unroll
        for (int j = 0; j < 4; ++j)
#pragma unroll
            for (int r = 0; r < 4; ++r) HB[(hpt * 16 + fq * 4 + r) * CM_LD + (hnt0 + j) * 16 + fr] = (bf16)(pk2(hacc[j][r], 0.f) & 0xffffu);
        __syncthreads();
        const float acs_end = ACS[63];
#pragma unroll 2
        for (int i = 0; i < 8; ++i) { const int t = (tid >> 6) + 8 * i; const int q = cix * 64 + t; const bool valid = prompt ? (q >= PADR) : (q < SS);
            float a = xb;
#pragma unroll
            for (int k = 0; k < 4; ++k) a += bf2f(RAW[(t + k) * RAW_LD + xp]) * xw[k];
            a = valid ? silu_(a) : 0.f; const float xdt = a * DT[t];
            XC[t * XT_LD + xp] = (bf16)(pk2(a, 0.f) & 0xffffu); XT[xp * XT_LD + t] = (bf16)(pk2(xdt, 0.f) & 0xffffu); XD[xp * XT_LD + t] = (bf16)(pk2(xdt * __expf(acs_end - ACS[t]), 0.f) & 0xffffu); }
#pragma unroll 2
        for (int i = 0; i < 16; ++i) { const int t = (tid >> 7) + 4 * i; const int q = cix * 64 + t; const bool valid = prompt ? (q >= PADR) : (q < SS);
            float a = bb, b = cb;
#pragma unroll
            for (int k = 0; k < 4; ++k) { a += bf2f(RAW[(t + k) * RAW_LD + 64 + bn]) * bw[k]; b += bf2f(RAW[(t + k) * RAW_LD + 192 + bn]) * cw[k]; }
            a = valid ? silu_(a) : 0.f; b = valid ? silu_(b) : 0.f;
            const bf16 ab = (bf16)(pk2(a, 0.f) & 0xffffu); BM[t * CM_LD + bn] = ab; BT[bn * BT_LD + t] = ab; CM[t * CM_LD + bn] = (bf16)(pk2(b, 0.f) & 0xffffu); }
        __syncthreads();
        f32x4 yacc[2];
        { f32x4 cbacc[2] = {(f32x4){0.f, 0.f, 0.f, 0.f}, (f32x4){0.f, 0.f, 0.f, 0.f}}; yacc[0] = cbacc[0]; yacc[1] = cbacc[0];
#pragma unroll
          for (int kk = 0; kk < 4; ++kk) { const bf16x8 af = *(const LAS bf16x8*)(CM + (yit * 16 + fr) * CM_LD + kk * 32 + fq * 8);
#pragma unroll
              for (int j = 0; j < 2; ++j) { const bf16x8 bfm = *(const LAS bf16x8*)(BM + ((ypt0 + j) * 16 + fr) * CM_LD + kk * 32 + fq * 8); cbacc[j] = mfma16(af, bfm, cbacc[j]);
                  const bf16x8 hf = *(const LAS bf16x8*)(HB + ((ypt0 + j) * 16 + fr) * CM_LD + kk * 32 + fq * 8); yacc[j] = mfma16(af, hf, yacc[j]); } }
#pragma unroll
          for (int j = 0; j < 2; ++j)
#pragma unroll
              for (int r = 0; r < 4; ++r) { const int i = yit * 16 + fq * 4 + r, jj = (ypt0 + j) * 16 + fr; const float ai = ACS[i];
                  const float gv = (jj <= i) ? cbacc[j][r] * __expf(ai - ACS[jj]) : 0.f; Gm[i * XT_LD + jj] = (bf16)(pk2(gv, 0.f) & 0xffffu);
                  yacc[j][r] *= __expf(ai); } }
        { const float cd = __expf(acs_end);
#pragma unroll
          for (int j = 0; j < 4; ++j) hacc[j] = hacc[j] * cd;
#pragma unroll
          for (int kk = 0; kk < 2; ++kk) { const bf16x8 af = *(const LAS bf16x8*)(XD + (hpt * 16 + fr) * XT_LD + kk * 32 + fq * 8);
#pragma unroll
              for (int j = 0; j < 4; ++j) { const bf16x8 bfm = *(const LAS bf16x8*)(BT + ((hnt0 + j) * 16 + fr) * BT_LD + kk * 32 + fq * 8); hacc[j] = mfma16(af, bfm, hacc[j]); } } }
        __syncthreads();
#pragma unroll
        for (int kk = 0; kk < 2; ++kk) { const bf16x8 af = *(const LAS bf16x8*)(Gm + (yit * 16 + fr) * XT_LD + kk * 32 + fq * 8);
#pragma unroll
            for (int j = 0; j < 2; ++j) { const bf16x8 bfm = *(const LAS bf16x8*)(XT + ((ypt0 + j) * 16 + fr) * XT_LD + kk * 32 + fq * 8); yacc[j] = mfma16(af, bfm, yacc[j]); } }
#pragma unroll
        for (int j = 0; j < 2; ++j)
#pragma unroll
            for (int r = 0; r < 4; ++r) { const int i = yit * 16 + fq * 4 + r, pp = (ypt0 + j) * 16 + fr; const int q = cix * 64 + i;
                if (prompt || q < SS) { bf16* zp = Z + (size_t)(row_base + q) * Z_LD + hd * 64 + pp;
                    const float yv = (yacc[j][r] + bf2f(XC[i * XT_LD + pp]) * dsk) * bf2f(*zp); *zp = (bf16)(pk2(yv, 0.f) & 0xffffu); } }
        __syncthreads();
    }
    { float* so = p.out + (prompt ? O_PSSM + ((size_t)s * SSMH + hd) * 64 * 128 : O_SSSM + ((size_t)(s - NB) * SSMH + hd) * 64 * 128);
#pragma unroll
      for (int j = 0; j < 4; ++j)
#pragma unroll
          for (int r = 0; r < 4; ++r) so[(size_t)(hpt * 16 + fq * 4 + r) * 128 + (hnt0 + j) * 16 + fr] = hacc[j][r]; }
}
__device__ __forceinline__ void phase_mixers(const Params& p, const Ctx& c) {
    for (int u = blockIdx.x; u < 1280; u += gridDim.x) {
        int kind, s, h, hf = 0;
        if (u < 128) { kind = 0; s = (u >> 1) / RWH; h = (u >> 1) % RWH; hf = u & 1; }
        else if (u < 256) { kind = 1; s = (u - 128) / SSMH; h = (u - 128) % SSMH; }
        else if (u < 768) { const int v = u - 256; kind = 0; s = NB + (v >> 1) / RWH; h = (v >> 1) % RWH; hf = v & 1; }
        else { const int v = u - 768; kind = 1; s = NB + v / SSMH; h = v % SSMH; }
        if (kind == 0) rwkv_scan_unit(p, c, s, h, hf); else ssd_unit(p, c, s, h);
    }
}

__device__ __forceinline__ bool setup_gemm(const Params& p, int ph, pg8::Gemm& g, pg8::EpiGen& E) {
    unsigned char* ws = p.ws;
    E.o0 = nullptr; E.o1 = nullptr; E.o2 = nullptr; E.i0 = nullptr; E.i1 = nullptr; E.f0 = nullptr; E.f1 = nullptr; E.alpha = 0.f; E.scale = 0.f; E.mode = 0; E.PERM = false;
    switch (ph) {
    case 1: case 14: g.A = (const bf16*)(ws + WS_XB); g.Bt = (const bf16*)(ws + WS_GUT); g.M = MROWS; g.N = 2 * FF; g.K = D; E.mode = pg8::EM_SWIGLU; E.PERM = true; E.o0 = ws + WS_ACT; return true;
    case 2: case 15: g.A = (const bf16*)(ws + WS_ACT); g.Bt = (const bf16*)(ws + WS_DNT); g.M = MROWS; g.N = D; g.K = FF; E.mode = pg8::EM_RESID; E.o0 = ws + WS_PRE; E.i0 = ws + WS_XB; E.alpha = ALPHA; E.scale = 0.5f; return true;
    case 4: g.A = (const bf16*)(ws + WS_XB); g.Bt = (const bf16*)(ws + WS_WINT); g.M = MROWS; g.N = NINP; g.K = D; E.mode = pg8::EM_WIN; E.PERM = true; E.o0 = ws + WS_PRW; E.f0 = PIN(I_BGATE); return true;
    case 6: g.A = (const bf16*)(ws + WS_ALORA); g.Bt = (const bf16*)(ws + WS_LORAT); g.M = MROWS; g.N = 3072; g.K = 512; E.mode = pg8::EM_LORA; E.o0 = ws + WS_WDEC; E.o1 = ws + WS_BB; E.o2 = ws + WS_GBUF; E.f0 = PIN(I_W0); E.f1 = PIN(I_A0); return true;
    case 10: g.A = (const bf16*)(ws + WS_YRW); g.Bt = (const bf16*)(ws + WS_RWOT); g.M = MROWS; g.N = D; g.K = RWD; E.mode = pg8::EM_M1; E.o0 = ws + WS_T1; E.i0 = ws + WS_GATE; return true;
    case 11: g.A = (const bf16*)(ws + WS_Z); g.Bt = (const bf16*)(ws + WS_SSMOT); g.M = MROWS; g.N = D; g.K = D; E.mode = pg8::EM_M2; E.PERM = true; E.o0 = ws + WS_MERGED; E.i0 = ws + WS_GATE; E.i1 = ws + WS_T1; return true;
    case 12: g.A = (const bf16*)(ws + WS_MERGED); g.Bt = (const bf16*)(ws + WS_WOT); g.M = MROWS; g.N = D; g.K = D; E.mode = pg8::EM_RESID; E.o0 = ws + WS_PRE; E.i0 = ws + WS_XB; E.alpha = ALPHA; E.scale = 1.0f; return true;
    default: return false;
    }
}

template <int PH> __device__ __forceinline__ void run_gemm(const Params& p, const Ctx& c) {
    pg8::Gemm g; pg8::EpiGen E; setup_gemm(p, PH, g, E);
    pg8::StaticOrder S; S.init(g.M, g.N, (int)gridDim.x, (int)blockIdx.x);
    pg8::gemm_phase<pg8::EpiGen, pg8::StaticOrder, true, true>(c.lds, g, S, E);
}
__global__ void __launch_bounds__(512, 2) mega_fwd(Params p) {
    extern __shared__ __attribute__((aligned(16))) unsigned char lds_raw[];
    const int lo = p.ph_lo, hi = p.ph_hi;
#define MKCTX Ctx c; { int t_ = threadIdx.x; asm volatile("" : "+v"(t_)); c.tid = t_; c.lane = t_ & 63; c.wave = __builtin_amdgcn_readfirstlane(t_ >> 6); c.gw = blockIdx.x * 8 + c.wave; c.ngw = gridDim.x * 8; c.lds = (LAS unsigned char*)lds_raw; }
#define IN(k) (lo <= (k) && (k) < hi)
#define SEAM(k) do { if (lo <= (k) && (k) + 1 < hi) cg::this_grid().sync(); } while (0)
#if !defined(EXP_SKIP_0)
    if (IN(0)) { MKCTX
        phase_convert_x(p, c);
        transpose_w(PIN(I_GU1), D, 2 * FF, (bf16*)(p.ws + WS_GUT), 2 * FF, MAP_GU, c);
        transpose_w(PIN(I_DN1), FF, D, (bf16*)(p.ws + WS_DNT), D, MAP_ID, c);
        transpose_w(PIN(I_RWO), RWD, D, (bf16*)(p.ws + WS_RWOT), D, MAP_ID, c);
        transpose_w(PIN(I_SSMO), D, D, (bf16*)(p.ws + WS_SSMOT), D, MAP_ID, c);
        transpose_w(PIN(I_WO), D, D, (bf16*)(p.ws + WS_WOT), D, MAP_ID, c);
        build_lorat(p, c);
    }
#endif
    SEAM(0);
    if (IN(1)) { MKCTX run_gemm<1>(p, c); }
    SEAM(1);
    if (IN(2)) { MKCTX run_gemm<2>(p, c); }
    SEAM(2);
#if !defined(EXP_SKIP_3)
    if (IN(3)) { MKCTX phase_ln<false>(p, c, PIN(I_LN1G), PIN(I_LN1B)); transpose_w(PIN(I_WIN), D, 12768, (bf16*)(p.ws + WS_WINT), NINP, MAP_WIN, c); }
#endif
    SEAM(3);
    if (IN(4)) { MKCTX run_gemm<4>(p, c); }
    SEAM(4);
#if !defined(EXP_SKIP_5)
    if (IN(5)) { MKCTX phase_prep1(p, c); }
#endif
    SEAM(5);
    if (IN(6)) { MKCTX run_gemm<6>(p, c); }
    SEAM(6);
#if !defined(EXP_SKIP_7)
    if (IN(7)) { MKCTX phase_prep2(p, c); }
#endif
    SEAM(7);
#if !defined(EXP_SKIP_8)
    if (IN(8)) { MKCTX phase_mixers(p, c); }
#endif
    SEAM(8);
#if !defined(EXP_SKIP_9)
    if (IN(9)) { MKCTX phase_post(p, c); }
#endif
    SEAM(9);
    if (IN(10)) { MKCTX run_gemm<10>(p, c); }
    SEAM(10);
    if (IN(11)) { MKCTX run_gemm<11>(p, c); }
    SEAM(11);
    if (IN(12)) { MKCTX run_gemm<12>(p, c); }
    SEAM(12);
#if !defined(EXP_SKIP_13)
    if (IN(13)) { MKCTX phase_ln<false>(p, c, PIN(I_LN2G), PIN(I_LN2B)); transpose_w(PIN(I_GU2), D, 2 * FF, (bf16*)(p.ws + WS_GUT), 2 * FF, MAP_GU, c); transpose_w(PIN(I_DN2), FF, D, (bf16*)(p.ws + WS_DNT), D, MAP_ID, c); }
#endif
    SEAM(13);
    if (IN(14)) { MKCTX run_gemm<14>(p, c); }
    SEAM(14);
    if (IN(15)) { MKCTX run_gemm<15>(p, c); }
    SEAM(15);
#if !defined(EXP_SKIP_16)
    if (IN(16)) { MKCTX phase_ln<true>(p, c, PIN(I_LN3G), PIN(I_LN3B)); }
#endif
#undef IN
#undef MKCTX
#undef SEAM
}

extern "C" void kernel_launch(void* const* d_in, const int* in_sizes, int n_in, void* d_out, int out_size, void* d_ws, size_t ws_size, hipStream_t stream) {
    static int grid = 0;
    if (!grid) {
        if (n_in != N_IN || (size_t)out_size != O_END || ws_size < WS_END) { fprintf(stderr, "kernel_launch: unexpected shapes (n_in %d, out %d, ws %zu)\n", n_in, out_size, ws_size); grid = -1; return; }
        int dev = 0, cus = 0, per_cu = 0;
        hipGetDevice(&dev); hipDeviceGetAttribute(&cus, hipDeviceAttributeMultiprocessorCount, dev);
        hipFuncSetAttribute((const void*)mega_fwd, hipFuncAttributeMaxDynamicSharedMemorySize, LDS_BYTES);
        hipOccupancyMaxActiveBlocksPerMultiprocessor(&per_cu, (const void*)mega_fwd, 512, LDS_BYTES);
        if (per_cu < 1) { fprintf(stderr, "kernel_launch: occupancy query says %d blocks per CU\n", per_cu); per_cu = 1; }
        grid = cus;
    }
    if (grid < 0) return;
    Params p{};
    for (int i = 0; i < N_IN; ++i) p.in[i] = (const float*)d_in[i];
    p.out = (float*)d_out; p.ws = (unsigned char*)d_ws;
#if MK_SINGLE_LAUNCH
    p.ph_lo = 0; p.ph_hi = NPHASE;
    void* args[] = {&p};
    hipError_t e = hipLaunchCooperativeKernel((const void*)mega_fwd, dim3(grid), dim3(512), args, LDS_BYTES, stream);
    if (e != hipSuccess) fprintf(stderr, "cooperative launch failed: %s (grid %d)\n", hipGetErrorString(e), grid);
#else
    for (int ph = 0; ph < NPHASE; ++ph) { p.ph_lo = ph; p.ph_hi = ph + 1; hipLaunchKernelGGL(mega_fwd, dim3(grid), dim3(512), LDS_BYTES, stream, p); }
#endif
}
```

```cpp
#include <hip/hip_runtime.h>
#include <hip/hip_cooperative_groups.h>
#include <cstdio>
#include <cstdint>
namespace cg = cooperative_groups;

#ifndef MK_SINGLE_LAUNCH
#define MK_SINGLE_LAUNCH 1
#endif

namespace pg8 {
#define PG8_LAS __attribute__((address_space(3)))
typedef unsigned short bf16_t;
typedef short bf16x8 __attribute__((ext_vector_type(8)));
typedef float f32x4 __attribute__((ext_vector_type(4)));
typedef unsigned u32x4 __attribute__((ext_vector_type(4)));
constexpr int BM = 256, BK = 64, HALF = 128, HTB = HALF * BK * 2  , STAGE_BYTES = 8 * HTB, NXCD = 8, WGM = 8;

__host__ __device__ __forceinline__ int lds_byte(int r, int c) { const int st = (r >> 4) * 2 + (c >> 5), rr = r & 15, cc = c & 31, ob = rr * 64 + cc * 2; return st * 1024 + (ob ^ (((ob >> 9) & 1) << 5)); }
__host__ __device__ __forceinline__ void stage_rc(int b, int& R, int& C) { const int st = b / 1024, sb = b % 1024, swz = sb ^ (((sb >> 9) & 1) << 5); R = (st >> 1) * 16 + swz / 64; C = (st & 1) * 32 + (swz % 64) / 2; }
__host__ __device__ __forceinline__ int perm32(int rho) { const int n = rho >> 4, i = rho & 15; return 8 * (i >> 2) + 4 * n + (i & 3); }

struct Unit { int pm, pn; };
struct Gemm { const bf16_t* A; const bf16_t* Bt; int M, N, K; };

struct StaticOrder {
    int nM, nN, nwg, G, c;
    __host__ __device__ void init(int M, int N, int G_, int c_) { nM = M / BM; nN = N / BM; nwg = nM * nN; G = G_; c = c_; }
    __host__ __device__ bool next(int i, Unit& u) const {
        const long L = (long)i * G + c; if (L >= nwg) return false;
        int wgid = (int)L; { const int q = nwg / NXCD, r = nwg % NXCD, xcd = wgid % NXCD, off = wgid / NXCD; wgid = (xcd < r ? xcd * (q + 1) : r * (q + 1) + (xcd - r) * q) + off; }
        const int nig = WGM * nN, gid = wgid / nig, fm = gid * WGM, gsz = (nM - fm) < WGM ? (nM - fm) : WGM;
        u.pm = fm + ((wgid % nig) % gsz); u.pn = (wgid % nig) / gsz; return true;
    }
    __device__ __forceinline__ void a_ready(const Unit&) const {}
    __device__ __forceinline__ void done(const Unit&) const {}
};

__device__ __forceinline__ unsigned cvt_pk_bf16(float lo, float hi) { unsigned r; asm volatile("v_cvt_pk_bf16_f32 %0, %1, %2" : "=v"(r) : "v"(lo), "v"(hi)); return r; }

__device__ __forceinline__ float bf2f(unsigned short h) { return __uint_as_float(((unsigned)h) << 16); }
__device__ __forceinline__ float bflo(unsigned w) { return __uint_as_float(w << 16); }
__device__ __forceinline__ float bfhi(unsigned w) { return __uint_as_float(w & 0xffff0000u); }
__device__ __forceinline__ float sigm(float x) { return 1.0f / (1.0f + __expf(-x)); }
__device__ __forceinline__ float silu_(float x) { return x / (1.0f + __expf(-x)); }
typedef unsigned u32x2 __attribute__((ext_vector_type(2)));

enum { EM_SWIGLU = 0, EM_RESID = 1, EM_WIN = 2, EM_LORA = 3, EM_M1 = 4, EM_M2 = 5 };
struct EpiGen {
    static constexpr bool AFTER_DRAIN = false;
    int mode; bool PERM;
    void* o0; void* o1; void* o2; const void* i0; const void* i1; const float* f0; const float* f1;
    float alpha, scale;
    __device__ __forceinline__ void operator()(const f32x4 (&acc)[2][2][4][2], const Unit& u, int wr, int wc, int fr, int fq) const {
        const int row0 = u.pm * BM + wr * 64 + fr;
        if (mode == EM_SWIGLU) {
            bf16_t* O = (bf16_t*)o0; const int col0 = u.pn * 128 + wc * 32 + 8 * fq;
#pragma unroll
            for (int ai = 0; ai < 2; ++ai)
#pragma unroll
                for (int m = 0; m < 4; ++m) { bf16_t* rowp = O + (size_t)(row0 + ai * HALF + m * 16) * 5632 + col0;
                    const f32x4 g0 = acc[ai][0][m][0], g1 = acc[ai][0][m][1], u0 = acc[ai][1][m][0], u1 = acc[ai][1][m][1];
                    f32x4 v0, v1;
#pragma unroll
                    for (int j = 0; j < 4; ++j) { v0[j] = silu_(g0[j]) * u0[j]; v1[j] = silu_(g1[j]) * u1[j]; }
                    u32x4 w; w.x = cvt_pk_bf16(v0[0], v0[1]); w.y = cvt_pk_bf16(v0[2], v0[3]); w.z = cvt_pk_bf16(v1[0], v1[1]); w.w = cvt_pk_bf16(v1[2], v1[3]);
                    *(u32x4*)rowp = w; }
        } else if (mode == EM_RESID) {
            float* C = (float*)o0; const bf16_t* R = (const bf16_t*)i0; const int col0 = u.pn * BM + wc * 32 + 4 * fq;
#pragma unroll
            for (int ai = 0; ai < 2; ++ai)
#pragma unroll
                for (int m = 0; m < 4; ++m) { const size_t off = (size_t)(row0 + ai * HALF + m * 16) * 2048 + col0;
#pragma unroll
                    for (int bj = 0; bj < 2; ++bj)
#pragma unroll
                        for (int n = 0; n < 2; ++n) { const u32x2 rv = *(const u32x2*)(R + off + bj * HALF + n * 16);
                            f32x4 o; o[0] = alpha * bflo(rv.x) + scale * acc[ai][bj][m][n][0]; o[1] = alpha * bfhi(rv.x) + scale * acc[ai][bj][m][n][1];
                            o[2] = alpha * bflo(rv.y) + scale * acc[ai][bj][m][n][2]; o[3] = alpha * bfhi(rv.y) + scale * acc[ai][bj][m][n][3];
                            *(f32x4*)(C + off + bj * HALF + n * 16) = o; } }
        } else if (mode == EM_WIN) {
            const int pn = u.pn; bf16_t* O; int ld, colt, act;
            if (pn < 14) { O = (bf16_t*)o0; ld = 3584; colt = pn * BM; act = 0; }
            else if (pn < 22) { O = (bf16_t*)o0 + (size_t)8704 * 3584; ld = 2048; colt = (pn - 14) * BM; act = 1; }
            else if (pn < 34) { O = (bf16_t*)o0 + (size_t)8704 * (3584 + 2048); ld = 3072; colt = (pn - 22) * BM; act = 0; }
            else { O = (bf16_t*)o0 + (size_t)8704 * (3584 + 2048 + 3072); ld = 4096; colt = (pn - 34) * BM; act = 2; }
            const int col0 = colt + wc * 32 + 8 * fq;
            f32x4 bv[2][2];
#pragma unroll
            for (int bj = 0; bj < 2; ++bj)
#pragma unroll
                for (int n = 0; n < 2; ++n) bv[bj][n] = (act == 2) ? *(const f32x4*)(f0 + col0 + bj * HALF + 4 * n) : (f32x4){0.f, 0.f, 0.f, 0.f};
#pragma unroll
            for (int ai = 0; ai < 2; ++ai)
#pragma unroll
                for (int m = 0; m < 4; ++m) { bf16_t* rowp = O + (size_t)(row0 + ai * HALF + m * 16) * ld + col0;
#pragma unroll
                    for (int bj = 0; bj < 2; ++bj) { f32x4 v0 = acc[ai][bj][m][0] + bv[bj][0], v1 = acc[ai][bj][m][1] + bv[bj][1];
                        if (act == 1) {
#pragma unroll
                            for (int j = 0; j < 4; ++j) { v0[j] = silu_(v0[j]); v1[j] = silu_(v1[j]); } }
                        else if (act == 2) {
#pragma unroll
                            for (int j = 0; j < 4; ++j) { v0[j] = sigm(v0[j]); v1[j] = sigm(v1[j]); } }
                        u32x4 w; w.x = cvt_pk_bf16(v0[0], v0[1]); w.y = cvt_pk_bf16(v0[2], v0[3]); w.z = cvt_pk_bf16(v1[0], v1[1]); w.w = cvt_pk_bf16(v1[2], v1[3]);
                        *(u32x4*)(rowp + bj * HALF) = w; } }
        } else if (mode == EM_LORA) {
            const int pn = u.pn; const int col0 = (pn & 3) * BM + wc * 32 + 4 * fq;
            if (pn < 4) {
#pragma unroll
                for (int ai = 0; ai < 2; ++ai)
#pragma unroll
                    for (int m = 0; m < 4; ++m) { const size_t off = (size_t)(row0 + ai * HALF + m * 16) * 1024 + col0;
#pragma unroll
                        for (int bj = 0; bj < 2; ++bj)
#pragma unroll
                            for (int n = 0; n < 2; ++n) { const int c = col0 + bj * HALF + n * 16; const f32x4 a = acc[ai][bj][m][n]; const f32x4 b = *(const f32x4*)(f0 + c); f32x4 o;
#pragma unroll
                                for (int j = 0; j < 4; ++j) o[j] = __expf(-0.6065306597f * sigm(a[j] + b[j]));
                                *(f32x4*)((float*)o0 + off + bj * HALF + n * 16) = o; } }
            } else if (pn < 8) {
#pragma unroll
                for (int ai = 0; ai < 2; ++ai)
#pragma unroll
                    for (int m = 0; m < 4; ++m) { const size_t off = (size_t)(row0 + ai * HALF + m * 16) * 1024 + col0;
#pragma unroll
                        for (int bj = 0; bj < 2; ++bj)
#pragma unroll
                            for (int n = 0; n < 2; ++n) { const int c = col0 + bj * HALF + n * 16; const f32x4 a = acc[ai][bj][m][n]; const f32x4 b = *(const f32x4*)(f1 + c);
                                u32x2 w; w.x = cvt_pk_bf16(sigm(a[0] + b[0]), sigm(a[1] + b[1])); w.y = cvt_pk_bf16(sigm(a[2] + b[2]), sigm(a[3] + b[3]));
                                *(u32x2*)((bf16_t*)o1 + off + bj * HALF + n * 16) = w; } }
            } else {
#pragma unroll
                for (int ai = 0; ai < 2; ++ai)
#pragma unroll
                    for (int m = 0; m < 4; ++m) { const size_t off = (size_t)(row0 + ai * HALF + m * 16) * 1024 + col0;
#pragma unroll
                        for (int bj = 0; bj < 2; ++bj)
#pragma unroll
                            for (int n = 0; n < 2; ++n) { const f32x4 a = acc[ai][bj][m][n];
                                u32x2 w; w.x = cvt_pk_bf16(a[0], a[1]); w.y = cvt_pk_bf16(a[2], a[3]); *(u32x2*)((bf16_t*)o2 + off + bj * HALF + n * 16) = w; } }
            }
        } else if (mode == EM_M1) {
            float* C = (float*)o0; const bf16_t* Gt = (const bf16_t*)i0; const int col0 = u.pn * BM + wc * 32 + 4 * fq;
#pragma unroll
            for (int ai = 0; ai < 2; ++ai)
#pragma unroll
                for (int m = 0; m < 4; ++m) { const size_t r = (size_t)(row0 + ai * HALF + m * 16);
#pragma unroll
                    for (int bj = 0; bj < 2; ++bj)
#pragma unroll
                        for (int n = 0; n < 2; ++n) { const int c = col0 + bj * HALF + n * 16; const u32x2 gv = *(const u32x2*)(Gt + r * 4096 + c); const f32x4 a = acc[ai][bj][m][n];
                            f32x4 o; o[0] = bflo(gv.x) * a[0]; o[1] = bfhi(gv.x) * a[1]; o[2] = bflo(gv.y) * a[2]; o[3] = bfhi(gv.y) * a[3];
                            *(f32x4*)(C + r * 2048 + c) = o; } }
        } else {
            bf16_t* O = (bf16_t*)o0; const bf16_t* Gt = (const bf16_t*)i0; const float* T1 = (const float*)i1; const int col0 = u.pn * BM + wc * 32 + 8 * fq;
#pragma unroll
            for (int ai = 0; ai < 2; ++ai)
#pragma unroll
                for (int m = 0; m < 4; ++m) { const size_t r = (size_t)(row0 + ai * HALF + m * 16);
#pragma unroll
                    for (int bj = 0; bj < 2; ++bj) { const int c = col0 + bj * HALF; const u32x4 gv = *(const u32x4*)(Gt + r * 4096 + 2048 + c);
                        const f32x4 t0 = *(const f32x4*)(T1 + r * 2048 + c), t1 = *(const f32x4*)(T1 + r * 2048 + c + 4); const f32x4 a0 = acc[ai][bj][m][0], a1 = acc[ai][bj][m][1];
                        u32x4 w; w.x = cvt_pk_bf16(t0[0] + bflo(gv.x) * a0[0], t0[1] + bfhi(gv.x) * a0[1]); w.y = cvt_pk_bf16(t0[2] + bflo(gv.y) * a0[2], t0[3] + bfhi(gv.y) * a0[3]);
                        w.z = cvt_pk_bf16(t1[0] + bflo(gv.z) * a1[0], t1[1] + bfhi(gv.z) * a1[1]); w.w = cvt_pk_bf16(t1[2] + bflo(gv.w) * a1[2], t1[3] + bfhi(gv.w) * a1[3]);
                        *(u32x4*)(O + r * 2048 + c) = w; } }
        }
    }
};
template <class Epi, class Sched, bool ALIGN_EPI = false, bool SP2 = false>
__device__ __forceinline__ void gemm_phase(PG8_LAS unsigned char* lds, const Gemm g, const Sched& S, const Epi& E) {
    const int tid = threadIdx.x, wid = __builtin_amdgcn_readfirstlane(tid >> 6), lane = tid & 63, wr = wid >> 2, wc = wid & 3, fr = lane & 15, fq = lane >> 4;
    const int K = g.K, nt = K / BK;
    unsigned voffA[2], voffB[2];
#pragma unroll
    for (int i = 0; i < 2; ++i) { int R, C; stage_rc(tid * 16 + i * 8192, R, C); const int Rb = E.PERM ? ((R & ~31) + perm32(R & 31)) : R;
        voffA[i] = (unsigned)(R * K + C) * 2u; voffB[i] = (unsigned)(Rb * K + C) * 2u; }
    const size_t kstep = (size_t)(BK * 2);
    const size_t hstep = (size_t)HALF * K * 2;
    const size_t tstep = 2 * hstep;
    const unsigned ldsw = (unsigned)wid * 1024u;
    const int aoff = lds_byte(wr * 64 + fr, fq * 8), boff = lds_byte(wc * 32 + fr, fq * 8);
#define PG8_SA(b, h) (((b) * 2 + (h)) * HTB)
#define PG8_SB(b, h) ((4 + (b) * 2 + (h)) * HTB)
#define PG8_STAGE(bufoff, gbase, voff) do { _Pragma("unroll") for (int _i = 0; _i < 2; ++_i) \
        __builtin_amdgcn_global_load_lds((const unsigned*)((const char*)(gbase) + (voff)[_i]), (PG8_LAS unsigned*)(lds + (bufoff) + ldsw + _i * 8192), 16, 0, 0); } while (0)
#define PG8_LDA(dst, b, h) do { _Pragma("unroll") for (int m = 0; m < 4; ++m) _Pragma("unroll") for (int k = 0; k < 2; ++k) dst[m][k] = *(const PG8_LAS bf16x8*)(lds + PG8_SA(b, h) + aoff + m * 2048 + k * 1024); } while (0)
#define PG8_LDB(dst, b, h) do { _Pragma("unroll") for (int n = 0; n < 2; ++n) _Pragma("unroll") for (int k = 0; k < 2; ++k) dst[n][k] = *(const PG8_LAS bf16x8*)(lds + PG8_SB(b, h) + boff + n * 2048 + k * 1024); } while (0)
#define PG8_MMA(ai, bj, At, Bt) do { __builtin_amdgcn_s_setprio(1); _Pragma("unroll") for (int m = 0; m < 4; ++m) _Pragma("unroll") for (int n = 0; n < 2; ++n) _Pragma("unroll") for (int k = 0; k < 2; ++k) \
        acc[ai][bj][m][n] = __builtin_amdgcn_mfma_f32_16x16x32_bf16(Bt[n][k], At[m][k], acc[ai][bj][m][n], 0, 0, 0); __builtin_amdgcn_s_setprio(0); } while (0)
#define PG8_WAIT_V(n) asm volatile("s_waitcnt vmcnt(" #n ")" ::: "memory")
#define PG8_WAIT_L(n) asm volatile("s_waitcnt lgkmcnt(" #n ")" ::: "memory")
#define PG8_BAR __builtin_amdgcn_s_barrier()
#define PG8_SCHED __builtin_amdgcn_sched_barrier(0)
    Unit cur, nxt; int ui = 0;
    if (!S.next(0, cur)) return;
    f32x4 acc[2][2][4][2];
#pragma unroll
    for (int a = 0; a < 2; ++a)
#pragma unroll
        for (int b = 0; b < 2; ++b)
#pragma unroll
            for (int m = 0; m < 4; ++m)
#pragma unroll
                for (int n = 0; n < 2; ++n) acc[a][b][m][n] = (f32x4){0.f, 0.f, 0.f, 0.f};
    bf16x8 At[4][2], B0[2][2], B1[2][2];
    const char* cA = (const char*)g.A + (size_t)cur.pm * tstep; const char* cB = (const char*)g.Bt + (size_t)cur.pn * tstep;
    S.a_ready(cur);
    if constexpr (SP2) {
        PG8_STAGE(PG8_SB(0, 0), cB, voffB); PG8_STAGE(PG8_SB(0, 1), cB + hstep, voffB); PG8_STAGE(PG8_SA(0, 0), cA, voffA); PG8_STAGE(PG8_SA(0, 1), cA + hstep, voffA);
        if (wr == 1) PG8_BAR;
        PG8_WAIT_V(2); PG8_BAR;
        PG8_STAGE(PG8_SB(1, 0), cB + kstep, voffB); PG8_STAGE(PG8_SA(1, 0), cA + kstep, voffA); PG8_STAGE(PG8_SB(1, 1), cB + hstep + kstep, voffB);
        PG8_WAIT_V(6); PG8_BAR;
    } else {
        PG8_STAGE(PG8_SB(0, 0), cB, voffB); PG8_STAGE(PG8_SA(0, 0), cA, voffA); PG8_STAGE(PG8_SB(0, 1), cB + hstep, voffB); PG8_STAGE(PG8_SA(0, 1), cA + hstep, voffA);
        if (wr == 1) PG8_BAR;
        PG8_WAIT_V(4); PG8_BAR;
        PG8_STAGE(PG8_SB(1, 0), cB + kstep, voffB); PG8_STAGE(PG8_SA(1, 0), cA + kstep, voffA); PG8_STAGE(PG8_SB(1, 1), cB + hstep + kstep, voffB);
        PG8_WAIT_V(6); PG8_BAR;
    }
    for (;;) {
        const bool has_next = S.next(ui + 1, nxt);
        const char* nA = has_next ? (const char*)g.A + (size_t)nxt.pm * tstep : cA; const char* nB = has_next ? (const char*)g.Bt + (size_t)nxt.pn * tstep : cB;
        for (int t = 0; t < nt; t += 2) {
            const bool last = (t == nt - 2);
            const char* a1 = cA + (size_t)(t + 1) * kstep;
            const char* a2 = last ? nA : cA + (size_t)(t + 2) * kstep; const char* b2 = last ? nB : cB + (size_t)(t + 2) * kstep;
            const char* a3 = a2 + kstep; const char* b3 = b2 + kstep;
            if (last && has_next) S.a_ready(nxt);
            if constexpr (SP2) {
            PG8_LDB(B0, 0, 0); PG8_LDB(B1, 0, 1); PG8_SCHED; PG8_LDA(At, 0, 0); PG8_STAGE(PG8_SA(1, 1), a1 + hstep, voffA);
            PG8_WAIT_V(8); PG8_WAIT_L(0); PG8_BAR; PG8_MMA(0, 0, At, B0); PG8_MMA(0, 1, At, B1); PG8_BAR; PG8_SCHED;
            PG8_LDA(At, 0, 1); PG8_STAGE(PG8_SB(0, 0), b2, voffB); PG8_STAGE(PG8_SB(0, 1), b2 + hstep, voffB); PG8_STAGE(PG8_SA(0, 0), a2, voffA);
            PG8_WAIT_V(8); PG8_WAIT_L(0); PG8_BAR; PG8_MMA(1, 0, At, B0); PG8_MMA(1, 1, At, B1); PG8_BAR; PG8_SCHED;
            PG8_LDB(B0, 1, 0); PG8_LDB(B1, 1, 1); PG8_SCHED; PG8_LDA(At, 1, 0); PG8_STAGE(PG8_SA(0, 1), a2 + hstep, voffA);
            PG8_WAIT_V(8); PG8_WAIT_L(0); PG8_BAR; PG8_MMA(0, 0, At, B0); PG8_MMA(0, 1, At, B1); PG8_BAR; PG8_SCHED;
            PG8_LDA(At, 1, 1); PG8_STAGE(PG8_SB(1, 0), b3, voffB); PG8_STAGE(PG8_SB(1, 1), b3 + hstep, voffB); PG8_STAGE(PG8_SA(1, 0), a3, voffA);
            PG8_WAIT_V(8); PG8_WAIT_L(0); PG8_BAR; PG8_MMA(1, 0, At, B0); PG8_MMA(1, 1, At, B1); PG8_BAR; PG8_SCHED;
            } else {
            PG8_LDB(B0, 0, 0); PG8_SCHED; PG8_LDA(At, 0, 0); PG8_STAGE(PG8_SA(1, 1), a1 + hstep, voffA);
            PG8_WAIT_L(8); PG8_BAR; PG8_WAIT_L(0); PG8_MMA(0, 0, At, B0); PG8_BAR; PG8_SCHED;
            PG8_LDB(B1, 0, 1); PG8_STAGE(PG8_SB(0, 0), b2, voffB);
            PG8_BAR; PG8_WAIT_L(0); PG8_MMA(0, 1, At, B1); PG8_BAR;
            PG8_LDA(At, 0, 1); PG8_STAGE(PG8_SA(0, 0), a2, voffA);
            PG8_BAR; PG8_WAIT_L(0); PG8_MMA(1, 0, At, B0); PG8_BAR; PG8_SCHED;
            PG8_STAGE(PG8_SB(0, 1), b2 + hstep, voffB);
            PG8_WAIT_V(6); PG8_BAR; PG8_MMA(1, 1, At, B1); PG8_BAR;
            PG8_LDB(B0, 1, 0); PG8_SCHED; PG8_LDA(At, 1, 0); PG8_STAGE(PG8_SA(0, 1), a2 + hstep, voffA);
            PG8_WAIT_L(8); PG8_BAR; PG8_WAIT_L(0); PG8_MMA(0, 0, At, B0); PG8_BAR; PG8_SCHED;
            PG8_LDB(B1, 1, 1); PG8_STAGE(PG8_SB(1, 0), b3, voffB);
            PG8_BAR; PG8_WAIT_L(0); PG8_MMA(0, 1, At, B1); PG8_BAR;
            PG8_LDA(At, 1, 1); PG8_STAGE(PG8_SA(1, 0), a3, voffA);
            PG8_BAR; PG8_WAIT_L(0); PG8_MMA(1, 0, At, B0); PG8_BAR; PG8_SCHED;
            PG8_STAGE(PG8_SB(1, 1), b3 + hstep, voffB);
            PG8_WAIT_V(6); PG8_BAR; PG8_MMA(1, 1, At, B1); PG8_BAR;
            }
        }
        if constexpr (ALIGN_EPI) { if (wr == 0) PG8_BAR; }
        if constexpr (!Epi::AFTER_DRAIN) { E(acc, cur, wr, wc, fr, fq); S.done(cur); }
        if (!has_next) break;
#pragma unroll
        for (int a = 0; a < 2; ++a)
#pragma unroll
            for (int b = 0; b < 2; ++b)
#pragma unroll
                for (int m = 0; m < 4; ++m)
#pragma unroll
                    for (int n = 0; n < 2; ++n) acc[a][b][m][n] = (f32x4){0.f, 0.f, 0.f, 0.f};
        cur = nxt; cA = nA; cB = nB; ++ui;
        if constexpr (ALIGN_EPI) { if (wr == 1) PG8_BAR; }
    }
    PG8_WAIT_V(0);
    if constexpr (!ALIGN_EPI) { if (wr == 0) PG8_BAR; }
    PG8_BAR;
    if constexpr (Epi::AFTER_DRAIN) { E.fused(acc, cur, wr, wc, fr, fq, lds, wid, lane); S.done(cur); }
#undef PG8_SA
#undef PG8_SB
#undef PG8_STAGE
#undef PG8_LDA
#undef PG8_LDB
#undef PG8_MMA
#undef PG8_WAIT_V
#undef PG8_WAIT_L
#undef PG8_BAR
#undef PG8_SCHED
}
}

#define LAS __attribute__((address_space(3)))
typedef unsigned short bf16;
typedef float f32x4 __attribute__((ext_vector_type(4)));
typedef unsigned u32x4 __attribute__((ext_vector_type(4)));
typedef unsigned u32x2 __attribute__((ext_vector_type(2)));
typedef short bf16x8 __attribute__((ext_vector_type(8)));
using pg8::bf2f; using pg8::bflo; using pg8::bfhi; using pg8::sigm; using pg8::silu_; using pg8::cvt_pk_bf16;

constexpr int D = 2048, FF = 5632, NB = 4, SEQ = 2048, NMETA = 16, PADR = 48, LP = 2112  , TP = 2064  ;
constexpr int SB = 16, SS = 16, MP = NB * LP  , MROWS = MP + SB * SS  ;
constexpr int RWD = 1024, RWH = 16, SHC = 3520, CONVD = 3072, SSMH = 32, SSMN = 128, NINP = 12800;
constexpr int PRW_LD = 3584, Z_LD = 2048, XBC_LD = 3072, GATE_LD = 4096;
constexpr float LN_EPS = 1e-5f, ALPHA = 1.189207115f  , GN_EPS = 64e-5f, RMS_EPS = 1e-5f;
constexpr int NPHASE = 17;
constexpr int LDS_BYTES = 147456;

enum { I_XP = 0, I_XS, I_SSH, I_SWKV, I_SCONV, I_SSSM, I_META, I_GU1, I_DN1, I_LN1G, I_LN1B, I_WIN, I_BGATE, I_MU, I_W0, I_W2, I_A0, I_A2, I_G2, I_KK, I_KA, I_RK, I_GNW, I_GNB,
       I_CONVW, I_CONVB, I_DTB, I_ALOG, I_DSKIP, I_NORMW, I_RWO, I_SSMO, I_WO, I_LN2G, I_LN2B, I_GU2, I_DN2, I_LN3G, I_LN3B, N_IN };
constexpr size_t O_YP = 0, O_YS = 16777216, O_PSH = 17301504, O_PWKV = 17315584, O_PCONV = 17577728, O_PSSM = 17614592, O_SSH = 18663168, O_SWKV = 18719488, O_SCONV = 19768064, O_SSSM = 19915520, O_END = 24109824;
constexpr size_t MiB = 1u << 20;
constexpr size_t WS_SBON = 1 * MiB, WS_RWOT = 2 * MiB, WS_SSMOT = 6 * MiB, WS_WOT = 14 * MiB, WS_LORAT = 22 * MiB, WS_WBIG = 25 * MiB, WS_XB = 91 * MiB, WS_ACT = 125 * MiB, WS_PROJ = 219 * MiB, WS_YRW = 432 * MiB, WS_END = 449 * MiB;
constexpr size_t WS_GUT = WS_WBIG, WS_DNT = WS_WBIG + 44 * MiB, WS_WINT = WS_WBIG, WS_WDEC = WS_WBIG, WS_GBUF = WS_WBIG + 34 * MiB, WS_MERGED = WS_WBIG;
constexpr size_t WS_R = WS_ACT, WS_KP = WS_ACT + 17 * MiB, WS_V = WS_ACT + 34 * MiB, WS_KK = WS_ACT + 51 * MiB, WS_BB = WS_ACT + 68 * MiB, WS_ALORA = WS_ACT + 85 * MiB, WS_T1 = WS_ACT;
constexpr size_t WS_PRW = WS_PROJ, WS_Z = WS_PRW + (size_t)MROWS * PRW_LD * 2, WS_XBC = WS_Z + (size_t)MROWS * Z_LD * 2, WS_GATE = WS_XBC + (size_t)MROWS * XBC_LD * 2, WS_PRE = WS_PROJ;
static_assert(WS_GATE + (size_t)MROWS * GATE_LD * 2 <= WS_YRW, "proj region");
static_assert(WS_ALORA + (size_t)MROWS * 512 * 2 <= WS_PROJ, "act region");

struct Params { const float* in[N_IN]; float* out; unsigned char* ws; int ph_lo, ph_hi; };

__device__ __forceinline__ int opaque_idx(int i) { asm volatile("" : "+s"(i)); return i; }
#define PIN(i) (p.in[opaque_idx(i)])
struct Ctx { int tid, lane, wave, gw, ngw; LAS unsigned char* lds; };

__device__ __forceinline__ float wave_sum(float v) {
#pragma unroll
    for (int o = 1; o < 64; o <<= 1) v += __shfl_xor(v, o);
    return v;
}
__device__ __forceinline__ unsigned pk2(float lo, float hi) { return cvt_pk_bf16(lo, hi); }
__device__ __forceinline__ float softplus_(float x) { return fmaxf(x, 0.f) + __logf(1.f + __expf(-fabsf(x))); }

__device__ __forceinline__ const float* xrow_ptr(const Params& p, int row) {
    if (row < MP) { const int b = row / LP, q = row - b * LP; if (q < PADR) return nullptr; const int t = q - PADR;
        return t < NMETA ? PIN(I_META) + (size_t)t * D : PIN(I_XP) + ((size_t)b * SEQ + (t - NMETA)) * D; }
    return PIN(I_XS) + (size_t)(row - MP) * D;
}
__device__ __forceinline__ float* yrow_ptr(const Params& p, int row) {
    if (row < MP) { const int b = row / LP, q = row - b * LP; if (q < PADR + NMETA) return nullptr; return p.out + O_YP + ((size_t)b * SEQ + (q - PADR - NMETA)) * D; }
    return p.out + O_YS + (size_t)(row - MP) * D;
}
__device__ __forceinline__ bool row_is_pad(int row) { return row < MP && (row % LP) < PADR; }

__device__ __forceinline__ void phase_convert_x(const Params& p, const Ctx& c) {
    bf16* XB = (bf16*)(p.ws + WS_XB);
    for (int row = c.gw; row < MROWS; row += c.ngw) { const float* src = xrow_ptr(p, row); u32x2* dst = (u32x2*)(XB + (size_t)row * D);
#pragma unroll
        for (int j = 0; j < 8; ++j) { f32x4 v = src ? ((const f32x4*)src)[c.lane + 64 * j] : (f32x4){0.f, 0.f, 0.f, 0.f}; u32x2 w; w.x = pk2(v[0], v[1]); w.y = pk2(v[2], v[3]); dst[c.lane + 64 * j] = w; } }
}
enum { MAP_ID = 0, MAP_GU = 1, MAP_WIN = 2 };
__device__ __forceinline__ int map_src_col(int kind, int c) {
    if (kind == MAP_ID) return c;
    if (kind == MAP_GU) { const int pn = c >> 8, bj = (c >> 7) & 1, r = c & 127; return bj * FF + 128 * pn + r; }
    if (c < 3520) return c; if (c < 3552) return 8640 + (c - 3520); if (c < 3584) return -1; if (c < 5632) return 3520 + (c - 3584); if (c < 8704) return 5568 + (c - 5632); return 8672 + (c - 8704);
}
__device__ __forceinline__ void transpose_w(const float* W, int K, int Nsrc, bf16* WT, int ndst, int kind, const Ctx& c) {
    LAS float* scr = (LAS float*)(c.lds + c.wave * 8704);
    const int nblk = ndst / 32, nitems = (K / 64) * nblk, lane = c.lane;
    for (int it = c.gw; it < nitems; it += c.ngw) {
        const int kb = it / nblk, nb = it - kb * nblk, k0 = 64 * kb, n0 = 32 * nb; const int sc = map_src_col(kind, n0);
        if (sc >= 0) {
#pragma unroll 8
            for (int i = 0; i < 32; ++i) { const int kk = 2 * i + (lane >> 5); scr[kk * 33 + (lane & 31)] = W[(size_t)(k0 + kk) * Nsrc + sc + (lane & 31)]; }
        } else {
#pragma unroll 8
            for (int i = 0; i < 32; ++i) { const int kk = 2 * i + (lane >> 5); scr[kk * 33 + (lane & 31)] = 0.f; }
        }
        asm volatile("s_waitcnt lgkmcnt(0)" ::: "memory");
        const int cc = lane & 7;
#pragma unroll
        for (int j = 0; j < 4; ++j) { const int n = (lane >> 3) + 8 * j; const LAS float* s = scr + (8 * cc) * 33 + n;
            u32x4 o; o.x = pk2(s[0 * 33], s[1 * 33]); o.y = pk2(s[2 * 33], s[3 * 33]); o.z = pk2(s[4 * 33], s[5 * 33]); o.w = pk2(s[6 * 33], s[7 * 33]);
            *(u32x4*)(WT + (size_t)(n0 + n) * K + k0 + 8 * cc) = o; }
        asm volatile("s_waitcnt lgkmcnt(0)" ::: "memory");
    }
}
__device__ __forceinline__ void build_lorat(const Params& p, const Ctx& c) {
    bf16* LT = (bf16*)(p.ws + WS_LORAT); const float* w2 = PIN(I_W2); const float* a2 = PIN(I_A2); const float* g2 = PIN(I_G2);
    const int gt = blockIdx.x * 512 + c.tid, ngt = gridDim.x * 512;
    for (int idx = gt; idx < 3072 * 512; idx += ngt) { const int k = idx / 3072, n = idx - k * 3072; float v = 0.f;
        if (n < 1024) { if (k < 96) v = w2[k * 1024 + n]; }
        else if (n < 2048) { if (k >= 96 && k < 192) v = a2[(k - 96) * 1024 + (n - 1024)]; }
        else { if (k >= 256) v = g2[(k - 256) * 1024 + (n - 2048)]; }
        LT[(size_t)n * 512 + k] = (bf16)(pk2(v, 0.f) & 0xffffu); }
}
template <bool FINAL> __device__ __forceinline__ void phase_ln(const Params& p, const Ctx& c, const float* gam, const float* bet) {
    const float* PRE = (const float*)(p.ws + WS_PRE); bf16* XB = (bf16*)(p.ws + WS_XB);
    f32x4 gv[8], bv[8];
#pragma unroll
    for (int j = 0; j < 8; ++j) { gv[j] = ((const f32x4*)gam)[c.lane + 64 * j]; bv[j] = ((const f32x4*)bet)[c.lane + 64 * j]; }
    for (int row = c.gw; row < MROWS; row += c.ngw) {
        float* yo = nullptr; if (FINAL) { yo = yrow_ptr(p, row); if (!yo) continue; }
        const f32x4* src = (const f32x4*)(PRE + (size_t)row * D); f32x4 v[8]; float s = 0.f;
#pragma unroll
        for (int j = 0; j < 8; ++j) { v[j] = src[c.lane + 64 * j]; s += (v[j][0] + v[j][1]) + (v[j][2] + v[j][3]); }
        const float mean = wave_sum(s) * (1.f / D); float q = 0.f;
#pragma unroll
        for (int j = 0; j < 8; ++j) { v[j] = v[j] - mean; q += (v[j][0] * v[j][0] + v[j][1] * v[j][1]) + (v[j][2] * v[j][2] + v[j][3] * v[j][3]); }
        const float rstd = 1.f / sqrtf(wave_sum(q) * (1.f / D) + LN_EPS);
#pragma unroll
        for (int j = 0; j < 8; ++j) { const f32x4 o = v[j] * rstd * gv[j] + bv[j];
            if (FINAL) ((f32x4*)yo)[c.lane + 64 * j] = o;
            else { u32x2 w; w.x = pk2(o[0], o[1]); w.y = pk2(o[2], o[3]); ((u32x2*)(XB + (size_t)row * D))[c.lane + 64 * j] = w; } }
    }
}
__device__ __forceinline__ void phase_prep1(const Params& p, const Ctx& c) {
    const bf16* PRW = (const bf16*)(p.ws + WS_PRW); const bf16* XBC = (const bf16*)(p.ws + WS_XBC); bf16* AL = (bf16*)(p.ws + WS_ALORA); const float* mu = PIN(I_MU);
    for (int row = c.gw; row < MROWS; row += c.ngw) {
        bf16* al = AL + (size_t)row * 512;
        if (row_is_pad(row)) {
#pragma unroll
            for (int i = 0; i < 8; ++i) al[c.lane + 64 * i] = 0; continue; }
        const bf16* cur = PRW + (size_t)row * PRW_LD; const bf16* prv = nullptr; const float* prvf = nullptr;
        if (row < MP) { if ((row % LP) != PADR) prv = cur - PRW_LD; }
        else { const int s = row - MP; if ((s & 15) != 0) prv = cur - PRW_LD; else prvf = PIN(I_SSH) + (size_t)(s >> 4) * SHC; }
#pragma unroll
        for (int i = 0; i < 7; ++i) { const int col = 3072 + c.lane + 64 * i; const float pc = bf2f(cur[col]); const float pp = prv ? bf2f(prv[col]) : (prvf ? prvf[col] : 0.f);
            const float ps = pc + (pp - pc) * mu[col]; const int lc = c.lane + 64 * i;
            if (lc < 96) al[lc] = (bf16)(pk2(tanhf(ps), 0.f) & 0xffffu);
            else if (lc < 192) al[lc] = (bf16)(pk2(ps, 0.f) & 0xffffu);
            else al[256 + (lc - 192)] = (bf16)(pk2(sigm(ps), 0.f) & 0xffffu); }
        al[192 + c.lane] = 0;
    }
    const int gt = blockIdx.x * 512 + c.tid, ngt = gridDim.x * 512;
    for (int i = gt; i < NB * SHC; i += ngt) { const int b = i / SHC, col = i - b * SHC; p.out[O_PSH + i] = bf2f(PRW[(size_t)(b * LP + LP - 1) * PRW_LD + col]); }
    for (int i = gt; i < SB * SHC; i += ngt) { const int b = i / SHC, col = i - b * SHC; p.out[O_SSH + i] = bf2f(PRW[(size_t)(MP + b * SS + SS - 1) * PRW_LD + col]); }
    for (int i = gt; i < NB * 3 * CONVD; i += ngt) { const int b = i / (3 * CONVD), r = (i / CONVD) % 3, col = i % CONVD; p.out[O_PCONV + i] = bf2f(XBC[(size_t)(b * LP + LP - 3 + r) * XBC_LD + col]); }
    for (int i = gt; i < SB * 3 * CONVD; i += ngt) { const int b = i / (3 * CONVD), r = (i / CONVD) % 3, col = i % CONVD; p.out[O_SCONV + i] = bf2f(XBC[(size_t)(MP + b * SS + SS - 3 + r) * XBC_LD + col]); }
}
__device__ __forceinline__ float sum16(float v) { v += __shfl_xor(v, 1); v += __shfl_xor(v, 2); v += __shfl_xor(v, 4); v += __shfl_xor(v, 8); return v; }
__device__ __forceinline__ void ld4bf(const bf16* ptr, float (&o)[4]) { const u32x2 w = *(const u32x2*)ptr; o[0] = bflo(w.x); o[1] = bfhi(w.x); o[2] = bflo(w.y); o[3] = bfhi(w.y); }
__device__ __forceinline__ void st4bf(bf16* ptr, const float (&v)[4]) { u32x2 w; w.x = pk2(v[0], v[1]); w.y = pk2(v[2], v[3]); *(u32x2*)ptr = w; }
__device__ __forceinline__ void shifted4(const bf16* cur, const bf16* prv, const float* prvf, int col, const float* mu, float (&o)[4]) {
    float pc[4], pp[4]; ld4bf(cur + col, pc);
    if (prv) ld4bf(prv + col, pp); else if (prvf) { const f32x4 t = *(const f32x4*)(prvf + col); pp[0] = t[0]; pp[1] = t[1]; pp[2] = t[2]; pp[3] = t[3]; } else { pp[0] = pp[1] = pp[2] = pp[3] = 0.f; }
    const f32x4 m = *(const f32x4*)(mu + col);
#pragma unroll
    for (int j = 0; j < 4; ++j) o[j] = pc[j] + (pp[j] - pc[j]) * m[j];
}
__device__ __forceinline__ void phase_prep2(const Params& p, const Ctx& c) {
    const bf16* PRW = (const bf16*)(p.ws + WS_PRW); bf16* R = (bf16*)(p.ws + WS_R); bf16* KP = (bf16*)(p.ws + WS_KP); bf16* V = (bf16*)(p.ws + WS_V); bf16* KK = (bf16*)(p.ws + WS_KK); bf16* BB = (bf16*)(p.ws + WS_BB);
    float* SBON = (float*)(p.ws + WS_SBON); const float* mu = PIN(I_MU);
    const int t4 = c.tid & 255, ch = 4 * t4, head = t4 >> 4;
    const f32x4 wkk = *(const f32x4*)(PIN(I_KK) + ch), wka = *(const f32x4*)(PIN(I_KA) + ch), wrk = *(const f32x4*)(PIN(I_RK) + ch);
    for (int row = blockIdx.x * 2 + (c.tid >> 8); row < MROWS; row += gridDim.x * 2) {
        if (row_is_pad(row)) continue;
        const bf16* cur = PRW + (size_t)row * PRW_LD; const bf16* prv = nullptr; const float* prvf = nullptr;
        if (row < MP) { if ((row % LP) != PADR) prv = cur - PRW_LD; }
        else { const int s = row - MP; if ((s & 15) != 0) prv = cur - PRW_LD; else prvf = PIN(I_SSH) + (size_t)(s >> 4) * SHC; }
        float r[4], k[4], v[4], a[4];
        shifted4(cur, prv, prvf, ch, mu, r); shifted4(cur, prv, prvf, 1024 + ch, mu, k); shifted4(cur, prv, prvf, 2048 + ch, mu, v);
        ld4bf(BB + (size_t)row * RWD + ch, a);
        float kk[4], ss = 0.f;
#pragma unroll
        for (int j = 0; j < 4; ++j) { kk[j] = k[j] * wkk[j]; ss += kk[j] * kk[j]; }
        ss = sum16(ss); const float inv = 1.f / fmaxf(sqrtf(ss), 1e-12f);
        float kp[4], bb[4], sb = 0.f;
#pragma unroll
        for (int j = 0; j < 4; ++j) { kk[j] *= inv; kp[j] = k[j] * (1.f + (a[j] - 1.f) * wka[j]); bb[j] = kk[j] * a[j]; sb += r[j] * kp[j] * wrk[j]; }
        sb = sum16(sb);
        const size_t o = (size_t)row * RWD + ch;
        st4bf(R + o, r); st4bf(KP + o, kp); st4bf(V + o, v); st4bf(KK + o, kk); st4bf(BB + o, bb);
        if ((t4 & 15) == 0) SBON[(size_t)row * RWH + head] = sb;
    }
}
__device__ __forceinline__ void phase_post(const Params& p, const Ctx& c) {
    const float* YRAW = p.out; const bf16* V = (const bf16*)(p.ws + WS_V); const bf16* G = (const bf16*)(p.ws + WS_GBUF); const float* SBON = (const float*)(p.ws + WS_SBON); bf16* YRW = (bf16*)(p.ws + WS_YRW);
    { const int t4 = c.tid & 255, ch = 4 * t4, head = t4 >> 4;
      const f32x4 gw = *(const f32x4*)(PIN(I_GNW) + ch), gb = *(const f32x4*)(PIN(I_GNB) + ch);
      for (int row = blockIdx.x * 2 + (c.tid >> 8); row < MROWS; row += gridDim.x * 2) {
        const size_t o = (size_t)row * RWD + ch;
        if (row_is_pad(row)) { u32x2 z; z.x = 0; z.y = 0; *(u32x2*)(YRW + o) = z; continue; }
        const f32x4 y = *(const f32x4*)(YRAW + o); float v[4], g[4]; ld4bf(V + o, v); ld4bf(G + o, g);
        const float mean = sum16((y[0] + y[1]) + (y[2] + y[3])) * (1.f / 64.f);
        float d[4], q = 0.f;
#pragma unroll
        for (int j = 0; j < 4; ++j) { d[j] = y[j] - mean; q += d[j] * d[j]; }
        const float rstd = 1.f / sqrtf(sum16(q) * (1.f / 64.f) + GN_EPS); const float sb = SBON[(size_t)row * RWH + head];
        float ov[4];
#pragma unroll
        for (int j = 0; j < 4; ++j) ov[j] = (d[j] * rstd * gw[j] + gb[j] + sb * v[j]) * g[j];
        st4bf(YRW + o, ov);
      } }
    { bf16* Z = (bf16*)(p.ws + WS_Z); const float* nw = PIN(I_NORMW);
      for (int it = c.gw; it < MROWS * 4; it += c.ngw) { const int row = it >> 2, g = it & 3; bf16* ptr = Z + (size_t)row * Z_LD + g * 512 + c.lane * 8;
        const u32x4 w = *(const u32x4*)ptr; float v[8] = {bflo(w.x), bfhi(w.x), bflo(w.y), bfhi(w.y), bflo(w.z), bfhi(w.z), bflo(w.w), bfhi(w.w)};
        float ss = 0.f;
#pragma unroll
        for (int j = 0; j < 8; ++j) ss += v[j] * v[j];
        const float rs = 1.f / sqrtf(wave_sum(ss) * (1.f / 512.f) + RMS_EPS);
        const f32x4 n0 = *(const f32x4*)(nw + g * 512 + c.lane * 8), n1 = *(const f32x4*)(nw + g * 512 + c.lane * 8 + 4);
        u32x4 o; o.x = pk2(v[0] * rs * n0[0], v[1] * rs * n0[1]); o.y = pk2(v[2] * rs * n0[2], v[3] * rs * n0[3]); o.z = pk2(v[4] * rs * n1[0], v[5] * rs * n1[1]); o.w = pk2(v[6] * rs * n1[2], v[7] * rs * n1[3]);
        *(u32x4*)ptr = o; } }
}

constexpr int SC_CH = 32;
constexpr int SC_BUF = 6 * SC_CH * 64 * 4;
__device__ __forceinline__ float dpp_sum8(float x) {
    x += __builtin_bit_cast(float, __builtin_amdgcn_update_dpp(0, __builtin_bit_cast(int, x), 0xB1, 0xF, 0xF, true));
    x += __builtin_bit_cast(float, __builtin_amdgcn_update_dpp(0, __builtin_bit_cast(int, x), 0x4E, 0xF, 0xF, true));
    x += __builtin_bit_cast(float, __builtin_amdgcn_update_dpp(0, __builtin_bit_cast(int, x), 0x141, 0xF, 0xF, true));
    return x;
}
__device__ __forceinline__ void scan_stage(const Params& p, const Ctx& c, LAS float* buf, int row0, int h, int steps, int lt  ) {
    const int i = lt >> 3, ch0 = (lt & 7) * 8;
    if (i < steps) {
        const size_t o = (size_t)(row0 + i) * RWD + h * 64 + ch0;
        const u32x4 wr = *(const u32x4*)((const bf16*)(p.ws + WS_R) + o), wk = *(const u32x4*)((const bf16*)(p.ws + WS_KP) + o), wv = *(const u32x4*)((const bf16*)(p.ws + WS_V) + o),
                    wkk = *(const u32x4*)((const bf16*)(p.ws + WS_KK) + o), wb = *(const u32x4*)((const bf16*)(p.ws + WS_BB) + o);
        const f32x4 d0 = *(const f32x4*)((const float*)(p.ws + WS_WDEC) + o), d1 = *(const f32x4*)((const float*)(p.ws + WS_WDEC) + o + 4);
        LAS f32x4* dst = (LAS f32x4*)(buf + i * 64 + ch0);
#define SC_PUT(arr, V_) do { dst[(arr) * (SC_CH * 16)] = (f32x4){bflo(V_.x), bfhi(V_.x), bflo(V_.y), bfhi(V_.y)}; dst[(arr) * (SC_CH * 16) + 1] = (f32x4){bflo(V_.z), bfhi(V_.z), bflo(V_[3]), bfhi(V_[3])}; } while (0)
        SC_PUT(0, wr); dst[1 * (SC_CH * 16)] = d0; dst[1 * (SC_CH * 16) + 1] = d1; SC_PUT(2, wk); SC_PUT(3, wkk); SC_PUT(4, wb); SC_PUT(5, wv);
#undef SC_PUT
    }
}
__device__ __forceinline__ void rwkv_scan_unit(const Params& p, const Ctx& c, int s, int h, int hf) {
    const bool prompt = s < NB; const int row_base = prompt ? s * LP + PADR : MP + (s - NB) * SS; const int T = prompt ? TP : SS;
    const int nch = (T + SC_CH - 1) / SC_CH;
    LAS float* buf0 = (LAS float*)c.lds; LAS float* buf1 = (LAS float*)(c.lds + SC_BUF);
    const bool comp = c.wave < 4; const int lane = c.lane, ks = lane & 7, vrow = 32 * hf + 8 * (c.wave & 3) + (lane >> 3);
    float S[8];
#pragma unroll
    for (int j = 0; j < 8; ++j) S[j] = 0.f;
    if (comp && !prompt) { const float* st = PIN(I_SWKV) + (((size_t)(s - NB) * RWH + h) * 64 + vrow) * 64 + ks * 8;
        const f32x4 a = *(const f32x4*)st, b = *(const f32x4*)(st + 4); S[0] = a[0]; S[1] = a[1]; S[2] = a[2]; S[3] = a[3]; S[4] = b[0]; S[5] = b[1]; S[6] = b[2]; S[7] = b[3]; }
    __syncthreads();
    scan_stage(p, c, buf0, row_base, h, T < SC_CH ? T : SC_CH, c.tid & 255);
    __syncthreads();
    float* yout = p.out;
    for (int cix = 0; cix < nch; ++cix) {
        LAS float* cur = (cix & 1) ? buf1 : buf0; LAS float* nxt = (cix & 1) ? buf0 : buf1;
        const int t0 = cix * SC_CH; const int steps = (T - t0) < SC_CH ? (T - t0) : SC_CH;
        if (!comp) { if (cix + 1 < nch) { const int t1 = t0 + SC_CH; scan_stage(p, c, nxt, row_base + t1, h, (T - t1) < SC_CH ? (T - t1) : SC_CH, c.tid - 256); } }
        else {
            const LAS float* bR = cur + ks * 8;
            f32x4 r0, r1, w0, w1, k0, k1, q0, q1, b0, b1; float vv;
#define SC_LOAD(i) do { const LAS float* bp = bR + (i) * 64; r0 = *(const LAS f32x4*)bp; r1 = *(const LAS f32x4*)(bp + 4); w0 = *(const LAS f32x4*)(bp + SC_CH * 64); w1 = *(const LAS f32x4*)(bp + SC_CH * 64 + 4); \
        k0 = *(const LAS f32x4*)(bp + 2 * SC_CH * 64); k1 = *(const LAS f32x4*)(bp + 2 * SC_CH * 64 + 4); q0 = *(const LAS f32x4*)(bp + 3 * SC_CH * 64); q1 = *(const LAS f32x4*)(bp + 3 * SC_CH * 64 + 4); \
        b0 = *(const LAS f32x4*)(bp + 4 * SC_CH * 64); b1 = *(const LAS f32x4*)(bp + 4 * SC_CH * 64 + 4); vv = cur[5 * SC_CH * 64 + (i) * 64 + vrow]; } while (0)
            SC_LOAD(0);
            for (int i = 0; i < steps; ++i) {
                const f32x4 cr0 = r0, cr1 = r1, cw0 = w0, cw1 = w1, ck0 = k0, ck1 = k1, cq0 = q0, cq1 = q1, cb0 = b0, cb1 = b1; const float cv = vv;
                const int in = (i + 1 < steps) ? i + 1 : i; SC_LOAD(in);
                float pa = S[0] * cq0[0] + S[1] * cq0[1], pb = S[2] * cq0[2] + S[3] * cq0[3]; pa += S[4] * cq1[0] + S[5] * cq1[1]; pb += S[6] * cq1[2] + S[7] * cq1[3];
                const float sa = -dpp_sum8(pa + pb);
                S[0] = S[0] * cw0[0] + (sa * cb0[0] + cv * ck0[0]); S[1] = S[1] * cw0[1] + (sa * cb0[1] + cv * ck0[1]); S[2] = S[2] * cw0[2] + (sa * cb0[2] + cv * ck0[2]); S[3] = S[3] * cw0[3] + (sa * cb0[3] + cv * ck0[3]);
                S[4] = S[4] * cw1[0] + (sa * cb1[0] + cv * ck1[0]); S[5] = S[5] * cw1[1] + (sa * cb1[1] + cv * ck1[1]); S[6] = S[6] * cw1[2] + (sa * cb1[2] + cv * ck1[2]); S[7] = S[7] * cw1[3] + (sa * cb1[3] + cv * ck1[3]);
                float ya = S[0] * cr0[0] + S[1] * cr0[1], yb = S[2] * cr0[2] + S[3] * cr0[3]; ya += S[4] * cr1[0] + S[5] * cr1[1]; yb += S[6] * cr1[2] + S[7] * cr1[3];
                const float y = dpp_sum8(ya + yb);
                if (ks == 0) yout[(size_t)(row_base + t0 + i) * RWD + h * 64 + vrow] = y;
            }
#undef SC_LOAD
        }
        __syncthreads();
    }
    if (comp) { float* so = p.out + (prompt ? O_PWKV + (((size_t)s * RWH + h) * 64 + vrow) * 64 : O_SWKV + (((size_t)(s - NB) * RWH + h) * 64 + vrow) * 64) + ks * 8;
        *(f32x4*)so = (f32x4){S[0], S[1], S[2], S[3]}; *(f32x4*)(so + 4) = (f32x4){S[4], S[5], S[6], S[7]}; }
}

constexpr int SD_RAW = 0, SD_G = 0, SD_CM = 43008, SD_BM = 60416, SD_HB = 77824, SD_BT = 95232, SD_XT = 113664, SD_XD = 122880, SD_XC = 132096, SD_DT = 141312, SD_ACS = 141568;
constexpr int RAW_LD = 320, CM_LD = 136, BT_LD = 72, XT_LD = 72;
__device__ __forceinline__ f32x4 mfma16(bf16x8 a, bf16x8 b, f32x4 c) { return __builtin_amdgcn_mfma_f32_16x16x32_bf16(a, b, c, 0, 0, 0); }
__device__ __forceinline__ void ssd_unit(const Params& p, const Ctx& c, int s, int hd) {
    const bool prompt = s < NB; const int row_base = prompt ? s * LP : MP + (s - NB) * SS; const int nchunks = prompt ? LP / 64 : 1; const int g = hd >> 3;
    const int tid = c.tid, lane = c.lane, w = c.wave, fr = lane & 15, fq = lane >> 4;
    const bf16* XBC = (const bf16*)(p.ws + WS_XBC); const bf16* PRW = (const bf16*)(p.ws + WS_PRW); bf16* Z = (bf16*)(p.ws + WS_Z);
    LAS bf16* RAW = (LAS bf16*)(c.lds + SD_RAW); LAS bf16* Gm = (LAS bf16*)(c.lds + SD_G); LAS bf16* CM = (LAS bf16*)(c.lds + SD_CM); LAS bf16* BM = (LAS bf16*)(c.lds + SD_BM); LAS bf16* HB = (LAS bf16*)(c.lds + SD_HB);
    LAS bf16* BT = (LAS bf16*)(c.lds + SD_BT); LAS bf16* XT = (LAS bf16*)(c.lds + SD_XT); LAS bf16* XD = (LAS bf16*)(c.lds + SD_XD); LAS bf16* XC = (LAS bf16*)(c.lds + SD_XC);
    LAS float* DT = (LAS float*)(c.lds + SD_DT); LAS float* ACS = (LAS float*)(c.lds + SD_ACS);
    const float* convw = PIN(I_CONVW); const float* convb = PIN(I_CONVB);
    const int xp = tid & 63, xch = hd * 64 + xp; float xw[4], xb = convb[xch];
#pragma unroll
    for (int i = 0; i < 4; ++i) xw[i] = convw[i * CONVD + xch];
    const int bn = tid & 127, bch = 2048 + g * 128 + bn, cch = 2560 + g * 128 + bn; float bw[4], cw[4], bb = convb[bch], cb = convb[cch];
#pragma unroll
    for (int i = 0; i < 4; ++i) { bw[i] = convw[i * CONVD + bch]; cw[i] = convw[i * CONVD + cch]; }
    const float dtb = PIN(I_DTB)[hd], aneg = -__expf(PIN(I_ALOG)[hd]), dsk = PIN(I_DSKIP)[hd];
    const int hpt = w & 3, hnt0 = (w >> 2) * 4;
    f32x4 hacc[4];
#pragma unroll
    for (int j = 0; j < 4; ++j) hacc[j] = (f32x4){0.f, 0.f, 0.f, 0.f};
    if (!prompt) { const float* st = PIN(I_SSSM) + ((size_t)(s - NB) * SSMH + hd) * 64 * 128;
#pragma unroll
        for (int j = 0; j < 4; ++j)
#pragma unroll
            for (int r = 0; r < 4; ++r) hacc[j][r] = st[(size_t)(hpt * 16 + fq * 4 + r) * 128 + (hnt0 + j) * 16 + fr]; }
    const int yit = w >> 1, ypt0 = (w & 1) * 2;
    __syncthreads();
    for (int cix = 0; cix < nchunks; ++cix) {
        for (int idx = tid; idx < 67 * 40; idx += 512) { const int rr = idx / 40, cc = idx - rr * 40; const int q = cix * 64 + rr - 3;
            const int col = cc < 8 ? hd * 64 + cc * 8 : (cc < 24 ? 2048 + g * 128 + (cc - 8) * 8 : 2560 + g * 128 + (cc - 24) * 8);
            u32x4 v = (u32x4){0u, 0u, 0u, 0u};
            if (prompt) { if (q >= PADR) v = *(const u32x4*)(XBC + (size_t)(row_base + q) * XBC_LD + col); }
            else { if (q >= 0 && q < SS) v = *(const u32x4*)(XBC + (size_t)(row_base + q) * XBC_LD + col);
                   else if (q < 0) { const float* hs = PIN(I_SCONV) + ((size_t)(s - NB) * 3 + (3 + q)) * CONVD + col; const f32x4 a = *(const f32x4*)hs, b = *(const f32x4*)(hs + 4);
                       v.x = pk2(a[0], a[1]); v.y = pk2(a[2], a[3]); v.z = pk2(b[0], b[1]); v.w = pk2(b[2], b[3]); } }
            *(LAS u32x4*)(RAW + rr * RAW_LD + cc * 8) = v; }
        if (w == 0) { const int q = cix * 64 + lane; const bool valid = prompt ? (q >= PADR) : (q < SS);
            float dtv = 0.f; if (valid) dtv = softplus_(bf2f(PRW[(size_t)(row_base + q) * PRW_LD + SHC + hd]) + dtb);
            float a = dtv * aneg;
#pragma unroll
            for (int o = 1; o < 64; o <<= 1) { const float t = __shfl_up(a, o); if (lane >= o) a += t; }
            DT[lane] = dtv; ACS[lane] = a; }
#pragma unroll
        for (int j = 0; j < 4; ++j)
#pragma unroll
            for (int r = 0; r < 4; ++r) HB[(hpt * 16 + fq * 4 + r) * CM_LD + (hnt0 + j) * 16 + fr] = (bf16)(pk2(hacc[j][r], 0.f) & 0xffffu);
        __syncthreads();
        const float acs_end = ACS[63];
#pragma unroll 2
        for (int i = 0; i < 8; ++i) { const int t = (tid >> 6) + 8 * i; const int q = cix * 64 + t; const bool valid = prompt ? (q >= PADR) : (q < SS);
            float a = xb;
#pragma unroll
            for (int k = 0; k < 4; ++k) a += bf2f(RAW[(t + k) * RAW_LD + xp]) * xw[k];
            a = valid ? silu_(a) : 0.f; const float xdt = a * DT[t];
            XC[t * XT_LD + xp] = (bf16)(pk2(a, 0.f) & 0xffffu); XT[xp * XT_LD + t] = (bf16)(pk2(xdt, 0.f) & 0xffffu); XD[xp * XT_LD + t] = (bf16)(pk2(xdt * __expf(acs_end - ACS[t]), 0.f) & 0xffffu); }
#pragma unroll 2
        for (int i = 0; i < 16; ++i) { const int t = (tid >> 7) + 4 * i; const int q = cix * 64 + t; const bool valid = prompt ? (q >= PADR) : (q < SS);
            float a = bb, b = cb;
#pragma unroll
            for (int k = 0; k < 4; ++k) { a += bf2f(RAW[(t + k) * RAW_LD + 64 + bn]) * bw[k]; b += bf2f(RAW[(t + k) * RAW_LD + 192 + bn]) * cw[k]; }
            a = valid ? silu_(a) : 0.f; b = valid ? silu_(b) : 0.f;
            const bf16 ab = (bf16)(pk2(a, 0.f) & 0xffffu); BM[t * CM_LD + bn] = ab; BT[bn * BT_LD + t] = ab; CM[t * CM_LD + bn] = (bf16)(pk2(b, 0.f) & 0xffffu); }
        __syncthreads();
        f32x4 yacc[2];
        { f32x4 cbacc[2] = {(f32x4){0.f, 0.f, 0.f, 0.f}, (f32x4){0.f, 0.f, 0.f, 0.f}}; yacc[0] = cbacc[0]; yacc[1] = cbacc[0];
#pragma unroll
          for (int kk = 0; kk < 4; ++kk) { const bf16x8 af = *(const LAS bf16x8*)(CM + (yit * 16 + fr) * CM_LD + kk * 32 + fq * 8);
#pragma unroll
              for (int j = 0; j < 2; ++j) { const bf16x8 bfm = *(const LAS bf16x8*)(BM + ((ypt0 + j) * 16 + fr) * CM_LD + kk * 32 + fq * 8); cbacc[j] = mfma16(af, bfm, cbacc[j]);
                  const bf16x8 hf = *(const LAS bf16x8*)(HB + ((ypt0 + j) * 16 + fr) * CM_LD + kk * 32 + fq * 8); yacc[j] = mfma16(af, hf, yacc[j]); } }
#pragma unroll
          for (int j = 0; j < 2; ++j)
#pragma unroll
              for (int r = 0; r < 4; ++r) { const int i = yit * 16 + fq * 4 + r, jj = (ypt0 + j) * 16 + fr; const float ai = ACS[i];
                  const float gv = (jj <= i) ? cbacc[j][r] * __expf(ai - ACS[jj]) : 0.f; Gm[i * XT_LD + jj] = (bf16)(pk2(gv, 0.f) & 0xffffu);
                  yacc[j][r] *= __expf(ai); } }
        { const float cd = __expf(acs_end);
#pragma unroll
          for (int j = 0; j < 4; ++j) hacc[j] = hacc[j] * cd;
#pragma unroll
          for (int kk = 0; kk < 2; ++kk) { const bf16x8 af = *(const LAS bf16x8*)(XD + (hpt * 16 + fr) * XT_LD + kk * 32 + fq * 8);
#pragma unroll
              for (int j = 0; j < 4; ++j) { const bf16x8 bfm = *(const LAS bf16x8*)(BT + ((hnt0 + j) * 16 + fr) * BT_LD + kk * 32 + fq * 8); hacc[j] = mfma16(af, bfm, hacc[j]); } } }
        __syncthreads();
#pragma unroll
        for (int kk = 0; kk < 2; ++kk) { const bf16x8 af = *(const LAS bf16x8*)(Gm + (yit * 16 + fr) * XT_LD + kk * 32 + fq * 8);
#pragma unroll
            for (int j = 0; j < 2; ++j) { const bf16x8 bfm = *(const LAS bf16x8*)(XT + ((ypt0 + j) * 16 + fr) * XT_LD + kk * 32 + fq * 8); yacc[j] = mfma16(af, bfm, yacc[j]); } }
#pragma unroll
        for (int j = 0; j < 2; ++j)
#pragma unroll
            for (int r = 0; r < 4; ++r) { const int i = yit * 16 + fq * 4 + r, pp = (ypt0 + j) * 16 + fr; const int q = cix * 64 + i;
                if (prompt || q < SS) { bf16* zp = Z + (size_t)(row_base + q) * Z_LD + hd * 64 + pp;
                    const float yv = (yacc[j][r] + bf2f(XC[i * XT_LD + pp]) * dsk) * bf2f(*zp); *zp = (bf16)(pk2(yv, 0.f) & 0xffffu); } }
        __syncthreads();
    }
    { float* so = p.out + (prompt ? O_PSSM + ((size_t)s * SSMH + hd) * 64 * 128 : O_SSSM + ((size_t)(s - NB) * SSMH + hd) * 64 * 128);
#pragma unroll
      for (int j = 0; j < 4; ++j)
#pragma unroll
          for (int r = 0; r < 4; ++r) so[(size_t)(hpt * 16 + fq * 4 + r) * 128 + (hnt0 + j) * 16 + fr] = hacc[j][r]; }
}
__device__ __forceinline__ void phase_mixers(const Params& p, const Ctx& c) {
    for (int u = blockIdx.x; u < 1280; u += gridDim.x) {
        int kind, s, h, hf = 0;
        if (u < 128) { kind = 0; s = (u >> 1) / RWH; h = (u >> 1) % RWH; hf = u & 1; }
        else if (u < 256) { kind = 1; s = (u - 128) / SSMH; h = (u - 128) % SSMH; }
        else if (u < 768) { const int v = u - 256; kind = 0; s = NB + (v >> 1) / RWH; h = (v >> 1) % RWH; hf = v & 1; }
        else { const int v = u - 768; kind = 1; s = NB + v / SSMH; h = v % SSMH; }
        if (kind == 0) rwkv_scan_unit(p, c, s, h, hf); else ssd_unit(p, c, s, h);
    }
}

__device__ __forceinline__ bool setup_gemm(const Params& p, int ph, pg8::Gemm& g, pg8::EpiGen& E) {
    unsigned char* ws = p.ws;
    E.o0 = nullptr; E.o1 = nullptr; E.o2 = nullptr; E.i0 = nullptr; E.i1 = nullptr; E.f0 = nullptr; E.f1 = nullptr; E.alpha = 0.f; E.scale = 0.f; E.mode = 0; E.PERM = false;
    switch (ph) {
    case 1: case 14: g.A = (const bf16*)(ws + WS_XB); g.Bt = (const bf16*)(ws + WS_GUT); g.M = MROWS; g.N = 2 * FF; g.K = D; E.mode = pg8::EM_SWIGLU; E.PERM = true; E.o0 = ws + WS_ACT; return true;
    case 2: case 15: g.A = (const bf16*)(ws + WS_ACT); g.Bt = (const bf16*)(ws + WS_DNT); g.M = MROWS; g.N = D; g.K = FF; E.mode = pg8::EM_RESID; E.o0 = ws + WS_PRE; E.i0 = ws + WS_XB; E.alpha = ALPHA; E.scale = 0.5f; return true;
    case 4: g.A = (const bf16*)(ws + WS_XB); g.Bt = (const bf16*)(ws + WS_WINT); g.M = MROWS; g.N = NINP; g.K = D; E.mode = pg8::EM_WIN; E.PERM = true; E.o0 = ws + WS_PRW; E.f0 = PIN(I_BGATE); return true;
    case 6: g.A = (const bf16*)(ws + WS_ALORA); g.Bt = (const bf16*)(ws + WS_LORAT); g.M = MROWS; g.N = 3072; g.K = 512; E.mode = pg8::EM_LORA; E.o0 = ws + WS_WDEC; E.o1 = ws + WS_BB; E.o2 = ws + WS_GBUF; E.f0 = PIN(I_W0); E.f1 = PIN(I_A0); return true;
    case 10: g.A = (const bf16*)(ws + WS_YRW); g.Bt = (const bf16*)(ws + WS_RWOT); g.M = MROWS; g.N = D; g.K = RWD; E.mode = pg8::EM_M1; E.o0 = ws + WS_T1; E.i0 = ws + WS_GATE; return true;
    case 11: g.A = (const bf16*)(ws + WS_Z); g.Bt = (const bf16*)(ws + WS_SSMOT); g.M = MROWS; g.N = D; g.K = D; E.mode = pg8::EM_M2; E.PERM = true; E.o0 = ws + WS_MERGED; E.i0 = ws + WS_GATE; E.i1 = ws + WS_T1; return true;
    case 12: g.A = (const bf16*)(ws + WS_MERGED); g.Bt = (const bf16*)(ws + WS_WOT); g.M = MROWS; g.N = D; g.K = D; E.mode = pg8::EM_RESID; E.o0 = ws + WS_PRE; E.i0 = ws + WS_XB; E.alpha = ALPHA; E.scale = 1.0f; return true;
    default: return false;
    }
}

template <int PH> __device__ __forceinline__ void run_gemm(const Params& p, const Ctx& c) {
    pg8::Gemm g; pg8::EpiGen E; setup_gemm(p, PH, g, E);
    pg8::StaticOrder S; S.init(g.M, g.N, (int)gridDim.x, (int)blockIdx.x);
    pg8::gemm_phase<pg8::EpiGen, pg8::StaticOrder, true, true>(c.lds, g, S, E);
}
__global__ void __launch_bounds__(512, 2) mega_fwd(Params p) {
    extern __shared__ __attribute__((aligned(16))) unsigned char lds_raw[];
    const int lo = p.ph_lo, hi = p.ph_hi;
#define MKCTX Ctx c; { int t_ = threadIdx.x; asm volatile("" : "+v"(t_)); c.tid = t_; c.lane = t_ & 63; c.wave = __builtin_amdgcn_readfirstlane(t_ >> 6); c.gw = blockIdx.x * 8 + c.wave; c.ngw = gridDim.x * 8; c.lds = (LAS unsigned char*)lds_raw; }
#define IN(k) (lo <= (k) && (k) < hi)
#define SEAM(k) do { if (lo <= (k) && (k) + 1 < hi) cg::this_grid().sync(); } while (0)
#if !defined(EXP_SKIP_0)
    if (IN(0)) { MKCTX
        phase_convert_x(p, c);
        transpose_w(PIN(I_GU1), D, 2 * FF, (bf16*)(p.ws + WS_GUT), 2 * FF, MAP_GU, c);
        transpose_w(PIN(I_DN1), FF, D, (bf16*)(p.ws + WS_DNT), D, MAP_ID, c);
        transpose_w(PIN(I_RWO), RWD, D, (bf16*)(p.ws + WS_RWOT), D, MAP_ID, c);
        transpose_w(PIN(I_SSMO), D, D, (bf16*)(p.ws + WS_SSMOT), D, MAP_ID, c);
        transpose_w(PIN(I_WO), D, D, (bf16*)(p.ws + WS_WOT), D, MAP_ID, c);
        build_lorat(p, c);
    }
#endif
    SEAM(0);
    if (IN(1)) { MKCTX run_gemm<1>(p, c); }
    SEAM(1);
    if (IN(2)) { MKCTX run_gemm<2>(p, c); }
    SEAM(2);
#if !defined(EXP_SKIP_3)
    if (IN(3)) { MKCTX phase_ln<false>(p, c, PIN(I_LN1G), PIN(I_LN1B)); transpose_w(PIN(I_WIN), D, 12768, (bf16*)(p.ws + WS_WINT), NINP, MAP_WIN, c); }
#endif
    SEAM(3);
    if (IN(4)) { MKCTX run_gemm<4>(p, c); }
    SEAM(4);
#if !defined(EXP_SKIP_5)
    if (IN(5)) { MKCTX phase_prep1(p, c); }
#endif
    SEAM(5);
    if (IN(6)) { MKCTX run_gemm<6>(p, c); }
    SEAM(6);
#if !defined(EXP_SKIP_7)
    if (IN(7)) { MKCTX phase_prep2(p, c); }
#endif
    SEAM(7);
#if !defined(EXP_SKIP_8)
    if (IN(8)) { MKCTX phase_mixers(p, c); }
#endif
    SEAM(8);
#if !defined(EXP_SKIP_9)
    if (IN(9)) { MKCTX phase_post(p, c); }
#endif
    SEAM(9);
    if (IN(10)) { MKCTX run_gemm<10>(p, c); }
    SEAM(10);
    if (IN(11)) { MKCTX run_gemm<11>(p, c); }
    SEAM(11);
    if (IN(12)) { MKCTX run_gemm<12>(p, c); }
    SEAM(12);
#if !defined(EXP_SKIP_13)
    if (IN(13)) { MKCTX phase_ln<false>(p, c, PIN(I_LN2G), PIN(I_LN2B)); transpose_w(PIN(I_GU2), D, 2 * FF, (bf16*)(p.ws + WS_GUT), 2 * FF, MAP_GU, c); transpose_w(PIN(I_DN2), FF, D, (bf16*)(p.ws + WS_DNT), D, MAP_ID, c); }
#endif
    SEAM(13);
    if (IN(14)) { MKCTX run_gemm<14>(p, c); }
    SEAM(14);
    if (IN(15)) { MKCTX run_gemm<15>(p, c); }
    SEAM(15);
#if !defined(EXP_SKIP_16)
    if (IN(16)) { MKCTX phase_ln<true>(p, c, PIN(I_LN3G), PIN(I_LN3B)); }
#endif
#undef IN
#undef MKCTX
#undef SEAM
}

extern "C" void kernel_launch(void* const* d_in, const int* in_sizes, int n_in, void* d_out, int out_size, void* d_ws, size_t ws_size, hipStream_t stream) {
    static int grid = 0;
    if (!grid) {
        if (n_in != N_IN || (size_t)out_size != O_END || ws_size < WS_END) { fprintf(stderr, "kernel_launch: unexpected shapes (n_in %d, out %d, ws %zu)\n", n_in, out_size, ws_size); grid = -1; return; }
        int dev = 0, cus = 0, per_cu = 0;
        hipGetDevice(&dev); hipDeviceGetAttribute(&cus, hipDeviceAttributeMultiprocessorCount, dev);
        hipFuncSetAttribute((const void*)mega_fwd, hipFuncAttributeMaxDynamicSharedMemorySize, LDS_BYTES);
        hipOccupancyMaxActiveBlocksPerMultiprocessor(&per_cu, (const void*)mega_fwd, 512, LDS_BYTES);
        if (per_cu < 1) { fprintf(stderr, "kernel_launch: occupancy query says %d blocks per CU\n", per_cu); per_cu = 1; }
        grid = cus;
    }
    if (grid < 0) return;
    Params p{};
    for (int i = 0; i < N_IN; ++i) p.in[i] = (const float*)d_in[i];
    p.out = (float*)d_out; p.ws = (unsigned char*)d_ws;
#if MK_SINGLE_LAUNCH
    p.ph_lo = 0; p.ph_hi = NPHASE;
    void* args[] = {&p};
    hipError_t e = hipLaunchCooperativeKernel((const void*)mega_fwd, dim3(grid), dim3(512), args, LDS_BYTES, stream);
    if (e != hipSuccess) fprintf(stderr, "cooperative launch failed: %s (grid %d)\n", hipGetErrorString(e), grid);
#else
    for (int ph = 0; ph < NPHASE; ++ph) { p.ph_lo = ph; p.ph_hi = ph + 1; hipLaunchKernelGGL(mega_fwd, dim3(grid), dim3(512), LDS_BYTES, stream, p); }
#endif
}
```

```cpp
#include <hip/hip_runtime.h>
#include <hip/hip_cooperative_groups.h>
#include <cstdio>
#include <cstdint>
namespace cg = cooperative_groups;

#ifndef MK_SINGLE_LAUNCH
#define MK_SINGLE_LAUNCH 1
#endif

namespace pg8 {
#define PG8_LAS __attribute__((address_space(3)))
typedef unsigned short bf16_t;
typedef short bf16x8 __attribute__((ext_vector_type(8)));
typedef float f32x4 __attribute__((ext_vector_type(4)));
typedef unsigned u32x4 __attribute__((ext_vector_type(4)));
constexpr int BM = 256, BK = 64, HALF = 128, HTB = HALF * BK * 2  , STAGE_BYTES = 8 * HTB, NXCD = 8, WGM = 8;

__host__ __device__ __forceinline__ int lds_byte(int r, int c) { const int st = (r >> 4) * 2 + (c >> 5), rr = r & 15, cc = c & 31, ob = rr * 64 + cc * 2; return st * 1024 + (ob ^ (((ob >> 9) & 1) << 5)); }
__host__ __device__ __forceinline__ void stage_rc(int b, int& R, int& C) { const int st = b / 1024, sb = b % 1024, swz = sb ^ (((sb >> 9) & 1) << 5); R = (st >> 1) * 16 + swz / 64; C = (st & 1) * 32 + (swz % 64) / 2; }
__host__ __device__ __forceinline__ int perm32(int rho) { const int n = rho >> 4, i = rho & 15; return 8 * (i >> 2) + 4 * n + (i & 3); }

struct Unit { int pm, pn; };
struct Gemm { const bf16_t* A; const bf16_t* Bt; int M, N, K; };

struct StaticOrder {
    int nM, nN, nwg, G, c;
    __host__ __device__ void init(int M, int N, int G_, int c_) { nM = M / BM; nN = N / BM; nwg = nM * nN; G = G_; c = c_; }
    __host__ __device__ bool next(int i, Unit& u) const {
        const long L = (long)i * G + c; if (L >= nwg) return false;
        int wgid = (int)L; { const int q = nwg / NXCD, r = nwg % NXCD, xcd = wgid % NXCD, off = wgid / NXCD; wgid = (xcd < r ? xcd * (q + 1) : r * (q + 1) + (xcd - r) * q) + off; }
        const int nig = WGM * nN, gid = wgid / nig, fm = gid * WGM, gsz = (nM - fm) < WGM ? (nM - fm) : WGM;
        u.pm = fm + ((wgid % nig) % gsz); u.pn = (wgid % nig) / gsz; return true;
    }
    __device__ __forceinline__ void a_ready(const Unit&) const {}
    __device__ __forceinline__ void done(const Unit&) const {}
};

__device__ __forceinline__ unsigned cvt_pk_bf16(float lo, float hi) { unsigned r; asm volatile("v_cvt_pk_bf16_f32 %0, %1, %2" : "=v"(r) : "v"(lo), "v"(hi)); return r; }

__device__ __forceinline__ float bf2f(unsigned short h) { return __uint_as_float(((unsigned)h) << 16); }
__device__ __forceinline__ float bflo(unsigned w) { return __uint_as_float(w << 16); }
__device__ __forceinline__ float bfhi(unsigned w) { return __uint_as_float(w & 0xffff0000u); }
__device__ __forceinline__ float sigm(float x) { return 1.0f / (1.0f + __expf(-x)); }
__device__ __forceinline__ float silu_(float x) { return x / (1.0f + __expf(-x)); }
typedef unsigned u32x2 __attribute__((ext_vector_type(2)));

enum { EM_SWIGLU = 0, EM_RESID = 1, EM_WIN = 2, EM_LORA = 3, EM_M1 = 4, EM_M2 = 5 };
struct EpiGen {
    static constexpr bool AFTER_DRAIN = false;
    int mode; bool PERM;
    void* o0; void* o1; void* o2; const void* i0; const void* i1; const float* f0; const float* f1;
    float alpha, scale;
    __device__ __forceinline__ void operator()(const f32x4 (&acc)[2][2][4][2], const Unit& u, int wr, int wc, int fr, int fq) const {
        const int row0 = u.pm * BM + wr * 64 + fr;
        if (mode == EM_SWIGLU) {
            bf16_t* O = (bf16_t*)o0; const int col0 = u.pn * 128 + wc * 32 + 8 * fq;
#pragma unroll
            for (int ai = 0; ai < 2; ++ai)
#pragma unroll
                for (int m = 0; m < 4; ++m) { bf16_t* rowp = O + (size_t)(row0 + ai * HALF + m * 16) * 5632 + col0;
                    const f32x4 g0 = acc[ai][0][m][0], g1 = acc[ai][0][m][1], u0 = acc[ai][1][m][0], u1 = acc[ai][1][m][1];
                    f32x4 v0, v1;
#pragma unroll
                    for (int j = 0; j < 4; ++j) { v0[j] = silu_(g0[j]) * u0[j]; v1[j] = silu_(g1[j]) * u1[j]; }
                    u32x4 w; w.x = cvt_pk_bf16(v0[0], v0[1]); w.y = cvt_pk_bf16(v0[2], v0[3]); w.z = cvt_pk_bf16(v1[0], v1[1]); w.w = cvt_pk_bf16(v1[2], v1[3]);
                    *(u32x4*)rowp = w; }
        } else if (mode == EM_RESID) {
            float* C = (float*)o0; const bf16_t* R = (const bf16_t*)i0; const int col0 = u.pn * BM + wc * 32 + 4 * fq;
#pragma unroll
            for (int ai = 0; ai < 2; ++ai)
#pragma unroll
                for (int m = 0; m < 4; ++m) { const size_t off = (size_t)(row0 + ai * HALF + m * 16) * 2048 + col0;
#pragma unroll
                    for (int bj = 0; bj < 2; ++bj)
#pragma unroll
                        for (int n = 0; n < 2; ++n) { const u32x2 rv = *(const u32x2*)(R + off + bj * HALF + n * 16);
                            f32x4 o; o[0] = alpha * bflo(rv.x) + scale * acc[ai][bj][m][n][0]; o[1] = alpha * bfhi(rv.x) + scale * acc[ai][bj][m][n][1];
                            o[2] = alpha * bflo(rv.y) + scale * acc[ai][bj][m][n][2]; o[3] = alpha * bfhi(rv.y) + scale * acc[ai][bj][m][n][3];
                            *(f32x4*)(C + off + bj * HALF + n * 16) = o; } }
        } else if (mode == EM_WIN) {
            const int pn = u.pn; bf16_t* O; int ld, colt, act;
            if (pn < 14) { O = (bf16_t*)o0; ld = 3584; colt = pn * BM; act = 0; }
            else if (pn < 22) { O = (bf16_t*)o0 + (size_t)8704 * 3584; ld = 2048; colt = (pn - 14) * BM; act = 1; }
            else if (pn < 34) { O = (bf16_t*)o0 + (size_t)8704 * (3584 + 2048); ld = 3072; colt = (pn - 22) * BM; act = 0; }
            else { O = (bf16_t*)o0 + (size_t)8704 * (3584 + 2048 + 3072); ld = 4096; colt = (pn - 34) * BM; act = 2; }
            const int col0 = colt + wc * 32 + 8 * fq;
            f32x4 bv[2][2];
#pragma unroll
            for (int bj = 0; bj < 2; ++bj)
#pragma unroll
                for (int n = 0; n < 2; ++n) bv[bj][n] = (act == 2) ? *(const f32x4*)(f0 + col0 + bj * HALF + 4 * n) : (f32x4){0.f, 0.f, 0.f, 0.f};
#pragma unroll
            for (int ai = 0; ai < 2; ++ai)
#pragma unroll
                for (int m = 0; m < 4; ++m) { bf16_t* rowp = O + (size_t)(row0 + ai * HALF + m * 16) * ld + col0;
#pragma unroll
                    for (int bj = 0; bj < 2; ++bj) { f32x4 v0 = acc[ai][bj][m][0] + bv[bj][0], v1 = acc[ai][bj][m][1] + bv[bj][1];
                        if (act == 1) {
#pragma unroll
                            for (int j = 0; j < 4; ++j) { v0[j] = silu_(v0[j]); v1[j] = silu_(v1[j]); } }
                        else if (act == 2) {
#pragma unroll
                            for (int j = 0; j < 4; ++j) { v0[j] = sigm(v0[j]); v1[j] = sigm(v1[j]); } }
                        u32x4 w; w.x = cvt_pk_bf16(v0[0], v0[1]); w.y = cvt_pk_bf16(v0[2], v0[3]); w.z = cvt_pk_bf16(v1[0], v1[1]); w.w = cvt_pk_bf16(v1[2], v1[3]);
                        *(u32x4*)(rowp + bj * HALF) = w; } }
        } else if (mode == EM_LORA) {
            const int pn = u.pn; const int col0 = (pn & 3) * BM + wc * 32 + 4 * fq;
            if (pn < 4) {
#pragma unroll
                for (int ai = 0; ai < 2; ++ai)
#pragma unroll
                    for (int m = 0; m < 4; ++m) { const size_t off = (size_t)(row0 + ai * HALF + m * 16) * 1024 + col0;
#pragma unroll
                        for (int bj = 0; bj < 2; ++bj)
#pragma unroll
                            for (int n = 0; n < 2; ++n) { const int c = col0 + bj * HALF + n * 16; const f32x4 a = acc[ai][bj][m][n]; const f32x4 b = *(const f32x4*)(f0 + c); f32x4 o;
#pragma unroll
                                for (int j = 0; j < 4; ++j) o[j] = __expf(-0.6065306597f * sigm(a[j] + b[j]));
                                *(f32x4*)((float*)o0 + off + bj * HALF + n * 16) = o; } }
            } else if (pn < 8) {
#pragma unroll
                for (int ai = 0; ai < 2; ++ai)
#pragma unroll
                    for (int m = 0; m < 4; ++m) { const size_t off = (size_t)(row0 + ai * HALF + m * 16) * 1024 + col0;
#pragma unroll
                        for (int bj = 0; bj < 2; ++bj)
#pragma unroll
                            for (int n = 0; n < 2; ++n) { const int c = col0 + bj * HALF + n * 16; const f32x4 a = acc[ai][bj][m][n]; const f32x4 b = *(const f32x4*)(f1 + c);
                                u32x2 w; w.x = cvt_pk_bf16(sigm(a[0] + b[0]), sigm(a[1] + b[1])); w.y = cvt_pk_bf16(sigm(a[2] + b[2]), sigm(a[3] + b[3]));
                                *(u32x2*)((bf16_t*)o1 + off + bj * HALF + n * 16) = w; } }
            } else {
#pragma unroll
                for (int ai = 0; ai < 2; ++ai)
#pragma unroll
                    for (int m = 0; m < 4; ++m) { const size_t off = (size_t)(row0 + ai * HALF + m * 16) * 1024 + col0;
#pragma unroll
                        for (int bj = 0; bj < 2; ++bj)
#pragma unroll
                            for (int n = 0; n < 2; ++n) { const f32x4 a = acc[ai][bj][m][n];
                                u32x2 w; w.x = cvt_pk_bf16(a[0], a[1]); w.y = cvt_pk_bf16(a[2], a[3]); *(u32x2*)((bf16_t*)o2 + off + bj * HALF + n * 16) = w; } }
            }
        } else if (mode == EM_M1) {
            float* C = (float*)o0; const bf16_t* Gt = (const bf16_t*)i0; const int col0 = u.pn * BM + wc * 32 + 4 * fq;
#pragma unroll
            for (int ai = 0; ai < 2; ++ai)
#pragma unroll
                for (int m = 0; m < 4; ++m) { const size_t r = (size_t)(row0 + ai * HALF + m * 16);
#pragma unroll
                    for (int bj = 0; bj < 2; ++bj)
#pragma unroll
                        for (int n = 0; n < 2; ++n) { const int c = col0 + bj * HALF + n * 16; const u32x2 gv = *(const u32x2*)(Gt + r * 4096 + c); const f32x4 a = acc[ai][bj][m][n];
                            f32x4 o; o[0] = bflo(gv.x) * a[0]; o[1] = bfhi(gv.x) * a[1]; o[2] = bflo(gv.y) * a[2]; o[3] = bfhi(gv.y) * a[3];
                            *(f32x4*)(C + r * 2048 + c) = o; } }
        } else {
            bf16_t* O = (bf16_t*)o0; const bf16_t* Gt = (const bf16_t*)i0; const float* T1 = (const float*)i1; const int col0 = u.pn * BM + wc * 32 + 8 * fq;
#pragma unroll
            for (int ai = 0; ai < 2; ++ai)
#pragma unroll
                for (int m = 0; m < 4; ++m) { const size_t r = (size_t)(row0 + ai * HALF + m * 16);
#pragma unroll
                    for (int bj = 0; bj < 2; ++bj) { const int c = col0 + bj * HALF; const u32x4 gv = *(const u32x4*)(Gt + r * 4096 + 2048 + c);
                        const f32x4 t0 = *(const f32x4*)(T1 + r * 2048 + c), t1 = *(const f32x4*)(T1 + r * 2048 + c + 4); const f32x4 a0 = acc[ai][bj][m][0], a1 = acc[ai][bj][m][1];
                        u32x4 w; w.x = cvt_pk_bf16(t0[0] + bflo(gv.x) * a0[0], t0[1] + bfhi(gv.x) * a0[1]); w.y = cvt_pk_bf16(t0[2] + bflo(gv.y) * a0[2], t0[3] + bfhi(gv.y) * a0[3]);
                        w.z = cvt_pk_bf16(t1[0] + bflo(gv.z) * a1[0], t1[1] + bfhi(gv.z) * a1[1]); w.w = cvt_pk_bf16(t1[2] + bflo(gv.w) * a1[2], t1[3] + bfhi(gv.w) * a1[3]);
                        *(u32x4*)(O + r * 2048 + c) = w; } }
        }
    }
};
template <class Epi, class Sched, bool ALIGN_EPI = false, bool SP2 = false>
__device__ __forceinline__ void gemm_phase(PG8_LAS unsigned char* lds, const Gemm g, const Sched& S, const Epi& E) {
    const int tid = threadIdx.x, wid = __builtin_amdgcn_readfirstlane(tid >> 6), lane = tid & 63, wr = wid >> 2, wc = wid & 3, fr = lane & 15, fq = lane >> 4;
    const int K = g.K, nt = K / BK;
    unsigned voffA[2], voffB[2];
#pragma unroll
    for (int i = 0; i < 2; ++i) { int R, C; stage_rc(tid * 16 + i * 8192, R, C); const int Rb = E.PERM ? ((R & ~31) + perm32(R & 31)) : R;
        voffA[i] = (unsigned)(R * K + C) * 2u; voffB[i] = (unsigned)(Rb * K + C) * 2u; }
    const size_t kstep = (size_t)(BK * 2);
    const size_t hstep = (size_t)HALF * K * 2;
    const size_t tstep = 2 * hstep;
    const unsigned ldsw = (unsigned)wid * 1024u;
    const int aoff = lds_byte(wr * 64 + fr, fq * 8), boff = lds_byte(wc * 32 + fr, fq * 8);
#define PG8_SA(b, h) (((b) * 2 + (h)) * HTB)
#define PG8_SB(b, h) ((4 + (b) * 2 + (h)) * HTB)
#define PG8_STAGE(bufoff, gbase, voff) do { _Pragma("unroll") for (int _i = 0; _i < 2; ++_i) \
        __builtin_amdgcn_global_load_lds((const unsigned*)((const char*)(gbase) + (voff)[_i]), (PG8_LAS unsigned*)(lds + (bufoff) + ldsw + _i * 8192), 16, 0, 0); } while (0)
#define PG8_LDA(dst, b, h) do { _Pragma("unroll") for (int m = 0; m < 4; ++m) _Pragma("unroll") for (int k = 0; k < 2; ++k) dst[m][k] = *(const PG8_LAS bf16x8*)(lds + PG8_SA(b, h) + aoff + m * 2048 + k * 1024); } while (0)
#define PG8_LDB(dst, b, h) do { _Pragma("unroll") for (int n = 0; n < 2; ++n) _Pragma("unroll") for (int k = 0; k < 2; ++k) dst[n][k] = *(const PG8_LAS bf16x8*)(lds + PG8_SB(b, h) + boff + n * 2048 + k * 1024); } while (0)
#define PG8_MMA(ai, bj, At, Bt) do { __builtin_amdgcn_s_setprio(1); _Pragma("unroll") for (int m = 0; m < 4; ++m) _Pragma("unroll") for (int n = 0; n < 2; ++n) _Pragma("unroll") for (int k = 0; k < 2; ++k) \
        acc[ai][bj][m][n] = __builtin_amdgcn_mfma_f32_16x16x32_bf16(Bt[n][k], At[m][k], acc[ai][bj][m][n], 0, 0, 0); __builtin_amdgcn_s_setprio(0); } while (0)
#define PG8_WAIT_V(n) asm volatile("s_waitcnt vmcnt(" #n ")" ::: "memory")
#define PG8_WAIT_L(n) asm volatile("s_waitcnt lgkmcnt(" #n ")" ::: "memory")
#define PG8_BAR __builtin_amdgcn_s_barrier()
#define PG8_SCHED __builtin_amdgcn_sched_barrier(0)
    Unit cur, nxt; int ui = 0;
    if (!S.next(0, cur)) return;
    f32x4 acc[2][2][4][2];
#pragma unroll
    for (int a = 0; a < 2; ++a)
#pragma unroll
        for (int b = 0; b < 2; ++b)
#pragma unroll
            for (int m = 0; m < 4; ++m)
#pragma unroll
                for (int n = 0; n < 2; ++n) acc[a][b][m][n] = (f32x4){0.f, 0.f, 0.f, 0.f};
    bf16x8 At[4][2], B0[2][2], B1[2][2];
    const char* cA = (const char*)g.A + (size_t)cur.pm * tstep; const char* cB = (const char*)g.Bt + (size_t)cur.pn * tstep;
    S.a_ready(cur);
    if constexpr (SP2) {
        PG8_STAGE(PG8_SB(0, 0), cB, voffB); PG8_STAGE(PG8_SB(0, 1), cB + hstep, voffB); PG8_STAGE(PG8_SA(0, 0), cA, voffA); PG8_STAGE(PG8_SA(0, 1), cA + hstep, voffA);
        if (wr == 1) PG8_BAR;
        PG8_WAIT_V(2); PG8_BAR;
        PG8_STAGE(PG8_SB(1, 0), cB + kstep, voffB); PG8_STAGE(PG8_SA(1, 0), cA + kstep, voffA); PG8_STAGE(PG8_SB(1, 1), cB + hstep + kstep, voffB);
        PG8_WAIT_V(6); PG8_BAR;
    } else {
        PG8_STAGE(PG8_SB(0, 0), cB, voffB); PG8_STAGE(PG8_SA(0, 0), cA, voffA); PG8_STAGE(PG8_SB(0, 1), cB + hstep, voffB); PG8_STAGE(PG8_SA(0, 1), cA + hstep, voffA);
        if (wr == 1) PG8_BAR;
        PG8_WAIT_V(4); PG8_BAR;
        PG8_STAGE(PG8_SB(1, 0), cB + kstep, voffB); PG8_STAGE(PG8_SA(1, 0), cA + kstep, voffA); PG8_STAGE(PG8_SB(1, 1), cB + hstep + kstep, voffB);
        PG8_WAIT_V(6); PG8_BAR;
    }
    for (;;) {
        const bool has_next = S.next(ui + 1, nxt);
        const char* nA = has_next ? (const char*)g.A + (size_t)nxt.pm * tstep : cA; const char* nB = has_next ? (const char*)g.Bt + (size_t)nxt.pn * tstep : cB;
        for (int t = 0; t < nt; t += 2) {
            const bool last = (t == nt - 2);
            const char* a1 = cA + (size_t)(t + 1) * kstep;
            const char* a2 = last ? nA : cA + (size_t)(t + 2) * kstep; const char* b2 = last ? nB : cB + (size_t)(t + 2) * kstep;
            const char* a3 = a2 + kstep; const char* b3 = b2 + kstep;
            if (last && has_next) S.a_ready(nxt);
            if constexpr (SP2) {
            PG8_LDB(B0, 0, 0); PG8_LDB(B1, 0, 1); PG8_SCHED; PG8_LDA(At, 0, 0); PG8_STAGE(PG8_SA(1, 1), a1 + hstep, voffA);
            PG8_WAIT_V(8); PG8_WAIT_L(0); PG8_BAR; PG8_MMA(0, 0, At, B0); PG8_MMA(0, 1, At, B1); PG8_BAR; PG8_SCHED;
            PG8_LDA(At, 0, 1); PG8_STAGE(PG8_SB(0, 0), b2, voffB); PG8_STAGE(PG8_SB(0, 1), b2 + hstep, voffB); PG8_STAGE(PG8_SA(0, 0), a2, voffA);
            PG8_WAIT_V(8); PG8_WAIT_L(0); PG8_BAR; PG8_MMA(1, 0, At, B0); PG8_MMA(1, 1, At, B1); PG8_BAR; PG8_SCHED;
            PG8_LDB(B0, 1, 0); PG8_LDB(B1, 1, 1); PG8_SCHED; PG8_LDA(At, 1, 0); PG8_STAGE(PG8_SA(0, 1), a2 + hstep, voffA);
            PG8_WAIT_V(8); PG8_WAIT_L(0); PG8_BAR; PG8_MMA(0, 0, At, B0); PG8_MMA(0, 1, At, B1); PG8_BAR; PG8_SCHED;
            PG8_LDA(At, 1, 1); PG8_STAGE(PG8_SB(1, 0), b3, voffB); PG8_STAGE(PG8_SB(1, 1), b3 + hstep, voffB); PG8_STAGE(PG8_SA(1, 0), a3, voffA);
            PG8_WAIT_V(8); PG8_WAIT_L(0); PG8_BAR; PG8_MMA(1, 0, At, B0); PG8_MMA(1, 1, At, B1); PG8_BAR; PG8_SCHED;
            } else {
            PG8_LDB(B0, 0, 0); PG8_SCHED; PG8_LDA(At, 0, 0); PG8_STAGE(PG8_SA(1, 1), a1 + hstep, voffA);
            PG8_WAIT_L(8); PG8_BAR; PG8_WAIT_L(0); PG8_MMA(0, 0, At, B0); PG8_BAR; PG8_SCHED;
            PG8_LDB(B1, 0, 1); PG8_STAGE(PG8_SB(0, 0), b2, voffB);
            PG8_BAR; PG8_WAIT_L(0); PG8_MMA(0, 1, At, B1); PG8_BAR;
            PG8_LDA(At, 0, 1); PG8_STAGE(PG8_SA(0, 0), a2, voffA);
            PG8_BAR; PG8_WAIT_L(0); PG8_MMA(1, 0, At, B0); PG8_BAR; PG8_SCHED;
            PG8_STAGE(PG8_SB(0, 1), b2 + hstep, voffB);
            PG8_WAIT_V(6); PG8_BAR; PG8_MMA(1, 1, At, B1); PG8_BAR;
            PG8_LDB(B0, 1, 0); PG8_SCHED; PG8_LDA(At, 1, 0); PG8_STAGE(PG8_SA(0, 1), a2 + hstep, voffA);
            PG8_WAIT_L(8); PG8_BAR; PG8_WAIT_L(0); PG8_MMA(0, 0, At, B0); PG8_BAR; PG8_SCHED;
            PG8_LDB(B1, 1, 1); PG8_STAGE(PG8_SB(1, 0), b3, voffB);
            PG8_BAR; PG8_WAIT_L(0); PG8_MMA(0, 1, At, B1); PG8_BAR;
            PG8_LDA(At, 1, 1); PG8_STAGE(PG8_SA(1, 0), a3, voffA);
            PG8_BAR; PG8_WAIT_L(0); PG8_MMA(1, 0, At, B0); PG8_BAR; PG8_SCHED;
            PG8_STAGE(PG8_SB(1, 1), b3 + hstep, voffB);
            PG8_WAIT_V(6); PG8_BAR; PG8_MMA(1, 1, At, B1); PG8_BAR;
            }
        }
        if constexpr (ALIGN_EPI) { if (wr == 0) PG8_BAR; }
        if constexpr (!Epi::AFTER_DRAIN) { E(acc, cur, wr, wc, fr, fq); S.done(cur); }
        if (!has_next) break;
#pragma unroll
        for (int a = 0; a < 2; ++a)
#pragma unroll
            for (int b = 0; b < 2; ++b)
#pragma unroll
                for (int m = 0; m < 4; ++m)
#pragma unroll
                    for (int n = 0; n < 2; ++n) acc[a][b][m][n] = (f32x4){0.f, 0.f, 0.f, 0.f};
        cur = nxt; cA = nA; cB = nB; ++ui;
        if constexpr (ALIGN_EPI) { if (wr == 1) PG8_BAR; }
    }
    PG8_WAIT_V(0);
    if constexpr (!ALIGN_EPI) { if (wr == 0) PG8_BAR; }
    PG8_BAR;
    if constexpr (Epi::AFTER_DRAIN) { E.fused(acc, cur, wr, wc, fr, fq, lds, wid, lane); S.done(cur); }
#undef PG8_SA
#undef PG8_SB
#undef PG8_STAGE
#undef PG8_LDA
#undef PG8_LDB
#undef PG8_MMA
#undef PG8_WAIT_V
#undef PG8_WAIT_L
#undef PG8_BAR
#undef PG8_SCHED
}
}

#define LAS __attribute__((address_space(3)))
typedef unsigned short bf16;
typedef float f32x4 __attribute__((ext_vector_type(4)));
typedef unsigned u32x4 __attribute__((ext_vector_type(4)));
typedef unsigned u32x2 __attribute__((ext_vector_type(2)));
typedef short bf16x8 __attribute__((ext_vector_type(8)));
using pg8::bf2f; using pg8::bflo; using pg8::bfhi; using pg8::sigm; using pg8::silu_; using pg8::cvt_pk_bf16;

constexpr int D = 2048, FF = 5632, NB = 4, SEQ = 2048, NMETA = 16, PADR = 48, LP = 2112  , TP = 2064  ;
constexpr int SB = 16, SS = 16, MP = NB * LP  , MROWS = MP + SB * SS  ;
constexpr int RWD = 1024, RWH = 16, SHC = 3520, CONVD = 3072, SSMH = 32, SSMN = 128, NINP = 12800;
constexpr int PRW_LD = 3584, Z_LD = 2048, XBC_LD = 3072, GATE_LD = 4096;
constexpr float LN_EPS = 1e-5f, ALPHA = 1.189207115f  , GN_EPS = 64e-5f, RMS_EPS = 1e-5f;
constexpr int NPHASE = 17;
constexpr int LDS_BYTES = 147456;

enum { I_XP = 0, I_XS, I_SSH, I_SWKV, I_SCONV, I_SSSM, I_META, I_GU1, I_DN1, I_LN1G, I_LN1B, I_WIN, I_BGATE, I_MU, I_W0, I_W2, I_A0, I_A2, I_G2, I_KK, I_KA, I_RK, I_GNW, I_GNB,
       I_CONVW, I_CONVB, I_DTB, I_ALOG, I_DSKIP, I_NORMW, I_RWO, I_SSMO, I_WO, I_LN2G, I_LN2B, I_GU2, I_DN2, I_LN3G, I_LN3B, N_IN };
constexpr size_t O_YP = 0, O_YS = 16777216, O_PSH = 17301504, O_PWKV = 17315584, O_PCONV = 17577728, O_PSSM = 17614592, O_SSH = 18663168, O_SWKV = 18719488, O_SCONV = 19768064, O_SSSM = 19915520, O_END = 24109824;
constexpr size_t MiB = 1u << 20;
constexpr size_t WS_SBON = 1 * MiB, WS_RWOT = 2 * MiB, WS_SSMOT = 6 * MiB, WS_WOT = 14 * MiB, WS_LORAT = 22 * MiB, WS_WBIG = 25 * MiB, WS_XB = 91 * MiB, WS_ACT = 125 * MiB, WS_PROJ = 219 * MiB, WS_YRW = 432 * MiB, WS_END = 449 * MiB;
constexpr size_t WS_GUT = WS_WBIG, WS_DNT = WS_WBIG + 44 * MiB, WS_WINT = WS_WBIG, WS_WDEC = WS_WBIG, WS_GBUF = WS_WBIG + 34 * MiB, WS_MERGED = WS_WBIG;
constexpr size_t WS_R = WS_ACT, WS_KP = WS_ACT + 17 * MiB, WS_V = WS_ACT + 34 * MiB, WS_KK = WS_ACT + 51 * MiB, WS_BB = WS_ACT + 68 * MiB, WS_ALORA = WS_ACT + 85 * MiB, WS_T1 = WS_ACT;
constexpr size_t WS_PRW = WS_PROJ, WS_Z = WS_PRW + (size_t)MROWS * PRW_LD * 2, WS_XBC = WS_Z + (size_t)MROWS * Z_LD * 2, WS_GATE = WS_XBC + (size_t)MROWS * XBC_LD * 2, WS_PRE = WS_PROJ;
static_assert(WS_GATE + (size_t)MROWS * GATE_LD * 2 <= WS_YRW, "proj region");
static_assert(WS_ALORA + (size_t)MROWS * 512 * 2 <= WS_PROJ, "act region");

struct Params { const float* in[N_IN]; float* out; unsigned char* ws; int ph_lo, ph_hi; };

__device__ __forceinline__ int opaque_idx(int i) { asm volatile("" : "+s"(i)); return i; }
#define PIN(i) (p.in[opaque_idx(i)])
struct Ctx { int tid, lane, wave, gw, ngw; LAS unsigned char* lds; };

__device__ __forceinline__ float wave_sum(float v) {
#pragma unroll
    for (int o = 1; o < 64; o <<= 1) v += __shfl_xor(v, o);
    return v;
}
__device__ __forceinline__ unsigned pk2(float lo, float hi) { return cvt_pk_bf16(lo, hi); }
__device__ __forceinline__ float softplus_(float x) { return fmaxf(x, 0.f) + __logf(1.f + __expf(-fabsf(x))); }

__device__ __forceinline__ const float* xrow_ptr(const Params& p, int row) {
    if (row < MP) { const int b = row / LP, q = row - b * LP; if (q < PADR) return nullptr; const int t = q - PADR;
        return t < NMETA ? PIN(I_META) + (size_t)t * D : PIN(I_XP) + ((size_t)b * SEQ + (t - NMETA)) * D; }
    return PIN(I_XS) + (size_t)(row - MP) * D;
}
__device__ __forceinline__ float* yrow_ptr(const Params& p, int row) {
    if (row < MP) { const int b = row / LP, q = row - b * LP; if (q < PADR + NMETA) return nullptr; return p.out + O_YP + ((size_t)b * SEQ + (q - PADR - NMETA)) * D; }
    return p.out + O_YS + (size_t)(row - MP) * D;
}
__device__ __forceinline__ bool row_is_pad(int row) { return row < MP && (row % LP) < PADR; }

__device__ __forceinline__ void phase_convert_x(const Params& p, const Ctx& c) {
    bf16* XB = (bf16*)(p.ws + WS_XB);
    for (int row = c.gw; row < MROWS; row += c.ngw) { const float* src = xrow_ptr(p, row); u32x2* dst = (u32x2*)(XB + (size_t)row * D);
#pragma unroll
        for (int j = 0; j < 8; ++j) { f32x4 v = src ? ((const f32x4*)src)[c.lane + 64 * j] : (f32x4){0.f, 0.f, 0.f, 0.f}; u32x2 w; w.x = pk2(v[0], v[1]); w.y = pk2(v[2], v[3]); dst[c.lane + 64 * j] = w; } }
}
enum { MAP_ID = 0, MAP_GU = 1, MAP_WIN = 2 };
__device__ __forceinline__ int map_src_col(int kind, int c) {
    if (kind == MAP_ID) return c;
    if (kind == MAP_GU) { const int pn = c >> 8, bj = (c >> 7) & 1, r = c & 127; return bj * FF + 128 * pn + r; }
    if (c < 3520) return c; if (c < 3552) return 8640 + (c - 3520); if (c < 3584) return -1; if (c < 5632) return 3520 + (c - 3584); if (c < 8704) return 5568 + (c - 5632); return 8672 + (c - 8704);
}
__device__ __forceinline__ void transpose_w(const float* W, int K, int Nsrc, bf16* WT, int ndst, int kind, const Ctx& c) {
    LAS float* scr = (LAS float*)(c.lds + c.wave * 8704);
    const int nblk = ndst / 32, nitems = (K / 64) * nblk, lane = c.lane;
    for (int it = c.gw; it < nitems; it += c.ngw) {
        const int kb = it / nblk, nb = it - kb * nblk, k0 = 64 * kb, n0 = 32 * nb; const int sc = map_src_col(kind, n0);
        if (sc >= 0) {
#pragma unroll 8
            for (int i = 0; i < 32; ++i) { const int kk = 2 * i + (lane >> 5); scr[kk * 33 + (lane & 31)] = W[(size_t)(k0 + kk) * Nsrc + sc + (lane & 31)]; }
        } else {
#pragma unroll 8
            for (int i = 0; i < 32; ++i) { const int kk = 2 * i + (lane >> 5); scr[kk * 33 + (lane & 31)] = 0.f; }
        }
        asm volatile("s_waitcnt lgkmcnt(0)" ::: "memory");
        const int cc = lane & 7;
#pragma unroll
        for (int j = 0; j < 4; ++j) { const int n = (lane >> 3) + 8 * j; const LAS float* s = scr + (8 * cc) * 33 + n;
            u32x4 o; o.x = pk2(s[0 * 33], s[1 * 33]); o.y = pk2(s[2 * 33], s[3 * 33]); o.z = pk2(s[4 * 33], s[5 * 33]); o.w = pk2(s[6 * 33], s[7 * 33]);
            *(u32x4*)(WT + (size_t)(n0 + n) * K + k0 + 8 * cc) = o; }
        asm volatile("s_waitcnt lgkmcnt(0)" ::: "memory");
    }
}
__device__ __forceinline__ void build_lorat(const Params& p, const Ctx& c) {
    bf16* LT = (bf16*)(p.ws + WS_LORAT); const float* w2 = PIN(I_W2); const float* a2 = PIN(I_A2); const float* g2 = PIN(I_G2);
    const int gt = blockIdx.x * 512 + c.tid, ngt = gridDim.x * 512;
    for (int idx = gt; idx < 3072 * 512; idx += ngt) { const int k = idx / 3072, n = idx - k * 3072; float v = 0.f;
        if (n < 1024) { if (k < 96) v = w2[k * 1024 + n]; }
        else if (n < 2048) { if (k >= 96 && k < 192) v = a2[(k - 96) * 1024 + (n - 1024)]; }
        else { if (k >= 256) v = g2[(k - 256) * 1024 + (n - 2048)]; }
        LT[(size_t)n * 512 + k] = (bf16)(pk2(v, 0.f) & 0xffffu); }
}
template <bool FINAL> __device__ __forceinline__ void phase_ln(const Params& p, const Ctx& c, const float* gam, const float* bet) {
    const float* PRE = (const float*)(p.ws + WS_PRE); bf16* XB = (bf16*)(p.ws + WS_XB);
    f32x4 gv[8], bv[8];
#pragma unroll
    for (int j = 0; j < 8; ++j) { gv[j] = ((const f32x4*)gam)[c.lane + 64 * j]; bv[j] = ((const f32x4*)bet)[c.lane + 64 * j]; }
    for (int row = c.gw; row < MROWS; row += c.ngw) {
        float* yo = nullptr; if (FINAL) { yo = yrow_ptr(p, row); if (!yo) continue; }
        const f32x4* src = (const f32x4*)(PRE + (size_t)row * D); f32x4 v[8]; float s = 0.f;
#pragma unroll
        for (int j = 0; j < 8; ++j) { v[j] = src[c.lane + 64 * j]; s += (v[j][0] + v[j][1]) + (v[j][2] + v[j][3]); }
        const float mean = wave_sum(s) * (1.f / D); float q = 0.f;
#pragma unroll
        for (int j = 0; j < 8; ++j) { v[j] = v[j] - mean; q += (v[j][0] * v[j][0] + v[j][1] * v[j][1]) + (v[j][2] * v[j][2] + v[j][3] * v[j][3]); }
        const float rstd = 1.f / sqrtf(wave_sum(q) * (1.f / D) + LN_EPS);
#pragma unroll
        for (int j = 0; j < 8; ++j) { const f32x4 o = v[j] * rstd * gv[j] + bv[j];
            if (FINAL) ((f32x4*)yo)[c.lane + 64 * j] = o;
            else { u32x2 w; w.x = pk2(o[0], o[1]); w.y = pk2(o[2], o[3]); ((u32x2*)(XB + (size_t)row * D))[c.lane + 64 * j] = w; } }
    }
}
__device__ __forceinline__ void phase_prep1(const Params& p, const Ctx& c) {
    const bf16* PRW = (const bf16*)(p.ws + WS_PRW); const bf16* XBC = (const bf16*)(p.ws + WS_XBC); bf16* AL = (bf16*)(p.ws + WS_ALORA); const float* mu = PIN(I_MU);
    for (int row = c.gw; row < MROWS; row += c.ngw) {
        bf16* al = AL + (size_t)row * 512;
        if (row_is_pad(row)) {
#pragma unroll
            for (int i = 0; i < 8; ++i) al[c.lane + 64 * i] = 0; continue; }
        const bf16* cur = PRW + (size_t)row * PRW_LD; const bf16* prv = nullptr; const float* prvf = nullptr;
        if (row < MP) { if ((row % LP) != PADR) prv = cur - PRW_LD; }
        else { const int s = row - MP; if ((s & 15) != 0) prv = cur - PRW_LD; else prvf = PIN(I_SSH) + (size_t)(s >> 4) * SHC; }
#pragma unroll
        for (int i = 0; i < 7; ++i) { const int col = 3072 + c.lane + 64 * i; const float pc = bf2f(cur[col]); const float pp = prv ? bf2f(prv[col]) : (prvf ? prvf[col] : 0.f);
            const float ps = pc + (pp - pc) * mu[col]; const int lc = c.lane + 64 * i;
            if (lc < 96) al[lc] = (bf16)(pk2(tanhf(ps), 0.f) & 0xffffu);
            else if (lc < 192) al[lc] = (bf16)(pk2(ps, 0.f) & 0xffffu);
            else al[256 + (lc - 192)] = (bf16)(pk2(sigm(ps), 0.f) & 0xffffu); }
        al[192 + c.lane] = 0;
    }
    const int gt = blockIdx.x * 512 + c.tid, ngt = gridDim.x * 512;
    for (int i = gt; i < NB * SHC; i += ngt) { const int b = i / SHC, col = i - b * SHC; p.out[O_PSH + i] = bf2f(PRW[(size_t)(b * LP + LP - 1) * PRW_LD + col]); }
    for (int i = gt; i < SB * SHC; i += ngt) { const int b = i / SHC, col = i - b * SHC; p.out[O_SSH + i] = bf2f(PRW[(size_t)(MP + b * SS + SS - 1) * PRW_LD + col]); }
    for (int i = gt; i < NB * 3 * CONVD; i += ngt) { const int b = i / (3 * CONVD), r = (i / CONVD) % 3, col = i % CONVD; p.out[O_PCONV + i] = bf2f(XBC[(size_t)(b * LP + LP - 3 + r) * XBC_LD + col]); }
    for (int i = gt; i < SB * 3 * CONVD; i += ngt) { const int b = i / (3 * CONVD), r = (i / CONVD) % 3, col = i % CONVD; p.out[O_SCONV + i] = bf2f(XBC[(size_t)(MP + b * SS + SS - 3 + r) * XBC_LD + col]); }
}
__device__ __forceinline__ float sum16(float v) { v += __shfl_xor(v, 1); v += __shfl_xor(v, 2); v += __shfl_xor(v, 4); v += __shfl_xor(v, 8); return v; }
__device__ __forceinline__ void ld4bf(const bf16* ptr, float (&o)[4]) { const u32x2 w = *(const u32x2*)ptr; o[0] = bflo(w.x); o[1] = bfhi(w.x); o[2] = bflo(w.y); o[3] = bfhi(w.y); }
__device__ __forceinline__ void st4bf(bf16* ptr, const float (&v)[4]) { u32x2 w; w.x = pk2(v[0], v[1]); w.y = pk2(v[2], v[3]); *(u32x2*)ptr = w; }
__device__ __forceinline__ void shifted4(const bf16* cur, const bf16* prv, const float* prvf, int col, const float* mu, float (&o)[4]) {
    float pc[4], pp[4]; ld4bf(cur + col, pc);
    if (prv) ld4bf(prv + col, pp); else if (prvf) { const f32x4 t = *(const f32x4*)(prvf + col); pp[0] = t[0]; pp[1] = t[1]; pp[2] = t[2]; pp[3] = t[3]; } else { pp[0] = pp[1] = pp[2] = pp[3] = 0.f; }
    const f32x4 m = *(const f32x4*)(mu + col);
#pragma unroll
    for (int j = 0; j < 4; ++j) o[j] = pc[j] + (pp[j] - pc[j]) * m[j];
}
__device__ __forceinline__ void phase_prep2(const Params& p, const Ctx& c) {
    const bf16* PRW = (const bf16*)(p.ws + WS_PRW); bf16* R = (bf16*)(p.ws + WS_R); bf16* KP = (bf16*)(p.ws + WS_KP); bf16* V = (bf16*)(p.ws + WS_V); bf16* KK = (bf16*)(p.ws + WS_KK); bf16* BB = (bf16*)(p.ws + WS_BB);
    float* SBON = (float*)(p.ws + WS_SBON); const float* mu = PIN(I_MU);
    const int t4 = c.tid & 255, ch = 4 * t4, head = t4 >> 4;
    const f32x4 wkk = *(const f32x4*)(PIN(I_KK) + ch), wka = *(const f32x4*)(PIN(I_KA) + ch), wrk = *(const f32x4*)(PIN(I_RK) + ch);
    for (int row = blockIdx.x * 2 + (c.tid >> 8); row < MROWS; row += gridDim.x * 2) {
        if (row_is_pad(row)) continue;
        const bf16* cur = PRW + (size_t)row * PRW_LD; const bf16* prv = nullptr; const float* prvf = nullptr;
        if (row < MP) { if ((row % LP) != PADR) prv = cur - PRW_LD; }
        else { const int s = row - MP; if ((s & 15) != 0) prv = cur - PRW_LD; else prvf = PIN(I_SSH) + (size_t)(s >> 4) * SHC; }
        float r[4], k[4], v[4], a[4];
        shifted4(cur, prv, prvf, ch, mu, r); shifted4(cur, prv, prvf, 1024 + ch, mu, k); shifted4(cur, prv, prvf, 2048 + ch, mu, v);
        ld4bf(BB + (size_t)row * RWD + ch, a);
        float kk[4], ss = 0.f;
#pragma unroll
        for (int j = 0; j < 4; ++j) { kk[j] = k[j] * wkk[j]; ss += kk[j] * kk[j]; }
        ss = sum16(ss); const float inv = 1.f / fmaxf(sqrtf(ss), 1e-12f);
        float kp[4], bb[4], sb = 0.f;
#pragma unroll
        for (int j = 0; j < 4; ++j) { kk[j] *= inv; kp[j] = k[j] * (1.f + (a[j] - 1.f) * wka[j]); bb[j] = kk[j] * a[j]; sb += r[j] * kp[j] * wrk[j]; }
        sb = sum16(sb);
        const size_t o = (size_t)row * RWD + ch;
        st4bf(R + o, r); st4bf(KP + o, kp); st4bf(V + o, v); st4bf(KK + o, kk); st4bf(BB + o, bb);
        if ((t4 & 15) == 0) SBON[(size_t)row * RWH + head] = sb;
    }
}
__device__ __forceinline__ void phase_post(const Params& p, const Ctx& c) {
    const float* YRAW = p.out; const bf16* V = (const bf16*)(p.ws + WS_V); const bf16* G = (const bf16*)(p.ws + WS_GBUF); const float* SBON = (const float*)(p.ws + WS_SBON); bf16* YRW = (bf16*)(p.ws + WS_YRW);
    { const int t4 = c.tid & 255, ch = 4 * t4, head = t4 >> 4;
      const f32x4 gw = *(const f32x4*)(PIN(I_GNW) + ch), gb = *(const f32x4*)(PIN(I_GNB) + ch);
      for (int row = blockIdx.x * 2 + (c.tid >> 8); row < MROWS; row += gridDim.x * 2) {
        const size_t o = (size_t)row * RWD + ch;
        if (row_is_pad(row)) { u32x2 z; z.x = 0; z.y = 0; *(u32x2*)(YRW + o) = z; continue; }
        const f32x4 y = *(const f32x4*)(YRAW + o); float v[4], g[4]; ld4bf(V + o, v); ld4bf(G + o, g);
        const float mean = sum16((y[0] + y[1]) + (y[2] + y[3])) * (1.f / 64.f);
        float d[4], q = 0.f;
#pragma unroll
        for (int j = 0; j < 4; ++j) { d[j] = y[j] - mean; q += d[j] * d[j]; }
        const float rstd = 1.f / sqrtf(sum16(q) * (1.f / 64.f) + GN_EPS); const float sb = SBON[(size_t)row * RWH + head];
        float ov[4];
#pragma unroll
        for (int j = 0; j < 4; ++j) ov[j] = (d[j] * rstd * gw[j] + gb[j] + sb * v[j]) * g[j];
        st4bf(YRW + o, ov);
      } }
    { bf16* Z = (bf16*)(p.ws + WS_Z); const float* nw = PIN(I_NORMW);
      for (int it = c.gw; it < MROWS * 4; it += c.ngw) { const int row = it >> 2, g = it & 3; bf16* ptr = Z + (size_t)row * Z_LD + g * 512 + c.lane * 8;
        const u32x4 w = *(const u32x4*)ptr; float v[8] = {bflo(w.x), bfhi(w.x), bflo(w.y), bfhi(w.y), bflo(w.z), bfhi(w.z), bflo(w.w), bfhi(w.w)};
        float ss = 0.f;
#pragma unroll
        for (int j = 0; j < 8; ++j) ss += v[j] * v[j];
        const float rs = 1.f / sqrtf(wave_sum(ss) * (1.f / 512.f) + RMS_EPS);
        const f32x4 n0 = *(const f32x4*)(nw + g * 512 + c.lane * 8), n1 = *(const f32x4*)(nw + g * 512 + c.lane * 8 + 4);
        u32x4 o; o.x = pk2(v[0] * rs * n0[0], v[1] * rs * n0[1]); o.y = pk2(v[2] * rs * n0[2], v[3] * rs * n0[3]); o.z = pk2(v[4] * rs * n1[0], v[5] * rs * n1[1]); o.w = pk2(v[6] * rs * n1[2], v[7] * rs * n1[3]);
        *(u32x4*)ptr = o; } }
}

constexpr int SC_CH = 32;
constexpr int SC_BUF = 6 * SC_CH * 64 * 4;
__device__ __forceinline__ float dpp_sum8(float x) {
    x += __builtin_bit_cast(float, __builtin_amdgcn_update_dpp(0, __builtin_bit_cast(int, x), 0xB1, 0xF, 0xF, true));
    x += __builtin_bit_cast(float, __builtin_amdgcn_update_dpp(0, __builtin_bit_cast(int, x), 0x4E, 0xF, 0xF, true));
    x += __builtin_bit_cast(float, __builtin_amdgcn_update_dpp(0, __builtin_bit_cast(int, x), 0x141, 0xF, 0xF, true));
    return x;
}
__device__ __forceinline__ void scan_stage(const Params& p, const Ctx& c, LAS float* buf, int row0, int h, int steps, int lt  ) {
    const int i = lt >> 3, ch0 = (lt & 7) * 8;
    if (i < steps) {
        const size_t o = (size_t)(row0 + i) * RWD + h * 64 + ch0;
        const u32x4 wr = *(const u32x4*)((const bf16*)(p.ws + WS_R) + o), wk = *(const u32x4*)((const bf16*)(p.ws + WS_KP) + o), wv = *(const u32x4*)((const bf16*)(p.ws + WS_V) + o),
                    wkk = *(const u32x4*)((const bf16*)(p.ws + WS_KK) + o), wb = *(const u32x4*)((const bf16*)(p.ws + WS_BB) + o);
        const f32x4 d0 = *(const f32x4*)((const float*)(p.ws + WS_WDEC) + o), d1 = *(const f32x4*)((const float*)(p.ws + WS_WDEC) + o + 4);
        LAS f32x4* dst = (LAS f32x4*)(buf + i * 64 + ch0);
#define SC_PUT(arr, V_) do { dst[(arr) * (SC_CH * 16)] = (f32x4){bflo(V_.x), bfhi(V_.x), bflo(V_.y), bfhi(V_.y)}; dst[(arr) * (SC_CH * 16) + 1] = (f32x4){bflo(V_.z), bfhi(V_.z), bflo(V_[3]), bfhi(V_[3])}; } while (0)
        SC_PUT(0, wr); dst[1 * (SC_CH * 16)] = d0; dst[1 * (SC_CH * 16) + 1] = d1; SC_PUT(2, wk); SC_PUT(3, wkk); SC_PUT(4, wb); SC_PUT(5, wv);
#undef SC_PUT
    }
}
__device__ __forceinline__ void rwkv_scan_unit(const Params& p, const Ctx& c, int s, int h, int hf) {
    const bool prompt = s < NB; const int row_base = prompt ? s * LP + PADR : MP + (s - NB) * SS; const int T = prompt ? TP : SS;
    const int nch = (T + SC_CH - 1) / SC_CH;
    LAS float* buf0 = (LAS float*)c.lds; LAS float* buf1 = (LAS float*)(c.lds + SC_BUF);
    const bool comp = c.wave < 4; const int lane = c.lane, ks = lane & 7, vrow = 32 * hf + 8 * (c.wave & 3) + (lane >> 3);
    float S[8];
#pragma unroll
    for (int j = 0; j < 8; ++j) S[j] = 0.f;
    if (comp && !prompt) { const float* st = PIN(I_SWKV) + (((size_t)(s - NB) * RWH + h) * 64 + vrow) * 64 + ks * 8;
        const f32x4 a = *(const f32x4*)st, b = *(const f32x4*)(st + 4); S[0] = a[0]; S[1] = a[1]; S[2] = a[2]; S[3] = a[3]; S[4] = b[0]; S[5] = b[1]; S[6] = b[2]; S[7] = b[3]; }
    __syncthreads();
    scan_stage(p, c, buf0, row_base, h, T < SC_CH ? T : SC_CH, c.tid & 255);
    __syncthreads();
    float* yout = p.out;
    for (int cix = 0; cix < nch; ++cix) {
        LAS float* cur = (cix & 1) ? buf1 : buf0; LAS float* nxt = (cix & 1) ? buf0 : buf1;
        const int t0 = cix * SC_CH; const int steps = (T - t0) < SC_CH ? (T - t0) : SC_CH;
        if (!comp) { if (cix + 1 < nch) { const int t1 = t0 + SC_CH; scan_stage(p, c, nxt, row_base + t1, h, (T - t1) < SC_CH ? (T - t1) : SC_CH, c.tid - 256); } }
        else {
            const LAS float* bR = cur + ks * 8;
            f32x4 r0, r1, w0, w1, k0, k1, q0, q1, b0, b1; float vv;
#define SC_LOAD(i) do { const LAS float* bp = bR + (i) * 64; r0 = *(const LAS f32x4*)bp; r1 = *(const LAS f32x4*)(bp + 4); w0 = *(const LAS f32x4*)(bp + SC_CH * 64); w1 = *(const LAS f32x4*)(bp + SC_CH * 64 + 4); \
        k0 = *(const LAS f32x4*)(bp + 2 * SC_CH * 64); k1 = *(const LAS f32x4*)(bp + 2 * SC_CH * 64 + 4); q0 = *(const LAS f32x4*)(bp + 3 * SC_CH * 64); q1 = *(const LAS f32x4*)(bp + 3 * SC_CH * 64 + 4); \
        b0 = *(const LAS f32x4*)(bp + 4 * SC_CH * 64); b1 = *(const LAS f32x4*)(bp + 4 * SC_CH * 64 + 4); vv = cur[5 * SC_CH * 64 + (i) * 64 + vrow]; } while (0)
            SC_LOAD(0);
            for (int i = 0; i < steps; ++i) {
                const f32x4 cr0 = r0, cr1 = r1, cw0 = w0, cw1 = w1, ck0 = k0, ck1 = k1, cq0 = q0, cq1 = q1, cb0 = b0, cb1 = b1; const float cv = vv;
                const int in = (i + 1 < steps) ? i + 1 : i; SC_LOAD(in);
                float pa = S[0] * cq0[0] + S[1] * cq0[1], pb = S[2] * cq0[2] + S[3] * cq0[3]; pa += S[4] * cq1[0] + S[5] * cq1[1]; pb += S[6] * cq1[2] + S[7] * cq1[3];
                const float sa = -dpp_sum8(pa + pb);
                S[0] = S[0] * cw0[0] + (sa * cb0[0] + cv * ck0[0]); S[1] = S[1] * cw0[1] + (sa * cb0[1] + cv * ck0[1]); S[2] = S[2] * cw0[2] + (sa * cb0[2] + cv * ck0[2]); S[3] = S[3] * cw0[3] + (sa * cb0[3] + cv * ck0[3]);
                S[4] = S[4] * cw1[0] + (sa * cb1[0] + cv * ck1[0]); S[5] = S[5] * cw1[1] + (sa * cb1[1] + cv * ck1[1]); S[6] = S[6] * cw1[2] + (sa * cb1[2] + cv * ck1[2]); S[7] = S[7] * cw1[3] + (sa * cb1[3] + cv * ck1[3]);
                float ya = S[0] * cr0[0] + S[1] * cr0[1], yb = S[2] * cr0[2] + S[3] * cr0[3]; ya += S[4] * cr1[0] + S[5] * cr1[1]; yb += S[6] * cr1[2] + S[7] * cr1[3];
                const float y = dpp_sum8(ya + yb);
                if (ks == 0) yout[(size_t)(row_base + t0 + i) * RWD + h * 64 + vrow] = y;
            }
#undef SC_LOAD
        }
        __syncthreads();
    }
    if (comp) { float* so = p.out + (prompt ? O_PWKV + (((size_t)s * RWH + h) * 64 + vrow) * 64 : O_SWKV + (((size_t)(s - NB) * RWH + h) * 64 + vrow) * 64) + ks * 8;
        *(f32x4*)so = (f32x4){S[0], S[1], S[2], S[3]}; *(f32x4*)(so + 4) = (f32x4){S[4], S[5], S[6], S[7]}; }
}

constexpr int SD_RAW = 0, SD_G = 0, SD_CM = 43008, SD_BM = 60416, SD_HB = 77824, SD_BT = 95232, SD_XT = 113664, SD_XD = 122880, SD_XC = 132096, SD_DT = 141312, SD_ACS = 141568;
constexpr int RAW_LD = 320, CM_LD = 136, BT_LD = 72, XT_LD = 72;
__device__ __forceinline__ f32x4 mfma16(bf16x8 a, bf16x8 b, f32x4 c) { return __builtin_amdgcn_mfma_f32_16x16x32_bf16(a, b, c, 0, 0, 0); }
__device__ __forceinline__ void ssd_unit(const Params& p, const Ctx& c, int s, int hd) {
    const bool prompt = s < NB; const int row_base = prompt ? s * LP : MP + (s - NB) * SS; const int nchunks = prompt ? LP / 64 : 1; const int g = hd >> 3;
    const int tid = c.tid, lane = c.lane, w = c.wave, fr = lane & 15, fq = lane >> 4;
    const bf16* XBC = (const bf16*)(p.ws + WS_XBC); const bf16* PRW = (const bf16*)(p.ws + WS_PRW); bf16* Z = (bf16*)(p.ws + WS_Z);
    LAS bf16* RAW = (LAS bf16*)(c.lds + SD_RAW); LAS bf16* Gm = (LAS bf16*)(c.lds + SD_G); LAS bf16* CM = (LAS bf16*)(c.lds + SD_CM); LAS bf16* BM = (LAS bf16*)(c.lds + SD_BM); LAS bf16* HB = (LAS bf16*)(c.lds + SD_HB);
    LAS bf16* BT = (LAS bf16*)(c.lds + SD_BT); LAS bf16* XT = (LAS bf16*)(c.lds + SD_XT); LAS bf16* XD = (LAS bf16*)(c.lds + SD_XD); LAS bf16* XC = (LAS bf16*)(c.lds + SD_XC);
    LAS float* DT = (LAS float*)(c.lds + SD_DT); LAS float* ACS = (LAS float*)(c.lds + SD_ACS);
    const float* convw = PIN(I_CONVW); const float* convb = PIN(I_CONVB);
    const int xp = tid & 63, xch = hd * 64 + xp; float xw[4], xb = convb[xch];
#pragma unroll
    for (int i = 0; i < 4; ++i) xw[i] = convw[i * CONVD + xch];
    const int bn = tid & 127, bch = 2048 + g * 128 + bn, cch = 2560 + g * 128 + bn; float bw[4], cw[4], bb = convb[bch], cb = convb[cch];
#pragma unroll
    for (int i = 0; i < 4; ++i) { bw[i] = convw[i * CONVD + bch]; cw[i] = convw[i * CONVD + cch]; }
    const float dtb = PIN(I_DTB)[hd], aneg = -__expf(PIN(I_ALOG)[hd]), dsk = PIN(I_DSKIP)[hd];
    const int hpt = w & 3, hnt0 = (w >> 2) * 4;
    f32x4 hacc[4];
#pragma unroll
    for (int j = 0; j < 4; ++j) hacc[j] = (f32x4){0.f, 0.f, 0.f, 0.f};
    if (!prompt) { const float* st = PIN(I_SSSM) + ((size_t)(s - NB) * SSMH + hd) * 64 * 128;
#pragma unroll
        for (int j = 0; j < 4; ++j)
#pragma unroll
            for (int r = 0; r < 4; ++r) hacc[j][r] = st[(size_t)(hpt * 16 + fq * 4 + r) * 128 + (hnt0 + j) * 16 + fr]; }
    const int yit = w >> 1, ypt0 = (w & 1) * 2;
    __syncthreads();
    for (int cix = 0; cix < nchunks; ++cix) {
        for (int idx = tid; idx < 67 * 40; idx += 512) { const int rr = idx / 40, cc = idx - rr * 40; const int q = cix * 64 + rr - 3;
            const int col = cc < 8 ? hd * 64 + cc * 8 : (cc < 24 ? 2048 + g * 128 + (cc - 8) * 8 : 2560 + g * 128 + (cc - 24) * 8);
            u32x4 v = (u32x4){0u, 0u, 0u, 0u};
            if (prompt) { if (q >= PADR) v = *(const u32x4*)(XBC + (size_t)(row_base + q) * XBC_LD + col); }
            else { if (q >= 0 && q < SS) v = *(const u32x4*)(XBC + (size_t)(row_base + q) * XBC_LD + col);
                   else if (q < 0) { const float* hs = PIN(I_SCONV) + ((size_t)(s - NB) * 3 + (3 + q)) * CONVD + col; const f32x4 a = *(const f32x4*)hs, b = *(const f32x4*)(hs + 4);
                       v.x = pk2(a[0], a[1]); v.y = pk2(a[2], a[3]); v.z = pk2(b[0], b[1]); v.w = pk2(b[2], b[3]); } }
            *(LAS u32x4*)(RAW + rr * RAW_LD + cc * 8) = v; }
        if (w == 0) { const int q = cix * 64 + lane; const bool valid = prompt ? (q >= PADR) : (q < SS);
            float dtv = 0.f; if (valid) dtv = softplus_(bf2f(PRW[(size_t)(row_base + q) * PRW_LD + SHC + hd]) + dtb);
            float a = dtv * aneg;
#pragma unroll
            for (int o = 1; o < 64; o <<= 1) { const float t = __shfl_up(a, o); if (lane >= o) a += t; }
            DT[lane] = dtv; ACS[lane] = a; }
#pragma unroll
        for (int j = 0; j < 4; ++j)
#pragma unroll
            for (int r = 0; r < 4; ++r) HB[(hpt * 16 + fq * 4 + r) * CM_LD + (hnt0 + j) * 16 + fr] = (bf16)(pk2(hacc[j][r], 0.f) & 0xffffu);
        __syncthreads();
        const float acs_end = ACS[63];
#pragma unroll 2
        for (int i = 0; i < 8; ++i) { const int t = (tid >> 6) + 8 * i; const int q = cix * 64 + t; const bool valid = prompt ? (q >= PADR) : (q < SS);
            float a = xb;
#pragma unroll
            for (int k = 0; k < 4; ++k) a += bf2f(RAW[(t + k) * RAW_LD + xp]) * xw[k];
            a = valid ? silu_(a) : 0.f; const float xdt = a * DT[t];
            XC[t * XT_LD + xp] = (bf16)(pk2(a, 0.f) & 0xffffu); XT[xp * XT_LD + t] = (bf16)(pk2(xdt, 0.f) & 0xffffu); XD[xp * XT_LD + t] = (bf16)(pk2(xdt * __expf(acs_end - ACS[t]), 0.f) & 0xffffu); }
#pragma unroll 2
        for (int i = 0; i < 16; ++i) { const int t = (tid >> 7) + 4 * i; const int q = cix * 64 + t; const bool valid = prompt ? (q >= PADR) : (q < SS);
            float a = bb, b = cb;
#pragma unroll
            for (int k = 0; k < 4; ++k) { a += bf2f(RAW[(t + k) * RAW_LD + 64 + bn]) * bw[k]; b += bf2f(RAW[(t + k) * RAW_LD + 192 + bn]) * cw[k]; }
            a = valid ? silu_(a) : 0.f; b = valid ? silu_(b) : 0.f;
            const bf16 ab = (bf16)(pk2(a, 0.f) & 0xffffu); BM[t * CM_LD + bn] = ab; BT[bn * BT_LD + t] = ab; CM[t * CM_LD + bn] = (bf16)(pk2(b, 0.f) & 0xffffu); }
        __syncthreads();
        f32x4 yacc[2];
        { f32x4 cbacc[2] = {(f32x4){0.f, 0.f, 0.f, 0.f}, (f32x4){0.f, 0.f, 0.f, 0.f}}; yacc[0] = cbacc[0]; yacc[1] = cbacc[0];
#pragma unroll
          for (int kk = 0; kk < 4; ++kk) { const bf16x8 af = *(const LAS bf16x8*)(CM + (yit * 16 + fr) * CM_LD + kk * 32 + fq * 8);
#pragma unroll
              for (int j = 0; j < 2; ++j) { const bf16x8 bfm = *(const LAS bf16x8*)(BM + ((ypt0 + j) * 16 + fr) * CM_LD + kk * 32 + fq * 8); cbacc[j] = mfma16(af, bfm, cbacc[j]);
                  const bf16x8 hf = *(const LAS bf16x8*)(HB + ((ypt0 + j) * 16 + fr) * CM_LD + kk * 32 + fq * 8); yacc[j] = mfma16(af, hf, yacc[j]); } }
#pragma unroll
          for (int j = 0; j < 2; ++j)
#pragma unroll
              for (int r = 0; r < 4; ++r) { const int i = yit * 16 + fq * 4 + r, jj = (ypt0 + j) * 16 + fr; const float ai = ACS[i];
                  const float gv = (jj <= i) ? cbacc[j][r] * __expf(ai - ACS[jj]) : 0.f; Gm[i * XT_LD + jj] = (bf16)(pk2(gv, 0.f) & 0xffffu);
                  yacc[j][r] *= __expf(ai); } }
        { const float cd = __expf(acs_end);
#pragma unroll
          for (int j = 0; j < 4; ++j) hacc[j] = hacc[j] * cd;
#pragma unroll
          for (int kk = 0; kk < 2; ++kk) { const bf16x8 af = *(const LAS bf16x8*)(XD + (hpt * 16 + fr) * XT_LD + kk * 32 + fq * 8);
#pragma unroll
              for (int j = 0; j < 4; ++j) { const bf16x8 bfm = *(const LAS bf16x8*)(BT + ((hnt0 + j) * 16 + fr) * BT_LD + kk * 32 + fq * 8); hacc[j] = mfma16(af, bfm, hacc[j]); } } }
        __syncthreads();
#pragma unroll
        for (int kk = 0; kk < 2; ++kk) { const bf16x8 af = *(const LAS bf16x8*)(Gm + (yit * 16 + fr) * XT_LD + kk * 32 + fq * 8);
#pragma unroll
            for (int j = 0; j < 2; ++j) { const bf16x8 bfm = *(const LAS bf16x8*)(XT + ((ypt0 + j) * 16 + fr) * XT_LD + kk * 32 + fq * 8); yacc[j] = mfma16(af, bfm, yacc[j]); } }
#pragma unroll
        for (int j = 0; j < 2; ++j)
#pragma unroll
            for (int r = 0; r < 4; ++r) { const int i = yit * 16 + fq * 4 + r, pp = (ypt0 + j) * 16 + fr; const int q = cix * 64 + i;
                if (prompt || q < SS) { bf16* zp = Z + (size_t)(row_base + q) * Z_LD + hd * 64 + pp;
                    const float yv = (yacc[j][r] + bf2f(XC[i * XT_LD + pp]) * dsk) * bf2f(*zp); *zp = (bf16)(pk2(yv, 0.f) & 0xffffu); } }
        __syncthreads();
    }
    { float* so = p.out + (prompt ? O_PSSM + ((size_t)s * SSMH + hd) * 64 * 128 : O_SSSM + ((size_t)(s - NB) * SSMH + hd) * 64 * 128);
#pragma unroll
      for (int j = 0; j < 4; ++j)
#pragma unroll
          for (int r = 0; r < 4; ++r) so[(size_t)(hpt * 16 + fq * 4 + r) * 128 + (hnt0 + j) * 16 + fr] = hacc[j][r]; }
}
__device__ __forceinline__ void phase_mixers(const Params& p, const Ctx& c) {
    for (int u = blockIdx.x; u < 1280; u += gridDim.x) {
        int kind, s, h, hf = 0;
        if (u < 128) { kind = 0; s = (u >> 1) / RWH; h = (u >> 1) % RWH; hf = u & 1; }
        else if (u < 256) { kind = 1; s = (u - 128) / SSMH; h = (u - 128) % SSMH; }
        else if (u < 768) { const int v = u - 256; kind = 0; s = NB + (v >> 1) / RWH; h = (v >> 1) % RWH; hf = v & 1; }
        else { const int v = u - 768; kind = 1; s = NB + v / SSMH; h = v % SSMH; }
#if defined(PROBE_SCAN2)
        for (int rep_ = 0; rep_ < (kind == 0 ? 2 : 1); ++rep_)
#endif
#if defined(PROBE_NOSSD)
        if (kind == 0)
#endif
        { if (kind == 0) rwkv_scan_unit(p, c, s, h, hf); else ssd_unit(p, c, s, h); }
    }
}

__device__ __forceinline__ bool setup_gemm(const Params& p, int ph, pg8::Gemm& g, pg8::EpiGen& E) {
    unsigned char* ws = p.ws;
    E.o0 = nullptr; E.o1 = nullptr; E.o2 = nullptr; E.i0 = nullptr; E.i1 = nullptr; E.f0 = nullptr; E.f1 = nullptr; E.alpha = 0.f; E.scale = 0.f; E.mode = 0; E.PERM = false;
    switch (ph) {
    case 1: case 14: g.A = (const bf16*)(ws + WS_XB); g.Bt = (const bf16*)(ws + WS_GUT); g.M = MROWS; g.N = 2 * FF; g.K = D; E.mode = pg8::EM_SWIGLU; E.PERM = true; E.o0 = ws + WS_ACT; return true;
    case 2: case 15: g.A = (const bf16*)(ws + WS_ACT); g.Bt = (const bf16*)(ws + WS_DNT); g.M = MROWS; g.N = D; g.K = FF; E.mode = pg8::EM_RESID; E.o0 = ws + WS_PRE; E.i0 = ws + WS_XB; E.alpha = ALPHA; E.scale = 0.5f; return true;
    case 4: g.A = (const bf16*)(ws + WS_XB); g.Bt = (const bf16*)(ws + WS_WINT); g.M = MROWS; g.N = NINP; g.K = D; E.mode = pg8::EM_WIN; E.PERM = true; E.o0 = ws + WS_PRW; E.f0 = PIN(I_BGATE); return true;
    case 6: g.A = (const bf16*)(ws + WS_ALORA); g.Bt = (const bf16*)(ws + WS_LORAT); g.M = MROWS; g.N = 3072; g.K = 512; E.mode = pg8::EM_LORA; E.o0 = ws + WS_WDEC; E.o1 = ws + WS_BB; E.o2 = ws + WS_GBUF; E.f0 = PIN(I_W0); E.f1 = PIN(I_A0); return true;
    case 10: g.A = (const bf16*)(ws + WS_YRW); g.Bt = (const bf16*)(ws + WS_RWOT); g.M = MROWS; g.N = D; g.K = RWD; E.mode = pg8::EM_M1; E.o0 = ws + WS_T1; E.i0 = ws + WS_GATE; return true;
    case 11: g.A = (const bf16*)(ws + WS_Z); g.Bt = (const bf16*)(ws + WS_SSMOT); g.M = MROWS; g.N = D; g.K = D; E.mode = pg8::EM_M2; E.PERM = true; E.o0 = ws + WS_MERGED; E.i0 = ws + WS_GATE; E.i1 = ws + WS_T1; return true;
    case 12: g.A = (const bf16*)(ws + WS_MERGED); g.Bt = (const bf16*)(ws + WS_WOT); g.M = MROWS; g.N = D; g.K = D; E.mode = pg8::EM_RESID; E.o0 = ws + WS_PRE; E.i0 = ws + WS_XB; E.alpha = ALPHA; E.scale = 1.0f; return true;
    default: return false;
    }
}

#ifndef MK_XCD_BARRIER
#define MK_XCD_BARRIER 1
#endif
#define XB_TMO      128
#define XB_XCNT(j)  (256  + 64 * (j))
#define XB_XSUB(j)  (1280 + 64 * (j))
#define XB_XGEN(j)  (2304 + 64 * (j))
#define XB_TOP      3328
#define XB_TOPGEN   3392
#define XCD_BAR_WORDS 3456
#define XB_SPIN_CAP (1u << 18)

__device__ __forceinline__ unsigned xb_ld(unsigned* p)              { return __hip_atomic_load(p, __ATOMIC_RELAXED, __HIP_MEMORY_SCOPE_AGENT); }
__device__ __forceinline__ unsigned xb_add(unsigned* p, unsigned v) { return __hip_atomic_fetch_add(p, v, __ATOMIC_RELAXED, __HIP_MEMORY_SCOPE_AGENT); }
__device__ __forceinline__ unsigned xb_xcc_id() { return (unsigned)__builtin_amdgcn_s_getreg((3 << 11) | 20) & 0xFu; }
#define XB_SPIN(cond, bar) do { unsigned _sp = 0; while (cond) { __builtin_amdgcn_s_sleep(1); \
    if ((++_sp & 255u) == 0u) { if (xb_ld(&(bar)[XB_TMO])) break; if (_sp > XB_SPIN_CAP) { atomicAdd(&(bar)[XB_TMO], 1u); break; } } } } while (0)

struct XcdBarrier {
    unsigned* bar; unsigned x;
    volatile LAS unsigned* st;
};

__device__ __forceinline__ XcdBarrier xcd_barrier_post(unsigned* bar, volatile LAS unsigned* st) {
    XcdBarrier b; b.bar = bar; b.x = xb_xcc_id(); b.st = st;
    if (threadIdx.x == 0) (void)xb_add(&bar[XB_XCNT(b.x)], 1u);
    return b;
}
__device__ __forceinline__ void xcd_barrier_complete(unsigned* bar, unsigned x, unsigned& nloc, unsigned& nx) {
    const unsigned G = gridDim.x * gridDim.y * gridDim.z;
    unsigned sum, cnt, mine, sp = 0u;
    for (;;) {
        sum = 0u; cnt = 0u; mine = 0u;
#pragma unroll
        for (unsigned j = 0; j < 16; ++j) { const unsigned c = xb_ld(&bar[XB_XCNT(j)]); sum += c; cnt += (c > 0u) ? 1u : 0u; mine = (j == x) ? c : mine; }
        if (sum == G) break;
        __builtin_amdgcn_s_sleep(1);
        if ((++sp & 255u) == 0u) { if (xb_ld(&bar[XB_TMO])) break; if (sp > XB_SPIN_CAP) { atomicAdd(&bar[XB_TMO], 1u); break; } }
    }
    nloc = mine > 0u ? mine : 1u; nx = cnt > 0u ? cnt : 1u;
}

__device__ __forceinline__ void xcd_barrier(const XcdBarrier& b) {
    asm volatile("s_waitcnt vmcnt(0)" ::: "memory");
    __syncthreads();
    if (threadIdx.x == 0) {
        unsigned* bar = b.bar;
        __builtin_amdgcn_s_waitcnt(0);
        unsigned nloc = b.st[0], nx = b.st[1];
        if (nloc == 0u) { xcd_barrier_complete(bar, b.x, nloc, nx); b.st[0] = nloc; b.st[1] = nx; }
        const unsigned old = xb_add(&bar[XB_XSUB(b.x)], 1u);
        const unsigned gen = old / nloc;
        if (old + 1u == (gen + 1u) * nloc) {
            __builtin_amdgcn_fence(__ATOMIC_RELEASE, "agent");
            asm volatile("s_waitcnt vmcnt(0)" ::: "memory");
            const unsigned og = xb_add(&bar[XB_TOP], 1u);
            const unsigned tg = og / nx;
            if (og + 1u == (tg + 1u) * nx) xb_add(&bar[XB_TOPGEN], 1u);
            else XB_SPIN(xb_ld(&bar[XB_TOPGEN]) == tg, bar);
            __builtin_amdgcn_fence(__ATOMIC_ACQUIRE, "agent");
            xb_add(&bar[XB_XGEN(b.x)], 1u);
            asm volatile("s_waitcnt vmcnt(0)" ::: "memory");
        } else {
            XB_SPIN(xb_ld(&bar[XB_XGEN(b.x)]) == gen, bar);
            __builtin_amdgcn_fence(__ATOMIC_ACQUIRE, "agent");
            asm volatile("s_waitcnt vmcnt(0)" ::: "memory");
        }
    }
    __syncthreads();
}

template <int PH> __device__ __forceinline__ void run_gemm(const Params& p, const Ctx& c) {
    pg8::Gemm g; pg8::EpiGen E; setup_gemm(p, PH, g, E);
    pg8::StaticOrder S; S.init(g.M, g.N, (int)gridDim.x, (int)blockIdx.x);
    pg8::gemm_phase<pg8::EpiGen, pg8::StaticOrder, true, true>(c.lds, g, S, E);
}
__global__ void __launch_bounds__(512, 2) mega_fwd(Params p) {
    extern __shared__ __attribute__((aligned(16))) unsigned char lds_raw[];
    const int lo = p.ph_lo, hi = p.ph_hi;
#define MKCTX Ctx c; { int t_ = threadIdx.x; asm volatile("" : "+v"(t_)); c.tid = t_; c.lane = t_ & 63; c.wave = __builtin_amdgcn_readfirstlane(t_ >> 6); c.gw = blockIdx.x * 8 + c.wave; c.ngw = gridDim.x * 8; c.lds = (LAS unsigned char*)lds_raw; }
#define IN(k) (lo <= (k) && (k) < hi)
#if MK_XCD_BARRIER
    { volatile LAS unsigned* st = (volatile LAS unsigned*)((LAS unsigned char*)lds_raw + LDS_BYTES - 64); if (threadIdx.x < 2) st[threadIdx.x] = 0u; __syncthreads(); }
    const XcdBarrier xbar = xcd_barrier_post((unsigned*)p.ws, (volatile LAS unsigned*)((LAS unsigned char*)lds_raw + LDS_BYTES - 64));
#define SEAM(k) do { if (lo <= (k) && (k) + 1 < hi) { if ((k) == 0) cg::this_grid().sync(); else xcd_barrier(xbar); } } while (0)
#else
#define SEAM(k) do { if (lo <= (k) && (k) + 1 < hi) cg::this_grid().sync(); } while (0)
#endif
#ifndef PROBE_DOUBLE
#define PROBE_DOUBLE 0
#endif
#define PH(k, ...) do { if (IN(k)) { { MKCTX __VA_ARGS__ } if (((PROBE_DOUBLE >> (k)) & 1) != 0) { cg::this_grid().sync(); { MKCTX __VA_ARGS__ } } } SEAM(k); } while (0)
    PH(0, phase_convert_x(p, c);
        transpose_w(PIN(I_GU1), D, 2 * FF, (bf16*)(p.ws + WS_GUT), 2 * FF, MAP_GU, c);
        transpose_w(PIN(I_DN1), FF, D, (bf16*)(p.ws + WS_DNT), D, MAP_ID, c);
        transpose_w(PIN(I_RWO), RWD, D, (bf16*)(p.ws + WS_RWOT), D, MAP_ID, c);
        transpose_w(PIN(I_SSMO), D, D, (bf16*)(p.ws + WS_SSMOT), D, MAP_ID, c);
        transpose_w(PIN(I_WO), D, D, (bf16*)(p.ws + WS_WOT), D, MAP_ID, c);
        build_lorat(p, c););
    PH(1, run_gemm<1>(p, c););
    PH(2, run_gemm<2>(p, c););
    PH(3, phase_ln<false>(p, c, PIN(I_LN1G), PIN(I_LN1B)); transpose_w(PIN(I_WIN), D, 12768, (bf16*)(p.ws + WS_WINT), NINP, MAP_WIN, c););
    PH(4, run_gemm<4>(p, c););
    PH(5, phase_prep1(p, c););
    PH(6, run_gemm<6>(p, c););
    PH(7, phase_prep2(p, c););
    PH(8, phase_mixers(p, c););
    PH(9, phase_post(p, c););
    PH(10, run_gemm<10>(p, c););
    PH(11, run_gemm<11>(p, c););
    PH(12, run_gemm<12>(p, c););
    PH(13, phase_ln<false>(p, c, PIN(I_LN2G), PIN(I_LN2B)); transpose_w(PIN(I_GU2), D, 2 * FF, (bf16*)(p.ws + WS_GUT), 2 * FF, MAP_GU, c); transpose_w(PIN(I_DN2), FF, D, (bf16*)(p.ws + WS_DNT), D, MAP_ID, c););
    PH(14, run_gemm<14>(p, c););
    PH(15, run_gemm<15>(p, c););
    PH(16, phase_ln<true>(p, c, PIN(I_LN3G), PIN(I_LN3B)););
#undef PH
#undef IN
#undef MKCTX
#undef SEAM
}

extern "C" void kernel_launch(void* const* d_in, const int* in_sizes, int n_in, void* d_out, int out_size, void* d_ws, size_t ws_size, hipStream_t stream) {
    static int grid = 0;
    if (!grid) {
        if (n_in != N_IN || (size_t)out_size != O_END || ws_size < WS_END) { fprintf(stderr, "kernel_launch: unexpected shapes (n_in %d, out %d, ws %zu)\n", n_in, out_size, ws_size); grid = -1; return; }
        int dev = 0, cus = 0, per_cu = 0;
        hipGetDevice(&dev); hipDeviceGetAttribute(&cus, hipDeviceAttributeMultiprocessorCount, dev);
        hipFuncSetAttribute((const void*)mega_fwd, hipFuncAttributeMaxDynamicSharedMemorySize, LDS_BYTES);
        hipOccupancyMaxActiveBlocksPerMultiprocessor(&per_cu, (const void*)mega_fwd, 512, LDS_BYTES);
        if (per_cu < 1) { fprintf(stderr, "kernel_launch: occupancy query says %d blocks per CU\n", per_cu); per_cu = 1; }
        grid = cus;
    }
    if (grid < 0) return;
    if (hipMemsetAsync(d_ws, 0, 16384, stream) != hipSuccess) fprintf(stderr, "kernel_launch: memset failed\n");
    Params p{};
    for (int i = 0; i < N_IN; ++i) p.in[i] = (const float*)d_in[i];
    p.out = (float*)d_out; p.ws = (unsigned char*)d_ws;
#if MK_SINGLE_LAUNCH
    p.ph_lo = 0; p.ph_hi = NPHASE;
    void* args[] = {&p};
    hipError_t e = hipLaunchCooperativeKernel((const void*)mega_fwd, dim3(grid), dim3(512), args, LDS_BYTES, stream);
    if (e != hipSuccess) fprintf(stderr, "cooperative launch failed: %s (grid %d)\n", hipGetErrorString(e), grid);
#else
    for (int ph = 0; ph < NPHASE; ++ph) { p.ph_lo = ph; p.ph_hi = ph + 1; hipLaunchKernelGGL(mega_fwd, dim3(grid), dim3(512), LDS_BYTES, stream, p); }
#endif
}
```

```cpp
#include <hip/hip_runtime.h>
#include <hip/hip_cooperative_groups.h>
#include <cstdio>
#include <cstdint>
namespace cg = cooperative_groups;

#ifndef MK_SINGLE_LAUNCH
#define MK_SINGLE_LAUNCH 1
#endif

namespace pg8 {
#define PG8_LAS __attribute__((address_space(3)))
typedef unsigned short bf16_t;
typedef short bf16x8 __attribute__((ext_vector_type(8)));
typedef float f32x4 __attribute__((ext_vector_type(4)));
typedef unsigned u32x4 __attribute__((ext_vector_type(4)));
constexpr int BM = 256, BK = 64, HALF = 128, HTB = HALF * BK * 2  , STAGE_BYTES = 8 * HTB, NXCD = 8, WGM = 8;

__host__ __device__ __forceinline__ int lds_byte(int r, int c) { const int st = (r >> 4) * 2 + (c >> 5), rr = r & 15, cc = c & 31, ob = rr * 64 + cc * 2; return st * 1024 + (ob ^ (((ob >> 9) & 1) << 5)); }
__host__ __device__ __forceinline__ void stage_rc(int b, int& R, int& C) { const int st = b / 1024, sb = b % 1024, swz = sb ^ (((sb >> 9) & 1) << 5); R = (st >> 1) * 16 + swz / 64; C = (st & 1) * 32 + (swz % 64) / 2; }
__host__ __device__ __forceinline__ int perm32(int rho) { const int n = rho >> 4, i = rho & 15; return 8 * (i >> 2) + 4 * n + (i & 3); }

struct Unit { int pm, pn; };
struct Gemm { const bf16_t* A; const bf16_t* Bt; int M, N, K; };

struct StaticOrder {
    int nM, nN, nwg, G, c;
    __host__ __device__ void init(int M, int N, int G_, int c_) { nM = M / BM; nN = N / BM; nwg = nM * nN; G = G_; c = c_; }
    __host__ __device__ bool next(int i, Unit& u) const {
        const long L = (long)i * G + c; if (L >= nwg) return false;
        int wgid = (int)L; { const int q = nwg / NXCD, r = nwg % NXCD, xcd = wgid % NXCD, off = wgid / NXCD; wgid = (xcd < r ? xcd * (q + 1) : r * (q + 1) + (xcd - r) * q) + off; }
        const int nig = WGM * nN, gid = wgid / nig, fm = gid * WGM, gsz = (nM - fm) < WGM ? (nM - fm) : WGM;
        u.pm = fm + ((wgid % nig) % gsz); u.pn = (wgid % nig) / gsz; return true;
    }
    __device__ __forceinline__ void a_ready(const Unit&) const {}
    __device__ __forceinline__ void done(const Unit&) const {}
};

__device__ __forceinline__ unsigned cvt_pk_bf16(float lo, float hi) { unsigned r; asm volatile("v_cvt_pk_bf16_f32 %0, %1, %2" : "=v"(r) : "v"(lo), "v"(hi)); return r; }

__device__ __forceinline__ float bf2f(unsigned short h) { return __uint_as_float(((unsigned)h) << 16); }
__device__ __forceinline__ float bflo(unsigned w) { return __uint_as_float(w << 16); }
__device__ __forceinline__ float bfhi(unsigned w) { return __uint_as_float(w & 0xffff0000u); }
__device__ __forceinline__ float sigm(float x) { return 1.0f / (1.0f + __expf(-x)); }
__device__ __forceinline__ float silu_(float x) { return x / (1.0f + __expf(-x)); }
typedef unsigned u32x2 __attribute__((ext_vector_type(2)));

enum { EM_SWIGLU = 0, EM_RESID = 1, EM_WIN = 2, EM_LORA = 3, EM_M1 = 4, EM_M2 = 5 };
struct EpiGen {
    static constexpr bool AFTER_DRAIN = false;
    int mode; bool PERM;
    void* o0; void* o1; void* o2; const void* i0; const void* i1; const float* f0; const float* f1;
    float alpha, scale;
    __device__ __forceinline__ void operator()(const f32x4 (&acc)[2][2][4][2], const Unit& u, int wr, int wc, int fr, int fq) const {
        const int row0 = u.pm * BM + wr * 64 + fr;
        if (mode == EM_SWIGLU) {
            bf16_t* O = (bf16_t*)o0; const int col0 = u.pn * 128 + wc * 32 + 8 * fq;
#pragma unroll
            for (int ai = 0; ai < 2; ++ai)
#pragma unroll
                for (int m = 0; m < 4; ++m) { bf16_t* rowp = O + (size_t)(row0 + ai * HALF + m * 16) * 5632 + col0;
                    const f32x4 g0 = acc[ai][0][m][0], g1 = acc[ai][0][m][1], u0 = acc[ai][1][m][0], u1 = acc[ai][1][m][1];
                    f32x4 v0, v1;
#pragma unroll
                    for (int j = 0; j < 4; ++j) { v0[j] = silu_(g0[j]) * u0[j]; v1[j] = silu_(g1[j]) * u1[j]; }
                    u32x4 w; w.x = cvt_pk_bf16(v0[0], v0[1]); w.y = cvt_pk_bf16(v0[2], v0[3]); w.z = cvt_pk_bf16(v1[0], v1[1]); w.w = cvt_pk_bf16(v1[2], v1[3]);
                    *(u32x4*)rowp = w; }
        } else if (mode == EM_RESID) {
            float* C = (float*)o0; const bf16_t* R = (const bf16_t*)i0; const int col0 = u.pn * BM + wc * 32 + 4 * fq;
#pragma unroll
            for (int ai = 0; ai < 2; ++ai)
#pragma unroll
                for (int m = 0; m < 4; ++m) { const size_t off = (size_t)(row0 + ai * HALF + m * 16) * 2048 + col0;
#pragma unroll
                    for (int bj = 0; bj < 2; ++bj)
#pragma unroll
                        for (int n = 0; n < 2; ++n) { const u32x2 rv = *(const u32x2*)(R + off + bj * HALF + n * 16);
                            f32x4 o; o[0] = alpha * bflo(rv.x) + scale * acc[ai][bj][m][n][0]; o[1] = alpha * bfhi(rv.x) + scale * acc[ai][bj][m][n][1];
                            o[2] = alpha * bflo(rv.y) + scale * acc[ai][bj][m][n][2]; o[3] = alpha * bfhi(rv.y) + scale * acc[ai][bj][m][n][3];
                            *(f32x4*)(C + off + bj * HALF + n * 16) = o; } }
        } else if (mode == EM_WIN) {
            const int pn = u.pn; bf16_t* O; int ld, colt, act;
            if (pn < 14) { O = (bf16_t*)o0; ld = 3584; colt = pn * BM; act = 0; }
            else if (pn < 22) { O = (bf16_t*)o0 + (size_t)8704 * 3584; ld = 2048; colt = (pn - 14) * BM; act = 1; }
            else if (pn < 34) { O = (bf16_t*)o0 + (size_t)8704 * (3584 + 2048); ld = 3072; colt = (pn - 22) * BM; act = 0; }
            else { O = (bf16_t*)o0 + (size_t)8704 * (3584 + 2048 + 3072); ld = 4096; colt = (pn - 34) * BM; act = 2; }
            const int col0 = colt + wc * 32 + 8 * fq;
            f32x4 bv[2][2];
#pragma unroll
            for (int bj = 0; bj < 2; ++bj)
#pragma unroll
                for (int n = 0; n < 2; ++n) bv[bj][n] = (act == 2) ? *(const f32x4*)(f0 + col0 + bj * HALF + 4 * n) : (f32x4){0.f, 0.f, 0.f, 0.f};
#pragma unroll
            for (int ai = 0; ai < 2; ++ai)
#pragma unroll
                for (int m = 0; m < 4; ++m) { bf16_t* rowp = O + (size_t)(row0 + ai * HALF + m * 16) * ld + col0;
#pragma unroll
                    for (int bj = 0; bj < 2; ++bj) { f32x4 v0 = acc[ai][bj][m][0] + bv[bj][0], v1 = acc[ai][bj][m][1] + bv[bj][1];
                        if (act == 1) {
#pragma unroll
                            for (int j = 0; j < 4; ++j) { v0[j] = silu_(v0[j]); v1[j] = silu_(v1[j]); } }
                        else if (act == 2) {
#pragma unroll
                            for (int j = 0; j < 4; ++j) { v0[j] = sigm(v0[j]); v1[j] = sigm(v1[j]); } }
                        u32x4 w; w.x = cvt_pk_bf16(v0[0], v0[1]); w.y = cvt_pk_bf16(v0[2], v0[3]); w.z = cvt_pk_bf16(v1[0], v1[1]); w.w = cvt_pk_bf16(v1[2], v1[3]);
                        *(u32x4*)(rowp + bj * HALF) = w; } }
        } else if (mode == EM_LORA) {
            const int pn = u.pn; const int col0 = (pn & 3) * BM + wc * 32 + 4 * fq;
            if (pn < 4) {
#pragma unroll
                for (int ai = 0; ai < 2; ++ai)
#pragma unroll
                    for (int m = 0; m < 4; ++m) { const size_t off = (size_t)(row0 + ai * HALF + m * 16) * 1024 + col0;
#pragma unroll
                        for (int bj = 0; bj < 2; ++bj)
#pragma unroll
                            for (int n = 0; n < 2; ++n) { const int c = col0 + bj * HALF + n * 16; const f32x4 a = acc[ai][bj][m][n]; const f32x4 b = *(const f32x4*)(f0 + c); f32x4 o;
#pragma unroll
                                for (int j = 0; j < 4; ++j) o[j] = __expf(-0.6065306597f * sigm(a[j] + b[j]));
                                *(f32x4*)((float*)o0 + off + bj * HALF + n * 16) = o; } }
            } else if (pn < 8) {
#pragma unroll
                for (int ai = 0; ai < 2; ++ai)
#pragma unroll
                    for (int m = 0; m < 4; ++m) { const size_t off = (size_t)(row0 + ai * HALF + m * 16) * 1024 + col0;
#pragma unroll
                        for (int bj = 0; bj < 2; ++bj)
#pragma unroll
                            for (int n = 0; n < 2; ++n) { const int c = col0 + bj * HALF + n * 16; const f32x4 a = acc[ai][bj][m][n]; const f32x4 b = *(const f32x4*)(f1 + c);
                                u32x2 w; w.x = cvt_pk_bf16(sigm(a[0] + b[0]), sigm(a[1] + b[1])); w.y = cvt_pk_bf16(sigm(a[2] + b[2]), sigm(a[3] + b[3]));
                                *(u32x2*)((bf16_t*)o1 + off + bj * HALF + n * 16) = w; } }
            } else {
#pragma unroll
                for (int ai = 0; ai < 2; ++ai)
#pragma unroll
                    for (int m = 0; m < 4; ++m) { const size_t off = (size_t)(row0 + ai * HALF + m * 16) * 1024 + col0;
#pragma unroll
                        for (int bj = 0; bj < 2; ++bj)
#pragma unroll
                            for (int n = 0; n < 2; ++n) { const f32x4 a = acc[ai][bj][m][n];
                                u32x2 w; w.x = cvt_pk_bf16(a[0], a[1]); w.y = cvt_pk_bf16(a[2], a[3]); *(u32x2*)((bf16_t*)o2 + off + bj * HALF + n * 16) = w; } }
            }
        } else if (mode == EM_M1) {
            float* C = (float*)o0; const bf16_t* Gt = (const bf16_t*)i0; const int col0 = u.pn * BM + wc * 32 + 4 * fq;
#pragma unroll
            for (int ai = 0; ai < 2; ++ai)
#pragma unroll
                for (int m = 0; m < 4; ++m) { const size_t r = (size_t)(row0 + ai * HALF + m * 16);
#pragma unroll
                    for (int bj = 0; bj < 2; ++bj)
#pragma unroll
                        for (int n = 0; n < 2; ++n) { const int c = col0 + bj * HALF + n * 16; const u32x2 gv = *(const u32x2*)(Gt + r * 4096 + c); const f32x4 a = acc[ai][bj][m][n];
                            f32x4 o; o[0] = bflo(gv.x) * a[0]; o[1] = bfhi(gv.x) * a[1]; o[2] = bflo(gv.y) * a[2]; o[3] = bfhi(gv.y) * a[3];
                            *(f32x4*)(C + r * 2048 + c) = o; } }
        } else {
            bf16_t* O = (bf16_t*)o0; const bf16_t* Gt = (const bf16_t*)i0; const float* T1 = (const float*)i1; const int col0 = u.pn * BM + wc * 32 + 8 * fq;
#pragma unroll
            for (int ai = 0; ai < 2; ++ai)
#pragma unroll
                for (int m = 0; m < 4; ++m) { const size_t r = (size_t)(row0 + ai * HALF + m * 16);
#pragma unroll
                    for (int bj = 0; bj < 2; ++bj) { const int c = col0 + bj * HALF; const u32x4 gv = *(const u32x4*)(Gt + r * 4096 + 2048 + c);
                        const f32x4 t0 = *(const f32x4*)(T1 + r * 2048 + c), t1 = *(const f32x4*)(T1 + r * 2048 + c + 4); const f32x4 a0 = acc[ai][bj][m][0], a1 = acc[ai][bj][m][1];
                        u32x4 w; w.x = cvt_pk_bf16(t0[0] + bflo(gv.x) * a0[0], t0[1] + bfhi(gv.x) * a0[1]); w.y = cvt_pk_bf16(t0[2] + bflo(gv.y) * a0[2], t0[3] + bfhi(gv.y) * a0[3]);
                        w.z = cvt_pk_bf16(t1[0] + bflo(gv.z) * a1[0], t1[1] + bfhi(gv.z) * a1[1]); w.w = cvt_pk_bf16(t1[2] + bflo(gv.w) * a1[2], t1[3] + bfhi(gv.w) * a1[3]);
                        *(u32x4*)(O + r * 2048 + c) = w; } }
        }
    }
};
template <class Epi, class Sched, bool ALIGN_EPI = false, bool SP2 = false>
__device__ __forceinline__ void gemm_phase(PG8_LAS unsigned char* lds, const Gemm g, const Sched& S, const Epi& E) {
    const int tid = threadIdx.x, wid = __builtin_amdgcn_readfirstlane(tid >> 6), lane = tid & 63, wr = wid >> 2, wc = wid & 3, fr = lane & 15, fq = lane >> 4;
    const int K = g.K, nt = K / BK;
    unsigned voffA[2], voffB[2];
#pragma unroll
    for (int i = 0; i < 2; ++i) { int R, C; stage_rc(tid * 16 + i * 8192, R, C); const int Rb = E.PERM ? ((R & ~31) + perm32(R & 31)) : R;
        voffA[i] = (unsigned)(R * K + C) * 2u; voffB[i] = (unsigned)(Rb * K + C) * 2u; }
    const size_t kstep = (size_t)(BK * 2);
    const size_t hstep = (size_t)HALF * K * 2;
    const size_t tstep = 2 * hstep;
    const unsigned ldsw = (unsigned)wid * 1024u;
    const int aoff = lds_byte(wr * 64 + fr, fq * 8), boff = lds_byte(wc * 32 + fr, fq * 8);
#define PG8_SA(b, h) (((b) * 2 + (h)) * HTB)
#define PG8_SB(b, h) ((4 + (b) * 2 + (h)) * HTB)
#define PG8_STAGE(bufoff, gbase, voff) do { _Pragma("unroll") for (int _i = 0; _i < 2; ++_i) \
        __builtin_amdgcn_global_load_lds((const unsigned*)((const char*)(gbase) + (voff)[_i]), (PG8_LAS unsigned*)(lds + (bufoff) + ldsw + _i * 8192), 16, 0, 0); } while (0)
#define PG8_LDA(dst, b, h) do { _Pragma("unroll") for (int m = 0; m < 4; ++m) _Pragma("unroll") for (int k = 0; k < 2; ++k) dst[m][k] = *(const PG8_LAS bf16x8*)(lds + PG8_SA(b, h) + aoff + m * 2048 + k * 1024); } while (0)
#define PG8_LDB(dst, b, h) do { _Pragma("unroll") for (int n = 0; n < 2; ++n) _Pragma("unroll") for (int k = 0; k < 2; ++k) dst[n][k] = *(const PG8_LAS bf16x8*)(lds + PG8_SB(b, h) + boff + n * 2048 + k * 1024); } while (0)
#define PG8_MMA(ai, bj, At, Bt) do { __builtin_amdgcn_s_setprio(1); _Pragma("unroll") for (int m = 0; m < 4; ++m) _Pragma("unroll") for (int n = 0; n < 2; ++n) _Pragma("unroll") for (int k = 0; k < 2; ++k) \
        acc[ai][bj][m][n] = __builtin_amdgcn_mfma_f32_16x16x32_bf16(Bt[n][k], At[m][k], acc[ai][bj][m][n], 0, 0, 0); __builtin_amdgcn_s_setprio(0); } while (0)
#define PG8_WAIT_V(n) asm volatile("s_waitcnt vmcnt(" #n ")" ::: "memory")
#define PG8_WAIT_L(n) asm volatile("s_waitcnt lgkmcnt(" #n ")" ::: "memory")
#define PG8_BAR __builtin_amdgcn_s_barrier()
#define PG8_SCHED __builtin_amdgcn_sched_barrier(0)
    Unit cur, nxt; int ui = 0;
    if (!S.next(0, cur)) return;
    f32x4 acc[2][2][4][2];
#pragma unroll
    for (int a = 0; a < 2; ++a)
#pragma unroll
        for (int b = 0; b < 2; ++b)
#pragma unroll
            for (int m = 0; m < 4; ++m)
#pragma unroll
                for (int n = 0; n < 2; ++n) acc[a][b][m][n] = (f32x4){0.f, 0.f, 0.f, 0.f};
    bf16x8 At[4][2], B0[2][2], B1[2][2];
    const char* cA = (const char*)g.A + (size_t)cur.pm * tstep; const char* cB = (const char*)g.Bt + (size_t)cur.pn * tstep;
    S.a_ready(cur);
    if constexpr (SP2) {
        PG8_STAGE(PG8_SB(0, 0), cB, voffB); PG8_STAGE(PG8_SB(0, 1), cB + hstep, voffB); PG8_STAGE(PG8_SA(0, 0), cA, voffA); PG8_STAGE(PG8_SA(0, 1), cA + hstep, voffA);
        if (wr == 1) PG8_BAR;
        PG8_WAIT_V(2); PG8_BAR;
        PG8_STAGE(PG8_SB(1, 0), cB + kstep, voffB); PG8_STAGE(PG8_SA(1, 0), cA + kstep, voffA); PG8_STAGE(PG8_SB(1, 1), cB + hstep + kstep, voffB);
        PG8_WAIT_V(6); PG8_BAR;
    } else {
        PG8_STAGE(PG8_SB(0, 0), cB, voffB); PG8_STAGE(PG8_SA(0, 0), cA, voffA); PG8_STAGE(PG8_SB(0, 1), cB + hstep, voffB); PG8_STAGE(PG8_SA(0, 1), cA + hstep, voffA);
        if (wr == 1) PG8_BAR;
        PG8_WAIT_V(4); PG8_BAR;
        PG8_STAGE(PG8_SB(1, 0), cB + kstep, voffB); PG8_STAGE(PG8_SA(1, 0), cA + kstep, voffA); PG8_STAGE(PG8_SB(1, 1), cB + hstep + kstep, voffB);
        PG8_WAIT_V(6); PG8_BAR;
    }
    for (;;) {
        const bool has_next = S.next(ui + 1, nxt);
        const char* nA = has_next ? (const char*)g.A + (size_t)nxt.pm * tstep : cA; const char* nB = has_next ? (const char*)g.Bt + (size_t)nxt.pn * tstep : cB;
        for (int t = 0; t < nt; t += 2) {
            const bool last = (t == nt - 2);
            const char* a1 = cA + (size_t)(t + 1) * kstep;
            const char* a2 = last ? nA : cA + (size_t)(t + 2) * kstep; const char* b2 = last ? nB : cB + (size_t)(t + 2) * kstep;
            const char* a3 = a2 + kstep; const char* b3 = b2 + kstep;
            if (last && has_next) S.a_ready(nxt);
            if constexpr (SP2) {
            PG8_LDB(B0, 0, 0); PG8_LDB(B1, 0, 1); PG8_SCHED; PG8_LDA(At, 0, 0); PG8_STAGE(PG8_SA(1, 1), a1 + hstep, voffA);
            PG8_WAIT_V(8); PG8_WAIT_L(0); PG8_BAR; PG8_MMA(0, 0, At, B0); PG8_MMA(0, 1, At, B1); PG8_BAR; PG8_SCHED;
            PG8_LDA(At, 0, 1); PG8_STAGE(PG8_SB(0, 0), b2, voffB); PG8_STAGE(PG8_SB(0, 1), b2 + hstep, voffB); PG8_STAGE(PG8_SA(0, 0), a2, voffA);
            PG8_WAIT_V(8); PG8_WAIT_L(0); PG8_BAR; PG8_MMA(1, 0, At, B0); PG8_MMA(1, 1, At, B1); PG8_BAR; PG8_SCHED;
            PG8_LDB(B0, 1, 0); PG8_LDB(B1, 1, 1); PG8_SCHED; PG8_LDA(At, 1, 0); PG8_STAGE(PG8_SA(0, 1), a2 + hstep, voffA);
            PG8_WAIT_V(8); PG8_WAIT_L(0); PG8_BAR; PG8_MMA(0, 0, At, B0); PG8_MMA(0, 1, At, B1); PG8_BAR; PG8_SCHED;
            PG8_LDA(At, 1, 1); PG8_STAGE(PG8_SB(1, 0), b3, voffB); PG8_STAGE(PG8_SB(1, 1), b3 + hstep, voffB); PG8_STAGE(PG8_SA(1, 0), a3, voffA);
            PG8_WAIT_V(8); PG8_WAIT_L(0); PG8_BAR; PG8_MMA(1, 0, At, B0); PG8_MMA(1, 1, At, B1); PG8_BAR; PG8_SCHED;
            } else {
            PG8_LDB(B0, 0, 0); PG8_SCHED; PG8_LDA(At, 0, 0); PG8_STAGE(PG8_SA(1, 1), a1 + hstep, voffA);
            PG8_WAIT_L(8); PG8_BAR; PG8_WAIT_L(0); PG8_MMA(0, 0, At, B0); PG8_BAR; PG8_SCHED;
            PG8_LDB(B1, 0, 1); PG8_STAGE(PG8_SB(0, 0), b2, voffB);
            PG8_BAR; PG8_WAIT_L(0); PG8_MMA(0, 1, At, B1); PG8_BAR;
            PG8_LDA(At, 0, 1); PG8_STAGE(PG8_SA(0, 0), a2, voffA);
            PG8_BAR; PG8_WAIT_L(0); PG8_MMA(1, 0, At, B0); PG8_BAR; PG8_SCHED;
            PG8_STAGE(PG8_SB(0, 1), b2 + hstep, voffB);
            PG8_WAIT_V(6); PG8_BAR; PG8_MMA(1, 1, At, B1); PG8_BAR;
            PG8_LDB(B0, 1, 0); PG8_SCHED; PG8_LDA(At, 1, 0); PG8_STAGE(PG8_SA(0, 1), a2 + hstep, voffA);
            PG8_WAIT_L(8); PG8_BAR; PG8_WAIT_L(0); PG8_MMA(0, 0, At, B0); PG8_BAR; PG8_SCHED;
            PG8_LDB(B1, 1, 1); PG8_STAGE(PG8_SB(1, 0), b3, voffB);
            PG8_BAR; PG8_WAIT_L(0); PG8_MMA(0, 1, At, B1); PG8_BAR;
            PG8_LDA(At, 1, 1); PG8_STAGE(PG8_SA(1, 0), a3, voffA);
            PG8_BAR; PG8_WAIT_L(0); PG8_MMA(1, 0, At, B0); PG8_BAR; PG8_SCHED;
            PG8_STAGE(PG8_SB(1, 1), b3 + hstep, voffB);
            PG8_WAIT_V(6); PG8_BAR; PG8_MMA(1, 1, At, B1); PG8_BAR;
            }
        }
        if constexpr (ALIGN_EPI) { if (wr == 0) PG8_BAR; }
        if constexpr (!Epi::AFTER_DRAIN) { E(acc, cur, wr, wc, fr, fq); S.done(cur); }
        if (!has_next) break;
#pragma unroll
        for (int a = 0; a < 2; ++a)
#pragma unroll
            for (int b = 0; b < 2; ++b)
#pragma unroll
                for (int m = 0; m < 4; ++m)
#pragma unroll
                    for (int n = 0; n < 2; ++n) acc[a][b][m][n] = (f32x4){0.f, 0.f, 0.f, 0.f};
        cur = nxt; cA = nA; cB = nB; ++ui;
        if constexpr (ALIGN_EPI) { if (wr == 1) PG8_BAR; }
    }
    PG8_WAIT_V(0);
    if constexpr (!ALIGN_EPI) { if (wr == 0) PG8_BAR; }
    PG8_BAR;
    if constexpr (Epi::AFTER_DRAIN) { E.fused(acc, cur, wr, wc, fr, fq, lds, wid, lane); S.done(cur); }
#undef PG8_SA
#undef PG8_SB
#undef PG8_STAGE
#undef PG8_LDA
#undef PG8_LDB
#undef PG8_MMA
#undef PG8_WAIT_V
#undef PG8_WAIT_L
#undef PG8_BAR
#undef PG8_SCHED
}
}

#define LAS __attribute__((address_space(3)))
typedef unsigned short bf16;
typedef float f32x4 __attribute__((ext_vector_type(4)));
typedef unsigned u32x4 __attribute__((ext_vector_type(4)));
typedef unsigned u32x2 __attribute__((ext_vector_type(2)));
typedef short bf16x8 __attribute__((ext_vector_type(8)));
using pg8::bf2f; using pg8::bflo; using pg8::bfhi; using pg8::sigm; using pg8::silu_; using pg8::cvt_pk_bf16;

constexpr int D = 2048, FF = 5632, NB = 4, SEQ = 2048, NMETA = 16, PADR = 48, LP = 2112  , TP = 2064  ;
constexpr int SB = 16, SS = 16, MP = NB * LP  , MROWS = MP + SB * SS  ;
constexpr int RWD = 1024, RWH = 16, SHC = 3520, CONVD = 3072, SSMH = 32, SSMN = 128, NINP = 12800;
constexpr int PRW_LD = 3584, Z_LD = 2048, XBC_LD = 3072, GATE_LD = 4096;
constexpr float LN_EPS = 1e-5f, ALPHA = 1.189207115f  , GN_EPS = 64e-5f, RMS_EPS = 1e-5f;
constexpr int NPHASE = 17;
constexpr int LDS_BYTES = 163840;

enum { I_XP = 0, I_XS, I_SSH, I_SWKV, I_SCONV, I_SSSM, I_META, I_GU1, I_DN1, I_LN1G, I_LN1B, I_WIN, I_BGATE, I_MU, I_W0, I_W2, I_A0, I_A2, I_G2, I_KK, I_KA, I_RK, I_GNW, I_GNB,
       I_CONVW, I_CONVB, I_DTB, I_ALOG, I_DSKIP, I_NORMW, I_RWO, I_SSMO, I_WO, I_LN2G, I_LN2B, I_GU2, I_DN2, I_LN3G, I_LN3B, N_IN };
constexpr size_t O_YP = 0, O_YS = 16777216, O_PSH = 17301504, O_PWKV = 17315584, O_PCONV = 17577728, O_PSSM = 17614592, O_SSH = 18663168, O_SWKV = 18719488, O_SCONV = 19768064, O_SSSM = 19915520, O_END = 24109824;
constexpr size_t MiB = 1u << 20;
constexpr size_t WS_SBON = 1 * MiB, WS_RWOT = 2 * MiB, WS_SSMOT = 6 * MiB, WS_WOT = 14 * MiB, WS_LORAT = 22 * MiB, WS_WBIG = 25 * MiB, WS_XB = 91 * MiB, WS_ACT = 125 * MiB, WS_PROJ = 219 * MiB, WS_YRW = 432 * MiB, WS_END = 449 * MiB;
constexpr size_t WS_GUT = WS_WBIG, WS_DNT = WS_WBIG + 44 * MiB, WS_WINT = WS_WBIG, WS_WDEC = WS_WBIG, WS_GBUF = WS_WBIG + 34 * MiB, WS_MERGED = WS_WBIG;
constexpr size_t WS_R = WS_ACT, WS_KP = WS_ACT + 17 * MiB, WS_V = WS_ACT + 34 * MiB, WS_KK = WS_ACT + 51 * MiB, WS_BB = WS_ACT + 68 * MiB, WS_ALORA = WS_ACT + 85 * MiB, WS_T1 = WS_ACT;
constexpr size_t WS_PRW = WS_PROJ, WS_Z = WS_PRW + (size_t)MROWS * PRW_LD * 2, WS_XBC = WS_Z + (size_t)MROWS * Z_LD * 2, WS_GATE = WS_XBC + (size_t)MROWS * XBC_LD * 2, WS_PRE = WS_PROJ;
static_assert(WS_GATE + (size_t)MROWS * GATE_LD * 2 <= WS_YRW, "proj region");
static_assert(WS_ALORA + (size_t)MROWS * 512 * 2 <= WS_PROJ, "act region");

struct Params { const float* in[N_IN]; float* out; unsigned char* ws; int ph_lo, ph_hi; };

__device__ __forceinline__ int opaque_idx(int i) { asm volatile("" : "+s"(i)); return i; }
#define PIN(i) (p.in[opaque_idx(i)])
struct Ctx { int tid, lane, wave, gw, ngw; LAS unsigned char* lds; };

__device__ __forceinline__ float wave_sum(float v) {
#pragma unroll
    for (int o = 1; o < 64; o <<= 1) v += __shfl_xor(v, o);
    return v;
}
__device__ __forceinline__ unsigned pk2(float lo, float hi) { return cvt_pk_bf16(lo, hi); }
__device__ __forceinline__ float softplus_(float x) { return fmaxf(x, 0.f) + __logf(1.f + __expf(-fabsf(x))); }

__device__ __forceinline__ const float* xrow_ptr(const Params& p, int row) {
    if (row < MP) { const int b = row / LP, q = row - b * LP; if (q < PADR) return nullptr; const int t = q - PADR;
        return t < NMETA ? PIN(I_META) + (size_t)t * D : PIN(I_XP) + ((size_t)b * SEQ + (t - NMETA)) * D; }
    return PIN(I_XS) + (size_t)(row - MP) * D;
}
__device__ __forceinline__ float* yrow_ptr(const Params& p, int row) {
    if (row < MP) { const int b = row / LP, q = row - b * LP; if (q < PADR + NMETA) return nullptr; return p.out + O_YP + ((size_t)b * SEQ + (q - PADR - NMETA)) * D; }
    return p.out + O_YS + (size_t)(row - MP) * D;
}
__device__ __forceinline__ bool row_is_pad(int row) { return row < MP && (row % LP) < PADR; }

__device__ __forceinline__ void phase_convert_x(const Params& p, const Ctx& c) {
    bf16* XB = (bf16*)(p.ws + WS_XB);
    for (int row = c.gw; row < MROWS; row += c.ngw) { const float* src = xrow_ptr(p, row); u32x2* dst = (u32x2*)(XB + (size_t)row * D);
#pragma unroll
        for (int j = 0; j < 8; ++j) { f32x4 v = src ? ((const f32x4*)src)[c.lane + 64 * j] : (f32x4){0.f, 0.f, 0.f, 0.f}; u32x2 w; w.x = pk2(v[0], v[1]); w.y = pk2(v[2], v[3]); dst[c.lane + 64 * j] = w; } }
}
enum { MAP_ID = 0, MAP_GU = 1, MAP_WIN = 2 };
__device__ __forceinline__ int map_src_col(int kind, int c) {
    if (kind == MAP_ID) return c;
    if (kind == MAP_GU) { const int pn = c >> 8, bj = (c >> 7) & 1, r = c & 127; return bj * FF + 128 * pn + r; }
    if (c < 3520) return c; if (c < 3552) return 8640 + (c - 3520); if (c < 3584) return -1; if (c < 5632) return 3520 + (c - 3584); if (c < 8704) return 5568 + (c - 5632); return 8672 + (c - 8704);
}
__device__ __forceinline__ void transpose_w(const float* W, int K, int Nsrc, bf16* WT, int ndst, int kind, const Ctx& c) {
    LAS float* scr = (LAS float*)(c.lds + c.wave * 8704);
    const int nblk = ndst / 32, nitems = (K / 64) * nblk, lane = c.lane;
    for (int it = c.gw; it < nitems; it += c.ngw) {
        const int kb = it / nblk, nb = it - kb * nblk, k0 = 64 * kb, n0 = 32 * nb; const int sc = map_src_col(kind, n0);
        if (sc >= 0) {
#pragma unroll 8
            for (int i = 0; i < 32; ++i) { const int kk = 2 * i + (lane >> 5); scr[kk * 33 + (lane & 31)] = W[(size_t)(k0 + kk) * Nsrc + sc + (lane & 31)]; }
        } else {
#pragma unroll 8
            for (int i = 0; i < 32; ++i) { const int kk = 2 * i + (lane >> 5); scr[kk * 33 + (lane & 31)] = 0.f; }
        }
        asm volatile("s_waitcnt lgkmcnt(0)" ::: "memory");
        const int cc = lane & 7;
#pragma unroll
        for (int j = 0; j < 4; ++j) { const int n = (lane >> 3) + 8 * j; const LAS float* s = scr + (8 * cc) * 33 + n;
            u32x4 o; o.x = pk2(s[0 * 33], s[1 * 33]); o.y = pk2(s[2 * 33], s[3 * 33]); o.z = pk2(s[4 * 33], s[5 * 33]); o.w = pk2(s[6 * 33], s[7 * 33]);
            *(u32x4*)(WT + (size_t)(n0 + n) * K + k0 + 8 * cc) = o; }
        asm volatile("s_waitcnt lgkmcnt(0)" ::: "memory");
    }
}
__device__ __forceinline__ void build_lorat(const Params& p, const Ctx& c) {
    bf16* LT = (bf16*)(p.ws + WS_LORAT); const float* w2 = PIN(I_W2); const float* a2 = PIN(I_A2); const float* g2 = PIN(I_G2);
    const int gt = blockIdx.x * 512 + c.tid, ngt = gridDim.x * 512;
    for (int idx = gt; idx < 3072 * 512; idx += ngt) { const int k = idx / 3072, n = idx - k * 3072; float v = 0.f;
        if (n < 1024) { if (k < 96) v = w2[k * 1024 + n]; }
        else if (n < 2048) { if (k >= 96 && k < 192) v = a2[(k - 96) * 1024 + (n - 1024)]; }
        else { if (k >= 256) v = g2[(k - 256) * 1024 + (n - 2048)]; }
        LT[(size_t)n * 512 + k] = (bf16)(pk2(v, 0.f) & 0xffffu); }
}
template <bool FINAL> __device__ __forceinline__ void phase_ln(const Params& p, const Ctx& c, const float* gam, const float* bet) {
    const float* PRE = (const float*)(p.ws + WS_PRE); bf16* XB = (bf16*)(p.ws + WS_XB);
    f32x4 gv[8], bv[8];
#pragma unroll
    for (int j = 0; j < 8; ++j) { gv[j] = ((const f32x4*)gam)[c.lane + 64 * j]; bv[j] = ((const f32x4*)bet)[c.lane + 64 * j]; }
    for (int row = c.gw; row < MROWS; row += c.ngw) {
        float* yo = nullptr; if (FINAL) { yo = yrow_ptr(p, row); if (!yo) continue; }
        const f32x4* src = (const f32x4*)(PRE + (size_t)row * D); f32x4 v[8]; float s = 0.f;
#pragma unroll
        for (int j = 0; j < 8; ++j) { v[j] = src[c.lane + 64 * j]; s += (v[j][0] + v[j][1]) + (v[j][2] + v[j][3]); }
        const float mean = wave_sum(s) * (1.f / D); float q = 0.f;
#pragma unroll
        for (int j = 0; j < 8; ++j) { v[j] = v[j] - mean; q += (v[j][0] * v[j][0] + v[j][1] * v[j][1]) + (v[j][2] * v[j][2] + v[j][3] * v[j][3]); }
        const float rstd = 1.f / sqrtf(wave_sum(q) * (1.f / D) + LN_EPS);
#pragma unroll
        for (int j = 0; j < 8; ++j) { const f32x4 o = v[j] * rstd * gv[j] + bv[j];
            if (FINAL) ((f32x4*)yo)[c.lane + 64 * j] = o;
            else { u32x2 w; w.x = pk2(o[0], o[1]); w.y = pk2(o[2], o[3]); ((u32x2*)(XB + (size_t)row * D))[c.lane + 64 * j] = w; } }
    }
}
__device__ __forceinline__ void phase_prep1(const Params& p, const Ctx& c) {
    const bf16* PRW = (const bf16*)(p.ws + WS_PRW); const bf16* XBC = (const bf16*)(p.ws + WS_XBC); bf16* AL = (bf16*)(p.ws + WS_ALORA); const float* mu = PIN(I_MU);
    for (int row = c.gw; row < MROWS; row += c.ngw) {
        bf16* al = AL + (size_t)row * 512;
        if (row_is_pad(row)) {
#pragma unroll
            for (int i = 0; i < 8; ++i) al[c.lane + 64 * i] = 0; continue; }
        const bf16* cur = PRW + (size_t)row * PRW_LD; const bf16* prv = nullptr; const float* prvf = nullptr;
        if (row < MP) { if ((row % LP) != PADR) prv = cur - PRW_LD; }
        else { const int s = row - MP; if ((s & 15) != 0) prv = cur - PRW_LD; else prvf = PIN(I_SSH) + (size_t)(s >> 4) * SHC; }
#pragma unroll
        for (int i = 0; i < 7; ++i) { const int col = 3072 + c.lane + 64 * i; const float pc = bf2f(cur[col]); const float pp = prv ? bf2f(prv[col]) : (prvf ? prvf[col] : 0.f);
            const float ps = pc + (pp - pc) * mu[col]; const int lc = c.lane + 64 * i;
            if (lc < 96) al[lc] = (bf16)(pk2(tanhf(ps), 0.f) & 0xffffu);
            else if (lc < 192) al[lc] = (bf16)(pk2(ps, 0.f) & 0xffffu);
            else al[256 + (lc - 192)] = (bf16)(pk2(sigm(ps), 0.f) & 0xffffu); }
        al[192 + c.lane] = 0;
    }
    const int gt = blockIdx.x * 512 + c.tid, ngt = gridDim.x * 512;
    for (int i = gt; i < NB * SHC; i += ngt) { const int b = i / SHC, col = i - b * SHC; p.out[O_PSH + i] = bf2f(PRW[(size_t)(b * LP + LP - 1) * PRW_LD + col]); }
    for (int i = gt; i < SB * SHC; i += ngt) { const int b = i / SHC, col = i - b * SHC; p.out[O_SSH + i] = bf2f(PRW[(size_t)(MP + b * SS + SS - 1) * PRW_LD + col]); }
    for (int i = gt; i < NB * 3 * CONVD; i += ngt) { const int b = i / (3 * CONVD), r = (i / CONVD) % 3, col = i % CONVD; p.out[O_PCONV + i] = bf2f(XBC[(size_t)(b * LP + LP - 3 + r) * XBC_LD + col]); }
    for (int i = gt; i < SB * 3 * CONVD; i += ngt) { const int b = i / (3 * CONVD), r = (i / CONVD) % 3, col = i % CONVD; p.out[O_SCONV + i] = bf2f(XBC[(size_t)(MP + b * SS + SS - 3 + r) * XBC_LD + col]); }
}
__device__ __forceinline__ float sum16(float v) { v += __shfl_xor(v, 1); v += __shfl_xor(v, 2); v += __shfl_xor(v, 4); v += __shfl_xor(v, 8); return v; }
__device__ __forceinline__ void ld4bf(const bf16* ptr, float (&o)[4]) { const u32x2 w = *(const u32x2*)ptr; o[0] = bflo(w.x); o[1] = bfhi(w.x); o[2] = bflo(w.y); o[3] = bfhi(w.y); }
__device__ __forceinline__ void st4bf(bf16* ptr, const float (&v)[4]) { u32x2 w; w.x = pk2(v[0], v[1]); w.y = pk2(v[2], v[3]); *(u32x2*)ptr = w; }
__device__ __forceinline__ void shifted4(const bf16* cur, const bf16* prv, const float* prvf, int col, const float* mu, float (&o)[4]) {
    float pc[4], pp[4]; ld4bf(cur + col, pc);
    if (prv) ld4bf(prv + col, pp); else if (prvf) { const f32x4 t = *(const f32x4*)(prvf + col); pp[0] = t[0]; pp[1] = t[1]; pp[2] = t[2]; pp[3] = t[3]; } else { pp[0] = pp[1] = pp[2] = pp[3] = 0.f; }
    const f32x4 m = *(const f32x4*)(mu + col);
#pragma unroll
    for (int j = 0; j < 4; ++j) o[j] = pc[j] + (pp[j] - pc[j]) * m[j];
}
__device__ __forceinline__ void phase_prep2(const Params& p, const Ctx& c) {
    const bf16* PRW = (const bf16*)(p.ws + WS_PRW); bf16* R = (bf16*)(p.ws + WS_R); bf16* KP = (bf16*)(p.ws + WS_KP); bf16* V = (bf16*)(p.ws + WS_V); bf16* KK = (bf16*)(p.ws + WS_KK); bf16* BB = (bf16*)(p.ws + WS_BB);
    float* SBON = (float*)(p.ws + WS_SBON); const float* mu = PIN(I_MU);
    const int t4 = c.tid & 255, ch = 4 * t4, head = t4 >> 4;
    const f32x4 wkk = *(const f32x4*)(PIN(I_KK) + ch), wka = *(const f32x4*)(PIN(I_KA) + ch), wrk = *(const f32x4*)(PIN(I_RK) + ch);
    for (int row = blockIdx.x * 2 + (c.tid >> 8); row < MROWS; row += gridDim.x * 2) {
        if (row_is_pad(row)) continue;
        const bf16* cur = PRW + (size_t)row * PRW_LD; const bf16* prv = nullptr; const float* prvf = nullptr;
        if (row < MP) { if ((row % LP) != PADR) prv = cur - PRW_LD; }
        else { const int s = row - MP; if ((s & 15) != 0) prv = cur - PRW_LD; else prvf = PIN(I_SSH) + (size_t)(s >> 4) * SHC; }
        float r[4], k[4], v[4], a[4];
        shifted4(cur, prv, prvf, ch, mu, r); shifted4(cur, prv, prvf, 1024 + ch, mu, k); shifted4(cur, prv, prvf, 2048 + ch, mu, v);
        ld4bf(BB + (size_t)row * RWD + ch, a);
        float kk[4], ss = 0.f;
#pragma unroll
        for (int j = 0; j < 4; ++j) { kk[j] = k[j] * wkk[j]; ss += kk[j] * kk[j]; }
        ss = sum16(ss); const float inv = 1.f / fmaxf(sqrtf(ss), 1e-12f);
        float kp[4], bb[4], sb = 0.f;
#pragma unroll
        for (int j = 0; j < 4; ++j) { kk[j] *= inv; kp[j] = k[j] * (1.f + (a[j] - 1.f) * wka[j]); bb[j] = kk[j] * a[j]; sb += r[j] * kp[j] * wrk[j]; }
        sb = sum16(sb);
        const size_t o = (size_t)row * RWD + ch;
        st4bf(R + o, r); st4bf(KP + o, kp); st4bf(V + o, v); st4bf(KK + o, kk); st4bf(BB + o, bb);
        if ((t4 & 15) == 0) SBON[(size_t)row * RWH + head] = sb;
    }
}
__device__ __forceinline__ void phase_post(const Params& p, const Ctx& c) {
    const float* YRAW = p.out; const bf16* V = (const bf16*)(p.ws + WS_V); const bf16* G = (const bf16*)(p.ws + WS_GBUF); const float* SBON = (const float*)(p.ws + WS_SBON); bf16* YRW = (bf16*)(p.ws + WS_YRW);
    { const int t4 = c.tid & 255, ch = 4 * t4, head = t4 >> 4;
      const f32x4 gw = *(const f32x4*)(PIN(I_GNW) + ch), gb = *(const f32x4*)(PIN(I_GNB) + ch);
      for (int row = blockIdx.x * 2 + (c.tid >> 8); row < MROWS; row += gridDim.x * 2) {
        const size_t o = (size_t)row * RWD + ch;
        if (row_is_pad(row)) { u32x2 z; z.x = 0; z.y = 0; *(u32x2*)(YRW + o) = z; continue; }
        const f32x4 y = *(const f32x4*)(YRAW + o); float v[4], g[4]; ld4bf(V + o, v); ld4bf(G + o, g);
        const float mean = sum16((y[0] + y[1]) + (y[2] + y[3])) * (1.f / 64.f);
        float d[4], q = 0.f;
#pragma unroll
        for (int j = 0; j < 4; ++j) { d[j] = y[j] - mean; q += d[j] * d[j]; }
        const float rstd = 1.f / sqrtf(sum16(q) * (1.f / 64.f) + GN_EPS); const float sb = SBON[(size_t)row * RWH + head];
        float ov[4];
#pragma unroll
        for (int j = 0; j < 4; ++j) ov[j] = (d[j] * rstd * gw[j] + gb[j] + sb * v[j]) * g[j];
        st4bf(YRW + o, ov);
      } }
    { bf16* Z = (bf16*)(p.ws + WS_Z); const float* nw = PIN(I_NORMW);
      for (int it = c.gw; it < MROWS * 4; it += c.ngw) { const int row = it >> 2, g = it & 3; bf16* ptr = Z + (size_t)row * Z_LD + g * 512 + c.lane * 8;
        const u32x4 w = *(const u32x4*)ptr; float v[8] = {bflo(w.x), bfhi(w.x), bflo(w.y), bfhi(w.y), bflo(w.z), bfhi(w.z), bflo(w.w), bfhi(w.w)};
        float ss = 0.f;
#pragma unroll
        for (int j = 0; j < 8; ++j) ss += v[j] * v[j];
        const float rs = 1.f / sqrtf(wave_sum(ss) * (1.f / 512.f) + RMS_EPS);
        const f32x4 n0 = *(const f32x4*)(nw + g * 512 + c.lane * 8), n1 = *(const f32x4*)(nw + g * 512 + c.lane * 8 + 4);
        u32x4 o; o.x = pk2(v[0] * rs * n0[0], v[1] * rs * n0[1]); o.y = pk2(v[2] * rs * n0[2], v[3] * rs * n0[3]); o.z = pk2(v[4] * rs * n1[0], v[5] * rs * n1[1]); o.w = pk2(v[6] * rs * n1[2], v[7] * rs * n1[3]);
        *(u32x4*)ptr = o; } }
}

constexpr int SC_CH = 32;
constexpr int SC_BUF = 6 * SC_CH * 64 * 4;
__device__ __forceinline__ float dpp_sum8(float x) {
    x += __builtin_bit_cast(float, __builtin_amdgcn_update_dpp(0, __builtin_bit_cast(int, x), 0xB1, 0xF, 0xF, true));
    x += __builtin_bit_cast(float, __builtin_amdgcn_update_dpp(0, __builtin_bit_cast(int, x), 0x4E, 0xF, 0xF, true));
    x += __builtin_bit_cast(float, __builtin_amdgcn_update_dpp(0, __builtin_bit_cast(int, x), 0x141, 0xF, 0xF, true));
    return x;
}
__device__ __forceinline__ void scan_stage(const Params& p, const Ctx& c, LAS float* buf, int row0, int h, int steps, int lt  ) {
    const int i = lt >> 3, ch0 = (lt & 7) * 8;
    if (i < steps) {
        const size_t o = (size_t)(row0 + i) * RWD + h * 64 + ch0;
        const u32x4 wr = *(const u32x4*)((const bf16*)(p.ws + WS_R) + o), wk = *(const u32x4*)((const bf16*)(p.ws + WS_KP) + o), wv = *(const u32x4*)((const bf16*)(p.ws + WS_V) + o),
                    wkk = *(const u32x4*)((const bf16*)(p.ws + WS_KK) + o), wb = *(const u32x4*)((const bf16*)(p.ws + WS_BB) + o);
        const f32x4 d0 = *(const f32x4*)((const float*)(p.ws + WS_WDEC) + o), d1 = *(const f32x4*)((const float*)(p.ws + WS_WDEC) + o + 4);
        LAS f32x4* dst = (LAS f32x4*)(buf + i * 64 + ch0);
#define SC_PUT(arr, V_) do { dst[(arr) * (SC_CH * 16)] = (f32x4){bflo(V_.x), bfhi(V_.x), bflo(V_.y), bfhi(V_.y)}; dst[(arr) * (SC_CH * 16) + 1] = (f32x4){bflo(V_.z), bfhi(V_.z), bflo(V_[3]), bfhi(V_[3])}; } while (0)
        SC_PUT(0, wr); dst[1 * (SC_CH * 16)] = d0; dst[1 * (SC_CH * 16) + 1] = d1; SC_PUT(2, wk); SC_PUT(3, wkk); SC_PUT(4, wb); SC_PUT(5, wv);
#undef SC_PUT
    }
}
struct ScanIn { f32x4 r0, r1, w0, w1, k0, k1, q0, q1, b0, b1; float v;
    __device__ __forceinline__ void load(const LAS float* bR, const LAS float* bV, int i) { const LAS float* bp = bR + i * 64;
        r0 = *(const LAS f32x4*)bp; r1 = *(const LAS f32x4*)(bp + 4); w0 = *(const LAS f32x4*)(bp + SC_CH * 64); w1 = *(const LAS f32x4*)(bp + SC_CH * 64 + 4);
        k0 = *(const LAS f32x4*)(bp + 2 * SC_CH * 64); k1 = *(const LAS f32x4*)(bp + 2 * SC_CH * 64 + 4); q0 = *(const LAS f32x4*)(bp + 3 * SC_CH * 64); q1 = *(const LAS f32x4*)(bp + 3 * SC_CH * 64 + 4);
        b0 = *(const LAS f32x4*)(bp + 4 * SC_CH * 64); b1 = *(const LAS f32x4*)(bp + 4 * SC_CH * 64 + 4); v = bV[i * 64]; } };
__device__ __forceinline__ float scan_step(float (&S)[8], const ScanIn& x) {
    float pa = S[0] * x.q0[0]; float pb = S[2] * x.q0[2]; pa = __builtin_fmaf(S[1], x.q0[1], pa); pb = __builtin_fmaf(S[3], x.q0[3], pb);
    pa = __builtin_fmaf(S[4], x.q1[0], pa); pb = __builtin_fmaf(S[6], x.q1[2], pb); pa = __builtin_fmaf(S[5], x.q1[1], pa); pb = __builtin_fmaf(S[7], x.q1[3], pb);
    const float sa = -dpp_sum8(pa + pb); const float cv = x.v;
    S[0] = __builtin_fmaf(S[0], x.w0[0], __builtin_fmaf(sa, x.b0[0], cv * x.k0[0])); S[1] = __builtin_fmaf(S[1], x.w0[1], __builtin_fmaf(sa, x.b0[1], cv * x.k0[1]));
    S[2] = __builtin_fmaf(S[2], x.w0[2], __builtin_fmaf(sa, x.b0[2], cv * x.k0[2])); S[3] = __builtin_fmaf(S[3], x.w0[3], __builtin_fmaf(sa, x.b0[3], cv * x.k0[3]));
    S[4] = __builtin_fmaf(S[4], x.w1[0], __builtin_fmaf(sa, x.b1[0], cv * x.k1[0])); S[5] = __builtin_fmaf(S[5], x.w1[1], __builtin_fmaf(sa, x.b1[1], cv * x.k1[1]));
    S[6] = __builtin_fmaf(S[6], x.w1[2], __builtin_fmaf(sa, x.b1[2], cv * x.k1[2])); S[7] = __builtin_fmaf(S[7], x.w1[3], __builtin_fmaf(sa, x.b1[3], cv * x.k1[3]));
    float ya = S[0] * x.r0[0]; float yb = S[2] * x.r0[2]; ya = __builtin_fmaf(S[1], x.r0[1], ya); yb = __builtin_fmaf(S[3], x.r0[3], yb);
    ya = __builtin_fmaf(S[4], x.r1[0], ya); yb = __builtin_fmaf(S[6], x.r1[2], yb); ya = __builtin_fmaf(S[5], x.r1[1], ya); yb = __builtin_fmaf(S[7], x.r1[3], yb);
    return dpp_sum8(ya + yb);
}
__device__ __forceinline__ void rwkv_scan_unit(const Params& p, const Ctx& c, int s, int h, int hf) {
    const bool prompt = s < NB; const int row_base = prompt ? s * LP + PADR : MP + (s - NB) * SS; const int T = prompt ? TP : SS;
    const int nch = (T + SC_CH - 1) / SC_CH;
    LAS float* buf0 = (LAS float*)c.lds; LAS float* buf1 = (LAS float*)(c.lds + SC_BUF);
    const bool comp = c.wave < 4; const int lane = c.lane, ks = lane & 7, vrow = 32 * hf + 8 * (c.wave & 3) + (lane >> 3);
    float S[8];
#pragma unroll
    for (int j = 0; j < 8; ++j) S[j] = 0.f;
    if (comp && !prompt) { const float* st = PIN(I_SWKV) + (((size_t)(s - NB) * RWH + h) * 64 + vrow) * 64 + ks * 8;
        const f32x4 a = *(const f32x4*)st, b = *(const f32x4*)(st + 4); S[0] = a[0]; S[1] = a[1]; S[2] = a[2]; S[3] = a[3]; S[4] = b[0]; S[5] = b[1]; S[6] = b[2]; S[7] = b[3]; }
    __syncthreads();
    scan_stage(p, c, buf0, row_base, h, T < SC_CH ? T : SC_CH, c.tid & 255);
    __syncthreads();
    float* yout = p.out;
    for (int cix = 0; cix < nch; ++cix) {
        LAS float* cur = (cix & 1) ? buf1 : buf0; LAS float* nxt = (cix & 1) ? buf0 : buf1;
        const int t0 = cix * SC_CH; const int steps = (T - t0) < SC_CH ? (T - t0) : SC_CH;
        if (!comp) { if (cix + 1 < nch) { const int t1 = t0 + SC_CH; scan_stage(p, c, nxt, row_base + t1, h, (T - t1) < SC_CH ? (T - t1) : SC_CH, c.tid - 256); } }
        else {
            const LAS float* bR = cur + ks * 8; const LAS float* bV = cur + 5 * SC_CH * 64 + vrow;
            ScanIn A, B; A.load(bR, bV, 0);
            for (int i = 0; i < steps; i += 2) {
                B.load(bR, bV, i + 1);
                const float y0 = scan_step(S, A);
                if (ks == 0) yout[(size_t)(row_base + t0 + i) * RWD + h * 64 + vrow] = y0;
                A.load(bR, bV, (i + 2 < steps) ? i + 2 : i);
                const float y1 = scan_step(S, B);
                if (ks == 0) yout[(size_t)(row_base + t0 + i + 1) * RWD + h * 64 + vrow] = y1;
            }
        }
        __syncthreads();
    }
    if (comp) { float* so = p.out + (prompt ? O_PWKV + (((size_t)s * RWH + h) * 64 + vrow) * 64 : O_SWKV + (((size_t)(s - NB) * RWH + h) * 64 + vrow) * 64) + ks * 8;
        *(f32x4*)so = (f32x4){S[0], S[1], S[2], S[3]}; *(f32x4*)(so + 4) = (f32x4){S[4], S[5], S[6], S[7]}; }
}

__device__ __forceinline__ void phase_bcconv(const Params& p, const Ctx& c) {
    const bf16* XBC = (const bf16*)(p.ws + WS_XBC); bf16* BCC = (bf16*)(p.ws + WS_YRW);
    const int c8 = (c.tid & 127) * 8, ch = 2048 + c8; const float* convw = PIN(I_CONVW); const float* convb = PIN(I_CONVB);
    f32x4 wa[4], wb[4];
#pragma unroll
    for (int k = 0; k < 4; ++k) { wa[k] = *(const f32x4*)(convw + k * CONVD + ch); wb[k] = *(const f32x4*)(convw + k * CONVD + ch + 4); }
    const f32x4 ba = *(const f32x4*)(convb + ch), bb = *(const f32x4*)(convb + ch + 4);
    for (int row = blockIdx.x * 4 + (c.tid >> 7); row < MROWS; row += gridDim.x * 4) {
        u32x4 o = (u32x4){0u, 0u, 0u, 0u};
        if (!row_is_pad(row)) {
            const bool prompt = row < MP; const int q = prompt ? (row % LP) - PADR : (row - MP) & 15;
            f32x4 a0 = ba, a1 = bb;
#pragma unroll
            for (int k = 0; k < 4; ++k) { const int qq = q - 3 + k; f32x4 v0 = (f32x4){0.f, 0.f, 0.f, 0.f}, v1 = v0;
                if (qq >= 0) { const u32x4 w = *(const u32x4*)(XBC + (size_t)(row - 3 + k) * XBC_LD + ch); v0 = (f32x4){bflo(w.x), bfhi(w.x), bflo(w.y), bfhi(w.y)}; v1 = (f32x4){bflo(w.z), bfhi(w.z), bflo(w[3]), bfhi(w[3])}; }
                else if (!prompt) { const float* hs = PIN(I_SCONV) + ((size_t)((row - MP) >> 4) * 3 + (3 + qq)) * CONVD + ch; v0 = *(const f32x4*)hs; v1 = *(const f32x4*)(hs + 4);
                    v0 = (f32x4){bf2f((bf16)(pk2(v0[0], 0.f) & 0xffffu)), bf2f((bf16)(pk2(v0[1], 0.f) & 0xffffu)), bf2f((bf16)(pk2(v0[2], 0.f) & 0xffffu)), bf2f((bf16)(pk2(v0[3], 0.f) & 0xffffu))};
                    v1 = (f32x4){bf2f((bf16)(pk2(v1[0], 0.f) & 0xffffu)), bf2f((bf16)(pk2(v1[1], 0.f) & 0xffffu)), bf2f((bf16)(pk2(v1[2], 0.f) & 0xffffu)), bf2f((bf16)(pk2(v1[3], 0.f) & 0xffffu))}; }
                a0 += v0 * wa[k]; a1 += v1 * wb[k]; }
            o.x = pk2(silu_(a0[0]), silu_(a0[1])); o.y = pk2(silu_(a0[2]), silu_(a0[3])); o.z = pk2(silu_(a1[0]), silu_(a1[1])); o[3] = pk2(silu_(a1[2]), silu_(a1[3]));
        }
        *(u32x4*)(BCC + (size_t)row * 1024 + c8) = o;
    }
}
constexpr int SD_RAW = 0, SD_HB = 44032, SD_BT = 61440, SD_XT = 79872, SD_XD = 89088, SD_XC = 98304, SD_YT = 107520, SD_G = 124928, SD_DT = 134144, SD_ACS = 134400, SD_WT = 134656;
constexpr int RAW_LD = 328, CM_LD = 136, BT_LD = 72, XT_LD = 72, YT_LD = 68;
__device__ __forceinline__ f32x4 mfma16(bf16x8 a, bf16x8 b, f32x4 c) { return __builtin_amdgcn_mfma_f32_16x16x32_bf16(a, b, c, 0, 0, 0); }
__device__ __forceinline__ void ssd_fetch(const Params& p, bool prompt, int s, int row_base, int cix, int hd, int g, int tid, u32x4 (&pre)[6], u32x4& zpre, float& dtraw) {
    const bf16* XBC = (const bf16*)(p.ws + WS_XBC); const bf16* BCC = (const bf16*)(p.ws + WS_YRW);
    asm volatile("" : "+v"(tid));
#pragma unroll
    for (int i = 0; i < 6; ++i) { const int idx = tid + 512 * i; u32x4 v = (u32x4){0u, 0u, 0u, 0u};
        if (idx < 67 * 40) { const int rr = idx / 40, cc = idx - rr * 40; const int q = cix * 64 + rr - 3;
            if (cc < 8) { const int col = hd * 64 + cc * 8;
                if (prompt) { if (q >= PADR) v = *(const u32x4*)(XBC + (size_t)(row_base + q) * XBC_LD + col); }
                else { if (q >= 0 && q < SS) v = *(const u32x4*)(XBC + (size_t)(row_base + q) * XBC_LD + col);
                       else if (q < 0) { const float* hs = PIN(I_SCONV) + ((size_t)(s - NB) * 3 + (3 + q)) * CONVD + col; const f32x4 a = *(const f32x4*)hs, b = *(const f32x4*)(hs + 4);
                           v.x = pk2(a[0], a[1]); v.y = pk2(a[2], a[3]); v.z = pk2(b[0], b[1]); v[3] = pk2(b[2], b[3]); } } }
            else { const int col = cc < 24 ? g * 128 + (cc - 8) * 8 : 512 + g * 128 + (cc - 24) * 8;
                if (prompt ? (q >= PADR) : (q >= 0 && q < SS)) v = *(const u32x4*)(BCC + (size_t)(row_base + q) * 1024 + col); } }
        pre[i] = v; }
    { const int t = tid >> 3, c8 = (tid & 7) * 8, q = cix * 64 + t; zpre = (u32x4){0u, 0u, 0u, 0u};
      if (prompt || q < SS) zpre = *(const u32x4*)((const bf16*)(p.ws + WS_Z) + (size_t)(row_base + q) * Z_LD + hd * 64 + c8); }
    { const int q = cix * 64 + (tid & 63); const bool valid = prompt ? (q >= PADR) : (q < SS); dtraw = 0.f;
      if (tid < 64 && valid) dtraw = bf2f(((const bf16*)(p.ws + WS_PRW))[(size_t)(row_base + q) * PRW_LD + SHC + hd]); }
}
__device__ __forceinline__ void ssd_unit(const Params& p, const Ctx& c, int s, int hd, bool dry = false) {
    const bool prompt = s < NB; const int row_base = prompt ? s * LP : MP + (s - NB) * SS; const int nchunks = prompt ? LP / 64 : 1; const int g = hd >> 3;
    const int tid = c.tid, lane = c.lane, w = c.wave, fr = lane & 15, fq = lane >> 4;
    LAS bf16* RAW = (LAS bf16*)(c.lds + SD_RAW); LAS bf16* Gm = (LAS bf16*)(c.lds + SD_G); LAS bf16* HB = (LAS bf16*)(c.lds + SD_HB);
    LAS bf16* BT = (LAS bf16*)(c.lds + SD_BT); LAS bf16* XT = (LAS bf16*)(c.lds + SD_XT); LAS bf16* XD = (LAS bf16*)(c.lds + SD_XD); LAS bf16* XC = (LAS bf16*)(c.lds + SD_XC);
    LAS float* YT = (LAS float*)(c.lds + SD_YT); LAS float* DT = (LAS float*)(c.lds + SD_DT); LAS float* ACS = (LAS float*)(c.lds + SD_ACS); LAS float* WT = (LAS float*)(c.lds + SD_WT);
    const int bpair = tid & 63, xpair = tid & 31;
    __syncthreads();
    if (tid < 64) { const float* convw = PIN(I_CONVW); const float* convb = PIN(I_CONVB); const int ch = hd * 64 + tid;
        *(LAS f32x4*)(WT + tid * 8) = (f32x4){convw[ch], convw[CONVD + ch], convw[2 * CONVD + ch], convw[3 * CONVD + ch]}; WT[tid * 8 + 4] = convb[ch]; }
    const float dtb = PIN(I_DTB)[hd], aneg = -__expf(PIN(I_ALOG)[hd]), dsk = PIN(I_DSKIP)[hd];
    const int hpt = w & 3, hnt0 = (w >> 2) * 4;
    f32x4 hacc[4];
#pragma unroll
    for (int j = 0; j < 4; ++j) hacc[j] = (f32x4){0.f, 0.f, 0.f, 0.f};
    if (!prompt) { const float* st = PIN(I_SSSM) + ((size_t)(s - NB) * SSMH + hd) * 64 * 128;
#pragma unroll
        for (int j = 0; j < 4; ++j)
#pragma unroll
            for (int r = 0; r < 4; ++r) hacc[j][r] = st[(size_t)(hpt * 16 + fq * 4 + r) * 128 + (hnt0 + j) * 16 + fr]; }
    const int yit = w >> 1, ypt0 = (w & 1) * 2;
    u32x4 pre[6], zpre, zcur = (u32x4){0u, 0u, 0u, 0u}; float dtraw;
    ssd_fetch(p, prompt, s, row_base, 0, hd, g, tid, pre, zpre, dtraw);
    for (int cix = 0; cix <= nchunks; ++cix) {
        if (cix < nchunks) {
            { int tl = tid; asm volatile("" : "+v"(tl));
#pragma unroll
              for (int i = 0; i < 6; ++i) { const int idx = tl + 512 * i; if (idx < 67 * 40) { const int rr = idx / 40, cc = idx - rr * 40; *(LAS u32x4*)(RAW + rr * RAW_LD + cc * 8) = pre[i]; } } }
            if (w == 0) { const int q = cix * 64 + lane; const bool valid = prompt ? (q >= PADR) : (q < SS);
                const float dtv = valid ? softplus_(dtraw + dtb) : 0.f; float a = dtv * aneg;
#pragma unroll
                for (int o = 1; o < 64; o <<= 1) { const float t = __shfl_up(a, o); if (lane >= o) a += t; }
                DT[lane] = dtv; ACS[lane] = a; }
#pragma unroll
            for (int j = 0; j < 4; ++j)
#pragma unroll
                for (int r = 0; r < 4; ++r) HB[(hpt * 16 + fq * 4 + r) * CM_LD + (hnt0 + j) * 16 + fr] = (bf16)(pk2(hacc[j][r], 0.f) & 0xffffu);
        }
        if (cix > 0) { const int t = tid >> 3, c8 = (tid & 7) * 8, q = (cix - 1) * 64 + t;
          if ((prompt || q < SS) && !dry) { const f32x4 y0 = *(const LAS f32x4*)(YT + t * YT_LD + c8), y1 = *(const LAS f32x4*)(YT + t * YT_LD + c8 + 4); const u32x4 xc = *(const LAS u32x4*)(XC + t * XT_LD + c8);
              u32x4 o; o.x = pk2((y0[0] + bflo(xc.x) * dsk) * bflo(zcur.x), (y0[1] + bfhi(xc.x) * dsk) * bfhi(zcur.x)); o.y = pk2((y0[2] + bflo(xc.y) * dsk) * bflo(zcur.y), (y0[3] + bfhi(xc.y) * dsk) * bfhi(zcur.y));
              o.z = pk2((y1[0] + bflo(xc.z) * dsk) * bflo(zcur.z), (y1[1] + bfhi(xc.z) * dsk) * bfhi(zcur.z)); o[3] = pk2((y1[2] + bflo(xc[3]) * dsk) * bflo(zcur[3]), (y1[3] + bfhi(xc[3]) * dsk) * bfhi(zcur[3]));
              *(u32x4*)((bf16*)(p.ws + WS_Z) + (size_t)(row_base + q) * Z_LD + hd * 64 + c8) = o; } }
        if (cix == nchunks) break;
        zcur = zpre;
        if (cix + 1 < nchunks) ssd_fetch(p, prompt, s, row_base, cix + 1, hd, g, tid, pre, zpre, dtraw);
        __syncthreads();
        const float acs_end = ACS[63];
        { const int t0 = 8 * w;
          unsigned t0w[4], t1w[4];
#pragma unroll
          for (int tt = 0; tt < 8; ++tt) { const unsigned bp = *(const LAS unsigned*)(RAW + (t0 + tt + 3) * RAW_LD + 64 + 2 * bpair);
              if (tt & 1) { t0w[tt >> 1] |= bp << 16; t1w[tt >> 1] |= bp & 0xffff0000u; } else { t0w[tt >> 1] = bp & 0xffffu; t1w[tt >> 1] = bp >> 16; } }
          *(LAS u32x4*)(BT + (2 * bpair) * BT_LD + t0) = (u32x4){t0w[0], t0w[1], t0w[2], t0w[3]}; *(LAS u32x4*)(BT + (2 * bpair + 1) * BT_LD + t0) = (u32x4){t1w[0], t1w[1], t1w[2], t1w[3]}; }
        { const int t0 = 4 * (tid >> 5);
          unsigned rx[7];
#pragma unroll
          for (int j = 0; j < 7; ++j) rx[j] = *(const LAS unsigned*)(RAW + (t0 + j) * RAW_LD + 2 * xpair);
          const f32x4 w0 = *(const LAS f32x4*)(WT + (2 * xpair) * 8), w1 = *(const LAS f32x4*)(WT + (2 * xpair + 1) * 8); const float bi0 = WT[(2 * xpair) * 8 + 4], bi1 = WT[(2 * xpair + 1) * 8 + 4];
          const f32x4 dta = *(const LAS f32x4*)(DT + t0), aca = *(const LAS f32x4*)(ACS + t0);
          unsigned xt0[2], xt1[2], xd0[2], xd1[2];
#pragma unroll
          for (int tt = 0; tt < 4; ++tt) { const int q = cix * 64 + t0 + tt; const bool valid = prompt ? (q >= PADR) : (q < SS);
              float x0 = bi0, x1 = bi1;
#pragma unroll
              for (int k = 0; k < 4; ++k) { x0 += bflo(rx[tt + k]) * w0[k]; x1 += bfhi(rx[tt + k]) * w1[k]; }
              x0 = valid ? silu_(x0) : 0.f; x1 = valid ? silu_(x1) : 0.f;
              *(LAS unsigned*)(XC + (t0 + tt) * XT_LD + 2 * xpair) = pk2(x0, x1);
              const float dtt = dta[tt], dec = __expf(acs_end - aca[tt]);
              const unsigned xp = pk2(x0 * dtt, x1 * dtt), xq = pk2(x0 * dtt * dec, x1 * dtt * dec);
              if (tt & 1) { xt0[tt >> 1] |= xp << 16; xt1[tt >> 1] |= xp & 0xffff0000u; xd0[tt >> 1] |= xq << 16; xd1[tt >> 1] |= xq & 0xffff0000u; }
              else { xt0[tt >> 1] = xp & 0xffffu; xt1[tt >> 1] = xp >> 16; xd0[tt >> 1] = xq & 0xffffu; xd1[tt >> 1] = xq >> 16; } }
          *(LAS u32x2*)(XT + (2 * xpair) * XT_LD + t0) = (u32x2){xt0[0], xt0[1]}; *(LAS u32x2*)(XT + (2 * xpair + 1) * XT_LD + t0) = (u32x2){xt1[0], xt1[1]};
          *(LAS u32x2*)(XD + (2 * xpair) * XT_LD + t0) = (u32x2){xd0[0], xd0[1]}; *(LAS u32x2*)(XD + (2 * xpair + 1) * XT_LD + t0) = (u32x2){xd1[0], xd1[1]}; }
        __syncthreads();
        f32x4 yacc[2];
        { f32x4 cbacc[2] = {(f32x4){0.f, 0.f, 0.f, 0.f}, (f32x4){0.f, 0.f, 0.f, 0.f}}; yacc[0] = cbacc[0]; yacc[1] = cbacc[0];
#pragma unroll
          for (int kk = 0; kk < 4; ++kk) { const bf16x8 af = *(const LAS bf16x8*)(RAW + (yit * 16 + fr + 3) * RAW_LD + 192 + kk * 32 + fq * 8);
#pragma unroll
              for (int j = 0; j < 2; ++j) { const bf16x8 bfm = *(const LAS bf16x8*)(RAW + ((ypt0 + j) * 16 + fr + 3) * RAW_LD + 64 + kk * 32 + fq * 8); cbacc[j] = mfma16(af, bfm, cbacc[j]);
                  const bf16x8 hf = *(const LAS bf16x8*)(HB + ((ypt0 + j) * 16 + fr) * CM_LD + kk * 32 + fq * 8); yacc[j] = mfma16(af, hf, yacc[j]); } }
#pragma unroll
          for (int j = 0; j < 2; ++j)
#pragma unroll
              for (int r = 0; r < 4; ++r) { const int i = yit * 16 + fq * 4 + r, jj = (ypt0 + j) * 16 + fr; const float ai = ACS[i];
                  const float gv = (jj <= i) ? cbacc[j][r] * __expf(ai - ACS[jj]) : 0.f; Gm[i * XT_LD + jj] = (bf16)(pk2(gv, 0.f) & 0xffffu);
                  yacc[j][r] *= __expf(ai); } }
        { const float cd = __expf(acs_end);
#pragma unroll
          for (int j = 0; j < 4; ++j) hacc[j] = hacc[j] * cd;
#pragma unroll
          for (int kk = 0; kk < 2; ++kk) { const bf16x8 af = *(const LAS bf16x8*)(XD + (hpt * 16 + fr) * XT_LD + kk * 32 + fq * 8);
#pragma unroll
              for (int j = 0; j < 4; ++j) { const bf16x8 bfm = *(const LAS bf16x8*)(BT + ((hnt0 + j) * 16 + fr) * BT_LD + kk * 32 + fq * 8); hacc[j] = mfma16(af, bfm, hacc[j]); } } }
        __syncthreads();
#pragma unroll
        for (int kk = 0; kk < 2; ++kk) { const bf16x8 af = *(const LAS bf16x8*)(Gm + (yit * 16 + fr) * XT_LD + kk * 32 + fq * 8);
#pragma unroll
            for (int j = 0; j < 2; ++j) { const bf16x8 bfm = *(const LAS bf16x8*)(XT + ((ypt0 + j) * 16 + fr) * XT_LD + kk * 32 + fq * 8); yacc[j] = mfma16(af, bfm, yacc[j]); } }
#pragma unroll
        for (int j = 0; j < 2; ++j)
#pragma unroll
            for (int r = 0; r < 4; ++r) YT[(yit * 16 + fq * 4 + r) * YT_LD + (ypt0 + j) * 16 + fr] = yacc[j][r];
        __syncthreads();
    }
    if (!dry) { float* so = p.out + (prompt ? O_PSSM + ((size_t)s * SSMH + hd) * 64 * 128 : O_SSSM + ((size_t)(s - NB) * SSMH + hd) * 64 * 128);
#pragma unroll
      for (int j = 0; j < 4; ++j)
#pragma unroll
          for (int r = 0; r < 4; ++r) so[(size_t)(hpt * 16 + fq * 4 + r) * 128 + (hnt0 + j) * 16 + fr] = hacc[j][r]; }
}
__device__ __forceinline__ void phase_mixers(const Params& p, const Ctx& c) {
#if defined(PROBE_SCAN2)
    constexpr int NUNITS = 1408;
#elif defined(PROBE_SSD2)
    constexpr int NUNITS = 1536;
#else
    constexpr int NUNITS = 1280;
#endif
    for (int u0 = blockIdx.x; u0 < NUNITS; u0 += gridDim.x) {
        int u = u0; bool dry = false; if (u >= 1280) { u -= 1280; dry = true; }
#if defined(PROBE_SSD2)
        if (dry && u < 128) continue;
#endif
        int kind, s, h, hf = 0;
        if (u < 128) { kind = 0; s = (u >> 1) / RWH; h = (u >> 1) % RWH; hf = u & 1; }
        else if (u < 256) { kind = 1; s = (u - 128) / SSMH; h = (u - 128) % SSMH; }
        else if (u < 768) { const int v = u - 256; kind = 0; s = NB + (v >> 1) / RWH; h = (v >> 1) % RWH; hf = v & 1; }
        else { const int v = u - 768; kind = 1; s = NB + v / SSMH; h = v % SSMH; }
#if defined(PROBE_NOSSD)
        if (kind == 0)
#endif
        { if (kind == 0) rwkv_scan_unit(p, c, s, h, hf); else ssd_unit(p, c, s, h, dry); }
    }
}

__device__ __forceinline__ bool setup_gemm(const Params& p, int ph, pg8::Gemm& g, pg8::EpiGen& E) {
    unsigned char* ws = p.ws;
    E.o0 = nullptr; E.o1 = nullptr; E.o2 = nullptr; E.i0 = nullptr; E.i1 = nullptr; E.f0 = nullptr; E.f1 = nullptr; E.alpha = 0.f; E.scale = 0.f; E.mode = 0; E.PERM = false;
    switch (ph) {
    case 1: case 14: g.A = (const bf16*)(ws + WS_XB); g.Bt = (const bf16*)(ws + WS_GUT); g.M = MROWS; g.N = 2 * FF; g.K = D; E.mode = pg8::EM_SWIGLU; E.PERM = true; E.o0 = ws + WS_ACT; return true;
    case 2: case 15: g.A = (const bf16*)(ws + WS_ACT); g.Bt = (const bf16*)(ws + WS_DNT); g.M = MROWS; g.N = D; g.K = FF; E.mode = pg8::EM_RESID; E.o0 = ws + WS_PRE; E.i0 = ws + WS_XB; E.alpha = ALPHA; E.scale = 0.5f; return true;
    case 4: g.A = (const bf16*)(ws + WS_XB); g.Bt = (const bf16*)(ws + WS_WINT); g.M = MROWS; g.N = NINP; g.K = D; E.mode = pg8::EM_WIN; E.PERM = true; E.o0 = ws + WS_PRW; E.f0 = PIN(I_BGATE); return true;
    case 6: g.A = (const bf16*)(ws + WS_ALORA); g.Bt = (const bf16*)(ws + WS_LORAT); g.M = MROWS; g.N = 3072; g.K = 512; E.mode = pg8::EM_LORA; E.o0 = ws + WS_WDEC; E.o1 = ws + WS_BB; E.o2 = ws + WS_GBUF; E.f0 = PIN(I_W0); E.f1 = PIN(I_A0); return true;
    case 10: g.A = (const bf16*)(ws + WS_YRW); g.Bt = (const bf16*)(ws + WS_RWOT); g.M = MROWS; g.N = D; g.K = RWD; E.mode = pg8::EM_M1; E.o0 = ws + WS_T1; E.i0 = ws + WS_GATE; return true;
    case 11: g.A = (const bf16*)(ws + WS_Z); g.Bt = (const bf16*)(ws + WS_SSMOT); g.M = MROWS; g.N = D; g.K = D; E.mode = pg8::EM_M2; E.PERM = true; E.o0 = ws + WS_MERGED; E.i0 = ws + WS_GATE; E.i1 = ws + WS_T1; return true;
    case 12: g.A = (const bf16*)(ws + WS_MERGED); g.Bt = (const bf16*)(ws + WS_WOT); g.M = MROWS; g.N = D; g.K = D; E.mode = pg8::EM_RESID; E.o0 = ws + WS_PRE; E.i0 = ws + WS_XB; E.alpha = ALPHA; E.scale = 1.0f; return true;
    default: return false;
    }
}

#ifndef MK_XCD_BARRIER
#define MK_XCD_BARRIER 1
#endif
#define XB_TMO      128
#define XB_XCNT(j)  (256  + 64 * (j))
#define XB_XSUB(j)  (1280 + 64 * (j))
#define XB_XGEN(j)  (2304 + 64 * (j))
#define XB_TOP      3328
#define XB_TOPGEN   3392
#define XCD_BAR_WORDS 3456
#define XB_SPIN_CAP (1u << 18)

__device__ __forceinline__ unsigned xb_ld(unsigned* p)              { return __hip_atomic_load(p, __ATOMIC_RELAXED, __HIP_MEMORY_SCOPE_AGENT); }
__device__ __forceinline__ unsigned xb_add(unsigned* p, unsigned v) { return __hip_atomic_fetch_add(p, v, __ATOMIC_RELAXED, __HIP_MEMORY_SCOPE_AGENT); }
__device__ __forceinline__ unsigned xb_xcc_id() { return (unsigned)__builtin_amdgcn_s_getreg((3 << 11) | 20) & 0xFu; }
#define XB_SPIN(cond, bar) do { unsigned _sp = 0; while (cond) { __builtin_amdgcn_s_sleep(1); \
    if ((++_sp & 255u) == 0u) { if (xb_ld(&(bar)[XB_TMO])) break; if (_sp > XB_SPIN_CAP) { atomicAdd(&(bar)[XB_TMO], 1u); break; } } } } while (0)

struct XcdBarrier {
    unsigned* bar; unsigned x;
    volatile LAS unsigned* st;
};

__device__ __forceinline__ XcdBarrier xcd_barrier_post(unsigned* bar, volatile LAS unsigned* st) {
    XcdBarrier b; b.bar = bar; b.x = xb_xcc_id(); b.st = st;
    if (threadIdx.x == 0) (void)xb_add(&bar[XB_XCNT(b.x)], 1u);
    return b;
}
__device__ __forceinline__ void xcd_barrier_complete(unsigned* bar, unsigned x, unsigned& nloc, unsigned& nx) {
    const unsigned G = gridDim.x * gridDim.y * gridDim.z;
    unsigned sum, cnt, mine, sp = 0u;
    for (;;) {
        sum = 0u; cnt = 0u; mine = 0u;
#pragma unroll
        for (unsigned j = 0; j < 16; ++j) { const unsigned c = xb_ld(&bar[XB_XCNT(j)]); sum += c; cnt += (c > 0u) ? 1u : 0u; mine = (j == x) ? c : mine; }
        if (sum == G) break;
        __builtin_amdgcn_s_sleep(1);
        if ((++sp & 255u) == 0u) { if (xb_ld(&bar[XB_TMO])) break; if (sp > XB_SPIN_CAP) { atomicAdd(&bar[XB_TMO], 1u); break; } }
    }
    nloc = mine > 0u ? mine : 1u; nx = cnt > 0u ? cnt : 1u;
}

__device__ __forceinline__ void xcd_barrier(const XcdBarrier& b) {
    asm volatile("s_waitcnt vmcnt(0)" ::: "memory");
    __syncthreads();
    if (threadIdx.x == 0) {
        unsigned* bar = b.bar;
        __builtin_amdgcn_s_waitcnt(0);
        unsigned nloc = b.st[0], nx = b.st[1];
        if (nloc == 0u) { xcd_barrier_complete(bar, b.x, nloc, nx); b.st[0] = nloc; b.st[1] = nx; }
        const unsigned old = xb_add(&bar[XB_XSUB(b.x)], 1u);
        const unsigned gen = old / nloc;
        if (old + 1u == (gen + 1u) * nloc) {
            __builtin_amdgcn_fence(__ATOMIC_RELEASE, "agent");
            asm volatile("s_waitcnt vmcnt(0)" ::: "memory");
            const unsigned og = xb_add(&bar[XB_TOP], 1u);
            const unsigned tg = og / nx;
            if (og + 1u == (tg + 1u) * nx) xb_add(&bar[XB_TOPGEN], 1u);
            else XB_SPIN(xb_ld(&bar[XB_TOPGEN]) == tg, bar);
            __builtin_amdgcn_fence(__ATOMIC_ACQUIRE, "agent");
            xb_add(&bar[XB_XGEN(b.x)], 1u);
            asm volatile("s_waitcnt vmcnt(0)" ::: "memory");
        } else {
            XB_SPIN(xb_ld(&bar[XB_XGEN(b.x)]) == gen, bar);
            __builtin_amdgcn_fence(__ATOMIC_ACQUIRE, "agent");
            asm volatile("s_waitcnt vmcnt(0)" ::: "memory");
        }
    }
    __syncthreads();
}

template <int PH> __device__ __forceinline__ void run_gemm(const Params& p, const Ctx& c) {
    pg8::Gemm g; pg8::EpiGen E; setup_gemm(p, PH, g, E);
    pg8::StaticOrder S; S.init(g.M, g.N, (int)gridDim.x, (int)blockIdx.x);
    pg8::gemm_phase<pg8::EpiGen, pg8::StaticOrder, true, true>(c.lds, g, S, E);
}
__global__ void __launch_bounds__(512, 2) __attribute__((target("no-packed-fp32-ops"))) mega_fwd(Params p) {
    extern __shared__ __attribute__((aligned(16))) unsigned char lds_raw[];
    const int lo = p.ph_lo, hi = p.ph_hi;
#define MKCTX Ctx c; { int t_ = threadIdx.x; asm volatile("" : "+v"(t_)); c.tid = t_; c.lane = t_ & 63; c.wave = __builtin_amdgcn_readfirstlane(t_ >> 6); c.gw = blockIdx.x * 8 + c.wave; c.ngw = gridDim.x * 8; c.lds = (LAS unsigned char*)lds_raw; }
#define IN(k) (lo <= (k) && (k) < hi)
#if MK_XCD_BARRIER
    { volatile LAS unsigned* st = (volatile LAS unsigned*)((LAS unsigned char*)lds_raw + LDS_BYTES - 64); if (threadIdx.x < 2) st[threadIdx.x] = 0u; __syncthreads(); }
    const XcdBarrier xbar = xcd_barrier_post((unsigned*)p.ws, (volatile LAS unsigned*)((LAS unsigned char*)lds_raw + LDS_BYTES - 64));
#define SEAM(k) do { if (lo <= (k) && (k) + 1 < hi) { if ((k) == 0) cg::this_grid().sync(); else xcd_barrier(xbar); } } while (0)
#else
#define SEAM(k) do { if (lo <= (k) && (k) + 1 < hi) cg::this_grid().sync(); } while (0)
#endif
#ifndef PROBE_DOUBLE
#define PROBE_DOUBLE 0
#endif
#define PH(k, ...) do { if (IN(k)) { { MKCTX __VA_ARGS__ } if (((PROBE_DOUBLE >> (k)) & 1) != 0) { cg::this_grid().sync(); { MKCTX __VA_ARGS__ } } } SEAM(k); } while (0)
    PH(0, phase_convert_x(p, c);
        transpose_w(PIN(I_GU1), D, 2 * FF, (bf16*)(p.ws + WS_GUT), 2 * FF, MAP_GU, c);
        transpose_w(PIN(I_DN1), FF, D, (bf16*)(p.ws + WS_DNT), D, MAP_ID, c);
        transpose_w(PIN(I_RWO), RWD, D, (bf16*)(p.ws + WS_RWOT), D, MAP_ID, c);
        transpose_w(PIN(I_SSMO), D, D, (bf16*)(p.ws + WS_SSMOT), D, MAP_ID, c);
        transpose_w(PIN(I_WO), D, D, (bf16*)(p.ws + WS_WOT), D, MAP_ID, c);
        build_lorat(p, c););
    PH(1, run_gemm<1>(p, c););
    PH(2, run_gemm<2>(p, c););
    PH(3, phase_ln<false>(p, c, PIN(I_LN1G), PIN(I_LN1B)); transpose_w(PIN(I_WIN), D, 12768, (bf16*)(p.ws + WS_WINT), NINP, MAP_WIN, c););
    PH(4, run_gemm<4>(p, c););
    PH(5, phase_prep1(p, c););
    PH(6, run_gemm<6>(p, c););
    PH(7, phase_prep2(p, c); phase_bcconv(p, c););
    PH(8, phase_mixers(p, c););
    PH(9, phase_post(p, c););
    PH(10, run_gemm<10>(p, c););
    PH(11, run_gemm<11>(p, c););
    PH(12, run_gemm<12>(p, c););
    PH(13, phase_ln<false>(p, c, PIN(I_LN2G), PIN(I_LN2B)); transpose_w(PIN(I_GU2), D, 2 * FF, (bf16*)(p.ws + WS_GUT), 2 * FF, MAP_GU, c); transpose_w(PIN(I_DN2), FF, D, (bf16*)(p.ws + WS_DNT), D, MAP_ID, c););
    PH(14, run_gemm<14>(p, c););
    PH(15, run_gemm<15>(p, c););
    PH(16, phase_ln<true>(p, c, PIN(I_LN3G), PIN(I_LN3B)););
#undef PH
#undef IN
#undef MKCTX
#undef SEAM
}

extern "C" void kernel_launch(void* const* d_in, const int* in_sizes, int n_in, void* d_out, int out_size, void* d_ws, size_t ws_size, hipStream_t stream) {
    static int grid = 0;
    if (!grid) {
        if (n_in != N_IN || (size_t)out_size != O_END || ws_size < WS_END) { fprintf(stderr, "kernel_launch: unexpected shapes (n_in %d, out %d, ws %zu)\n", n_in, out_size, ws_size); grid = -1; return; }
        int dev = 0, cus = 0, per_cu = 0;
        hipGetDevice(&dev); hipDeviceGetAttribute(&cus, hipDeviceAttributeMultiprocessorCount, dev);
        hipFuncSetAttribute((const void*)mega_fwd, hipFuncAttributeMaxDynamicSharedMemorySize, LDS_BYTES);
        hipOccupancyMaxActiveBlocksPerMultiprocessor(&per_cu, (const void*)mega_fwd, 512, LDS_BYTES);
        if (per_cu < 1) { fprintf(stderr, "kernel_launch: occupancy query says %d blocks per CU\n", per_cu); per_cu = 1; }
        grid = cus;
    }
    if (grid < 0) return;
    if (hipMemsetAsync(d_ws, 0, 16384, stream) != hipSuccess) fprintf(stderr, "kernel_launch: memset failed\n");
    Params p{};
    for (int i = 0; i < N_IN; ++i) p.in[i] = (const float*)d_in[i];
    p.out = (float*)d_out; p.ws = (unsigned char*)d_ws;
#if MK_SINGLE_LAUNCH
    p.ph_lo = 0; p.ph_hi = NPHASE;
    void* args[] = {&p};
    hipError_t e = hipLaunchCooperativeKernel((const void*)mega_fwd, dim3(grid), dim3(512), args, LDS_BYTES, stream);
    if (e != hipSuccess) fprintf(stderr, "cooperative launch failed: %s (grid %d)\n", hipGetErrorString(e), grid);
#else
    for (int ph = 0; ph < NPHASE; ++ph) { p.ph_lo = ph; p.ph_hi = ph + 1; hipLaunchKernelGGL(mega_fwd, dim3(grid), dim3(512), LDS_BYTES, stream, p); }
#endif
}
```

```cpp
#include <hip/hip_runtime.h>
#include <hip/hip_cooperative_groups.h>
#include <cstdio>
#include <cstdint>
namespace cg = cooperative_groups;

#ifndef MK_SINGLE_LAUNCH
#define MK_SINGLE_LAUNCH 1
#endif

namespace pg8 {
#define PG8_LAS __attribute__((address_space(3)))
typedef unsigned short bf16_t;
typedef short bf16x8 __attribute__((ext_vector_type(8)));
typedef float f32x4 __attribute__((ext_vector_type(4)));
typedef unsigned u32x4 __attribute__((ext_vector_type(4)));
constexpr int BM = 256, BK = 64, HALF = 128, HTB = HALF * BK * 2  , STAGE_BYTES = 8 * HTB, NXCD = 8, WGM = 8;

__host__ __device__ __forceinline__ int lds_byte(int r, int c) { const int st = (r >> 4) * 2 + (c >> 5), rr = r & 15, cc = c & 31, ob = rr * 64 + cc * 2; return st * 1024 + (ob ^ (((ob >> 9) & 1) << 5)); }
__host__ __device__ __forceinline__ void stage_rc(int b, int& R, int& C) { const int st = b / 1024, sb = b % 1024, swz = sb ^ (((sb >> 9) & 1) << 5); R = (st >> 1) * 16 + swz / 64; C = (st & 1) * 32 + (swz % 64) / 2; }
__host__ __device__ __forceinline__ int perm32(int rho) { const int n = rho >> 4, i = rho & 15; return 8 * (i >> 2) + 4 * n + (i & 3); }

struct Unit { int pm, pn, k0, nt, part, tl, half, rowoff, bq, coloff; };
struct Gemm { const bf16_t* A; const bf16_t* Bt; int M, N, K; };

struct StaticOrder {
    int nM, nN, nwg, G, c, ntK;
    int ext_n = 0, ext_pm0 = 0, ext_pn0 = 0, ext_w = 1;
    int split2 = 0;
    int qtail = 0;
    int htail = 0;
    int tail, nseg;
    __host__ __device__ void init(int M, int N, int K, int G_, int c_, bool split_tail = false) { nM = M / BM; nN = N / BM; nwg = nM * nN; G = G_; c = c_; ntK = K / BK; tail = 0; nseg = 1;
        if (split_tail && nwg > G && 2 * (nwg - G) <= G) { tail = nwg - G; nseg = G / tail; const int P = ntK / 2; if (nseg > P / 2) nseg = P / 2; if (nseg < 1) nseg = 1; } }
    __host__ __device__ void unit_of(int L, Unit& u) const {
        int wgid = L; { const int q = nwg / NXCD, r = nwg % NXCD, xcd = wgid % NXCD, off = wgid / NXCD; wgid = (xcd < r ? xcd * (q + 1) : r * (q + 1) + (xcd - r) * q) + off; }
        const int nig = WGM * nN, gid = wgid / nig, fm = gid * WGM, gsz = (nM - fm) < WGM ? (nM - fm) : WGM;
        u.pm = fm + ((wgid % nig) % gsz); u.pn = (wgid % nig) / gsz; u.k0 = 0; u.nt = ntK; u.part = 0; u.tl = 0; u.half = 0; u.rowoff = 0; u.bq = 0; u.coloff = 0; }
    __host__ __device__ bool next(int i, Unit& u) const {
        if (split2 > 0) { if (!next1(i >> 1, u)) return false; if ((i & 1) == 0) { u.nt = split2; u.part = 10; } else { u.k0 = split2; u.nt = ntK - split2; } return true; }
        return next1(i, u);
    }
    __host__ __device__ bool next1(int i, Unit& u) const {
        if (qtail > 0 && i >= nwg / G) { if (i > nwg / G || c >= 4 * qtail) return false; unit_of((nwg / G) * G + (c >> 2), u); u.half = 1; u.rowoff = 128 * (c & 1); u.bq = 1; u.coloff = 128 * ((c >> 1) & 1); return true; }
        if (htail > 0 && i >= nwg / G) { if (i > nwg / G || c >= 2 * htail) return false; unit_of((nwg / G) * G + (c >> 1), u); u.half = 1; u.rowoff = 128 * (c & 1); return true; }
        if (tail > 0 && i >= 1) {
            if (i > 1 || c >= tail * nseg) return false;
            const int tl = c % tail, sg = c / tail, P = ntK / 2; unit_of(G + tl, u);
            const int p0 = (sg * P) / nseg, p1 = ((sg + 1) * P) / nseg; u.k0 = 2 * p0; u.nt = 2 * (p1 - p0); u.part = 2 + sg; u.tl = tl; return true; }
        const long L = (long)i * G + c; if (L >= nwg + ext_n) return false;
        if (L >= nwg) { const int e = (int)L - nwg; u.pm = ext_pm0 + e / ext_w; u.pn = ext_pn0 + e % ext_w; u.k0 = 0; u.nt = ntK; u.part = 0; u.tl = 0; u.half = 0; u.rowoff = 0; u.bq = 0; u.coloff = 0; return true; }
        unit_of((int)L, u); return true;
    }
    __device__ __forceinline__ void a_ready(const Unit&) const {}
    __device__ __forceinline__ void done(const Unit&) const {}
};


__device__ __forceinline__ unsigned cvt_pk_bf16(float lo, float hi) { unsigned r; asm volatile("v_cvt_pk_bf16_f32 %0, %1, %2" : "=v"(r) : "v"(lo), "v"(hi)); return r; }

__device__ __forceinline__ float bf2f(unsigned short h) { return __uint_as_float(((unsigned)h) << 16); }
__device__ __forceinline__ float bflo(unsigned w) { return __uint_as_float(w << 16); }
__device__ __forceinline__ float bfhi(unsigned w) { return __uint_as_float(w & 0xffff0000u); }
__device__ __forceinline__ float sigm(float x) { return __builtin_amdgcn_rcpf(1.0f + __expf(-x)); }
__device__ __forceinline__ float silu_(float x) { return x * __builtin_amdgcn_rcpf(1.0f + __expf(-x)); }
typedef unsigned u32x2 __attribute__((ext_vector_type(2)));

enum { EM_SWIGLU = 0, EM_RESID = 1, EM_WIN = 2, EM_LORA = 3, EM_M1 = 4, EM_M2 = 5, EM_MF = 6 };
struct EpiGen {
    static constexpr bool AFTER_DRAIN = false;
    int mode; bool PERM; int nseg, pn0, midt;
    void* o0; void* o1; void* o2; const void* i0; const void* i1; const float* f0; const float* f1;
    float alpha, scale;
    __device__ __forceinline__ void mid(f32x4 (&acc)[2][2][4][2], const Unit& u, int wr, int wc, int fr, int fq) const {
        const int row0 = u.pm * BM + u.rowoff + wr * 64 + fr; const int nai = u.half ? 1 : 2, nbj = u.bq ? 1 : 2; const bf16_t* Gt = (const bf16_t*)i0; const int col0 = u.pn * BM + u.coloff + wc * 32 + 8 * fq;
#pragma unroll
        for (int ai = 0; ai < 2; ++ai) if (ai < nai)
#pragma unroll
            for (int m = 0; m < 4; ++m) { const size_t r = (size_t)(row0 + ai * HALF + m * 16);
#pragma unroll
                for (int bj = 0; bj < 2; ++bj) if (bj < nbj) { const int c = col0 + bj * HALF; const u32x4 ga = *(const u32x4*)(Gt + r * 4096 + c), gb = *(const u32x4*)(Gt + r * 4096 + 2048 + c);
                    f32x4& a0 = acc[ai][bj][m][0]; f32x4& a1 = acc[ai][bj][m][1];
                    a0[0] *= bflo(ga.x) * __builtin_amdgcn_rcpf(bflo(gb.x)); a0[1] *= bfhi(ga.x) * __builtin_amdgcn_rcpf(bfhi(gb.x)); a0[2] *= bflo(ga.y) * __builtin_amdgcn_rcpf(bflo(gb.y)); a0[3] *= bfhi(ga.y) * __builtin_amdgcn_rcpf(bfhi(gb.y));
                    a1[0] *= bflo(ga.z) * __builtin_amdgcn_rcpf(bflo(gb.z)); a1[1] *= bfhi(ga.z) * __builtin_amdgcn_rcpf(bfhi(gb.z)); a1[2] *= bflo(ga[3]) * __builtin_amdgcn_rcpf(bflo(gb[3])); a1[3] *= bfhi(ga[3]) * __builtin_amdgcn_rcpf(bfhi(gb[3])); }
                asm volatile("" ::: "memory"); }
    }
    __device__ __forceinline__ void operator()(f32x4 (&acc)[2][2][4][2], const Unit& u, int wr, int wc, int fr, int fq) const {
        if (mode == EM_MF && u.part == 10) { mid(acc, u, wr, wc, fr, fq); return; }
        const int row0 = u.pm * BM + u.rowoff + wr * 64 + fr; const int nai = u.half ? 1 : 2;
        if (mode == EM_SWIGLU) {
            bf16_t* O = (bf16_t*)o0; const int col0 = u.pn * 128 + wc * 32 + 8 * fq;
#pragma unroll
            for (int ai = 0; ai < 2; ++ai) if (ai < nai)
#pragma unroll
                for (int m = 0; m < 4; ++m) { bf16_t* rowp = O + (size_t)(row0 + ai * HALF + m * 16) * 5632 + col0;
                    const f32x4 g0 = acc[ai][0][m][0], g1 = acc[ai][0][m][1], u0 = acc[ai][1][m][0], u1 = acc[ai][1][m][1];
                    f32x4 v0, v1;
#pragma unroll
                    for (int j = 0; j < 4; ++j) { v0[j] = silu_(g0[j]) * u0[j]; v1[j] = silu_(g1[j]) * u1[j]; }
                    u32x4 w; w.x = cvt_pk_bf16(v0[0], v0[1]); w.y = cvt_pk_bf16(v0[2], v0[3]); w.z = cvt_pk_bf16(v1[0], v1[1]); w.w = cvt_pk_bf16(v1[2], v1[3]);
                    *(u32x4*)rowp = w; }
        } else if (mode == EM_RESID) {
            const bf16_t* R = (const bf16_t*)i0; const int col0 = u.pn * BM + wc * 32 + 4 * fq; const bool whole = u.part == 0; const float al = (whole || u.part == 2) ? alpha : 0.f;
            float* C = whole ? (float*)o0 : (float*)o1 + (size_t)(u.tl * nseg + (u.part - 2)) * 65536; const int ldc = whole ? 2048 : 256; const int ro = whole ? row0 : wr * 64 + fr, co = whole ? col0 : wc * 32 + 4 * fq;
#pragma unroll
            for (int ai = 0; ai < 2; ++ai) if (ai < nai)
#pragma unroll
                for (int m = 0; m < 4; ++m) { const size_t off = (size_t)(row0 + ai * HALF + m * 16) * 2048 + col0; float* crow = C + (size_t)(ro + ai * HALF + m * 16) * ldc + co;
#pragma unroll
                    for (int bj = 0; bj < 2; ++bj)
#pragma unroll
                        for (int n = 0; n < 2; ++n) { const u32x2 rv = *(const u32x2*)(R + off + bj * HALF + n * 16);
                            f32x4 o; o[0] = al * bflo(rv.x) + scale * acc[ai][bj][m][n][0]; o[1] = al * bfhi(rv.x) + scale * acc[ai][bj][m][n][1];
                            o[2] = al * bflo(rv.y) + scale * acc[ai][bj][m][n][2]; o[3] = al * bfhi(rv.y) + scale * acc[ai][bj][m][n][3];
                            *(f32x4*)(crow + bj * HALF + n * 16) = o; } }
        } else if (mode == EM_WIN) {
            const int pn = u.pn + pn0; bf16_t* O; int ld, colt, act;
            if (pn < 14) { O = (bf16_t*)o0; ld = 3584; colt = pn * BM; act = 0; }
            else if (pn < 22) { O = (bf16_t*)o1; ld = 2048; colt = (pn - 14) * BM; act = 1; }
            else if (pn < 34) { O = (bf16_t*)o2; ld = 3072; colt = (pn - 22) * BM; act = 0; }
            else { O = (bf16_t*)const_cast<void*>(i1); ld = 4096; colt = (pn - 34) * BM; act = 2; }
            const int col0 = colt + wc * 32 + 8 * fq;
            f32x4 bv[2][2];
#pragma unroll
            for (int bj = 0; bj < 2; ++bj)
#pragma unroll
                for (int n = 0; n < 2; ++n) bv[bj][n] = (act == 2) ? *(const f32x4*)(f0 + col0 + bj * HALF + 4 * n) : (f32x4){0.f, 0.f, 0.f, 0.f};
#pragma unroll
            for (int ai = 0; ai < 2; ++ai) if (ai < nai)
#pragma unroll
                for (int m = 0; m < 4; ++m) { bf16_t* rowp = O + (size_t)(row0 + ai * HALF + m * 16) * ld + col0;
#pragma unroll
                    for (int bj = 0; bj < 2; ++bj) { f32x4 v0 = acc[ai][bj][m][0] + bv[bj][0], v1 = acc[ai][bj][m][1] + bv[bj][1];
                        if (act == 1) {
#pragma unroll
                            for (int j = 0; j < 4; ++j) { v0[j] = silu_(v0[j]); v1[j] = silu_(v1[j]); } }
                        else if (act == 2) {
#pragma unroll
                            for (int j = 0; j < 4; ++j) { v0[j] = sigm(v0[j]); v1[j] = sigm(v1[j]); } }
                        u32x4 w; w.x = cvt_pk_bf16(v0[0], v0[1]); w.y = cvt_pk_bf16(v0[2], v0[3]); w.z = cvt_pk_bf16(v1[0], v1[1]); w.w = cvt_pk_bf16(v1[2], v1[3]);
                        *(u32x4*)(rowp + bj * HALF) = w; } }
        } else if (mode == EM_LORA) {
            const int pn = u.pn; const int col0 = (pn & 3) * BM + wc * 32 + 4 * fq;
            if (pn < 4) {
#pragma unroll
                for (int ai = 0; ai < 2; ++ai) if (ai < nai)
#pragma unroll
                    for (int m = 0; m < 4; ++m) { const size_t off = (size_t)(row0 + ai * HALF + m * 16) * 1024 + col0;
#pragma unroll
                        for (int bj = 0; bj < 2; ++bj)
#pragma unroll
                            for (int n = 0; n < 2; ++n) { const int c = col0 + bj * HALF + n * 16; const f32x4 a = acc[ai][bj][m][n]; const f32x4 b = *(const f32x4*)(f0 + c); f32x4 o;
#pragma unroll
                                for (int j = 0; j < 4; ++j) o[j] = __expf(-0.6065306597f * sigm(a[j] + b[j]));
                                *(f32x4*)((float*)o0 + off + bj * HALF + n * 16) = o; } }
            } else if (pn < 8) {
#pragma unroll
                for (int ai = 0; ai < 2; ++ai) if (ai < nai)
#pragma unroll
                    for (int m = 0; m < 4; ++m) { const size_t off = (size_t)(row0 + ai * HALF + m * 16) * 1024 + col0;
#pragma unroll
                        for (int bj = 0; bj < 2; ++bj)
#pragma unroll
                            for (int n = 0; n < 2; ++n) { const int c = col0 + bj * HALF + n * 16; const f32x4 a = acc[ai][bj][m][n]; const f32x4 b = *(const f32x4*)(f1 + c);
                                u32x2 w; w.x = cvt_pk_bf16(sigm(a[0] + b[0]), sigm(a[1] + b[1])); w.y = cvt_pk_bf16(sigm(a[2] + b[2]), sigm(a[3] + b[3]));
                                *(u32x2*)((bf16_t*)o1 + off + bj * HALF + n * 16) = w; } }
            } else {
#pragma unroll
                for (int ai = 0; ai < 2; ++ai) if (ai < nai)
#pragma unroll
                    for (int m = 0; m < 4; ++m) { const size_t off = (size_t)(row0 + ai * HALF + m * 16) * 1024 + col0;
#pragma unroll
                        for (int bj = 0; bj < 2; ++bj)
#pragma unroll
                            for (int n = 0; n < 2; ++n) { const f32x4 a = acc[ai][bj][m][n];
                                u32x2 w; w.x = cvt_pk_bf16(a[0], a[1]); w.y = cvt_pk_bf16(a[2], a[3]); *(u32x2*)((bf16_t*)o2 + off + bj * HALF + n * 16) = w; } }
            }
        } else if (mode == EM_M1) {
            float* C = (float*)o0; const bf16_t* Gt = (const bf16_t*)i0; const int col0 = u.pn * BM + wc * 32 + 4 * fq;
#pragma unroll
            for (int ai = 0; ai < 2; ++ai) if (ai < nai)
#pragma unroll
                for (int m = 0; m < 4; ++m) { const size_t r = (size_t)(row0 + ai * HALF + m * 16);
#pragma unroll
                    for (int bj = 0; bj < 2; ++bj)
#pragma unroll
                        for (int n = 0; n < 2; ++n) { const int c = col0 + bj * HALF + n * 16; const u32x2 gv = *(const u32x2*)(Gt + r * 4096 + c); const f32x4 a = acc[ai][bj][m][n];
                            f32x4 o; o[0] = bflo(gv.x) * a[0]; o[1] = bfhi(gv.x) * a[1]; o[2] = bflo(gv.y) * a[2]; o[3] = bfhi(gv.y) * a[3];
                            *(f32x4*)(C + r * 2048 + c) = o; } }
        } else if (mode == EM_MF) {
            bf16_t* O = (bf16_t*)o0; const bf16_t* Gt = (const bf16_t*)i0; const int col0 = u.pn * BM + u.coloff + wc * 32 + 8 * fq; const int nbj = u.bq ? 1 : 2;
#pragma unroll
            for (int ai = 0; ai < 2; ++ai) if (ai < nai)
#pragma unroll
                for (int m = 0; m < 4; ++m) { const size_t r = (size_t)(row0 + ai * HALF + m * 16);
#pragma unroll
                    for (int bj = 0; bj < 2; ++bj) if (bj < nbj) { const int c = col0 + bj * HALF; const u32x4 gv = *(const u32x4*)(Gt + r * 4096 + 2048 + c); const f32x4 a0 = acc[ai][bj][m][0], a1 = acc[ai][bj][m][1];
                        u32x4 w; w.x = cvt_pk_bf16(bflo(gv.x) * a0[0], bfhi(gv.x) * a0[1]); w.y = cvt_pk_bf16(bflo(gv.y) * a0[2], bfhi(gv.y) * a0[3]);
                        w.z = cvt_pk_bf16(bflo(gv.z) * a1[0], bfhi(gv.z) * a1[1]); w.w = cvt_pk_bf16(bflo(gv.w) * a1[2], bfhi(gv.w) * a1[3]);
                        *(u32x4*)(O + r * 2048 + c) = w; } }
        } else {
            bf16_t* O = (bf16_t*)o0; const bf16_t* Gt = (const bf16_t*)i0; const float* T1 = (const float*)i1; const int col0 = u.pn * BM + wc * 32 + 8 * fq;
#pragma unroll
            for (int ai = 0; ai < 2; ++ai) if (ai < nai)
#pragma unroll
                for (int m = 0; m < 4; ++m) { const size_t r = (size_t)(row0 + ai * HALF + m * 16);
#pragma unroll
                    for (int bj = 0; bj < 2; ++bj) { const int c = col0 + bj * HALF; const u32x4 gv = *(const u32x4*)(Gt + r * 4096 + 2048 + c);
                        const f32x4 t0 = *(const f32x4*)(T1 + r * 2048 + c), t1 = *(const f32x4*)(T1 + r * 2048 + c + 4); const f32x4 a0 = acc[ai][bj][m][0], a1 = acc[ai][bj][m][1];
                        u32x4 w; w.x = cvt_pk_bf16(t0[0] + bflo(gv.x) * a0[0], t0[1] + bfhi(gv.x) * a0[1]); w.y = cvt_pk_bf16(t0[2] + bflo(gv.y) * a0[2], t0[3] + bfhi(gv.y) * a0[3]);
                        w.z = cvt_pk_bf16(t1[0] + bflo(gv.z) * a1[0], t1[1] + bfhi(gv.z) * a1[1]); w.w = cvt_pk_bf16(t1[2] + bflo(gv.w) * a1[2], t1[3] + bfhi(gv.w) * a1[3]);
                        *(u32x4*)(O + r * 2048 + c) = w; } }
        }
    }
};
template <class Epi, class Sched, bool ALIGN_EPI = false, bool SP2 = false>
__device__ __forceinline__ void gemm_phase(PG8_LAS unsigned char* lds, const Gemm g, const Sched& S, const Epi& E) {
    const int tid = threadIdx.x, wid = __builtin_amdgcn_readfirstlane(tid >> 6), lane = tid & 63, wr = wid >> 2, wc = wid & 3, fr = lane & 15, fq = lane >> 4;
    const int K = g.K;
    unsigned voffA[2], voffB[2];
#pragma unroll
    for (int i = 0; i < 2; ++i) { int R, C; stage_rc(tid * 16 + i * 8192, R, C); const int Rb = E.PERM ? ((R & ~31) + perm32(R & 31)) : R;
        voffA[i] = (unsigned)(R * K + C) * 2u; voffB[i] = (unsigned)(Rb * K + C) * 2u; }
    const size_t kstep = (size_t)(BK * 2);
    const size_t hstep = (size_t)HALF * K * 2;
    const size_t tstep = 2 * hstep;
    const unsigned ldsw = (unsigned)wid * 1024u;
    const int aoff = lds_byte(wr * 64 + fr, fq * 8), boff = lds_byte(wc * 32 + fr, fq * 8);
#define PG8_SA(b, h) (((b) * 2 + (h)) * HTB)
#define PG8_SB(b, h) ((4 + (b) * 2 + (h)) * HTB)
#define PG8_STAGE(bufoff, gbase, voff) do { _Pragma("unroll") for (int _i = 0; _i < 2; ++_i) \
        __builtin_amdgcn_global_load_lds((const unsigned*)((const char*)(gbase) + (voff)[_i]), (PG8_LAS unsigned*)(lds + (bufoff) + ldsw + _i * 8192), 16, 0, 0); } while (0)
#define PG8_LDA(dst, b, h) do { _Pragma("unroll") for (int m = 0; m < 4; ++m) _Pragma("unroll") for (int k = 0; k < 2; ++k) dst[m][k] = *(const PG8_LAS bf16x8*)(lds + PG8_SA(b, h) + aoff + m * 2048 + k * 1024); } while (0)
#define PG8_LDB(dst, b, h) do { _Pragma("unroll") for (int n = 0; n < 2; ++n) _Pragma("unroll") for (int k = 0; k < 2; ++k) dst[n][k] = *(const PG8_LAS bf16x8*)(lds + PG8_SB(b, h) + boff + n * 2048 + k * 1024); } while (0)
#define PG8_MMA(ai, bj, At, Bt) do { __builtin_amdgcn_s_setprio(1); _Pragma("unroll") for (int m = 0; m < 4; ++m) _Pragma("unroll") for (int n = 0; n < 2; ++n) _Pragma("unroll") for (int k = 0; k < 2; ++k) \
        acc[ai][bj][m][n] = __builtin_amdgcn_mfma_f32_16x16x32_bf16(Bt[n][k], At[m][k], acc[ai][bj][m][n], 0, 0, 0); __builtin_amdgcn_s_setprio(0); } while (0)
#define PG8_WAIT_V(n) asm volatile("s_waitcnt vmcnt(" #n ")" ::: "memory")
#define PG8_WAIT_L(n) asm volatile("s_waitcnt lgkmcnt(" #n ")" ::: "memory")
#define PG8_BAR __builtin_amdgcn_s_barrier()
#define PG8_SCHED __builtin_amdgcn_sched_barrier(0)
    Unit cur, nxt; int ui = 0;
    if (!S.next(0, cur)) return;
    f32x4 acc[2][2][4][2];
#pragma unroll
    for (int a = 0; a < 2; ++a)
#pragma unroll
        for (int b = 0; b < 2; ++b)
#pragma unroll
            for (int m = 0; m < 4; ++m)
#pragma unroll
                for (int n = 0; n < 2; ++n) acc[a][b][m][n] = (f32x4){0.f, 0.f, 0.f, 0.f};
    bf16x8 At[4][2], B0[2][2], B1[2][2];
    size_t cH = cur.half ? 0 : hstep, cBH = cur.bq ? 0 : hstep;
    const char* cA = (const char*)g.A + (size_t)cur.pm * tstep + (size_t)(cur.rowoff >> 7) * hstep + (size_t)cur.k0 * kstep; const char* cB = (const char*)g.Bt + (size_t)cur.pn * tstep + (size_t)(cur.coloff >> 7) * hstep + (size_t)cur.k0 * kstep;
    S.a_ready(cur);
    if constexpr (SP2) {
        PG8_STAGE(PG8_SB(0, 0), cB, voffB); PG8_STAGE(PG8_SB(0, 1), cB + cBH, voffB); PG8_STAGE(PG8_SA(0, 0), cA, voffA); PG8_STAGE(PG8_SA(0, 1), cA + cH, voffA);
        if (wr == 1) PG8_BAR;
        PG8_WAIT_V(2); PG8_BAR;
        PG8_STAGE(PG8_SB(1, 0), cB + kstep, voffB); PG8_STAGE(PG8_SA(1, 0), cA + kstep, voffA); PG8_STAGE(PG8_SB(1, 1), cB + cBH + kstep, voffB);
        PG8_WAIT_V(6); PG8_BAR;
    } else {
        PG8_STAGE(PG8_SB(0, 0), cB, voffB); PG8_STAGE(PG8_SA(0, 0), cA, voffA); PG8_STAGE(PG8_SB(0, 1), cB + hstep, voffB); PG8_STAGE(PG8_SA(0, 1), cA + hstep, voffA);
        if (wr == 1) PG8_BAR;
        PG8_WAIT_V(4); PG8_BAR;
        PG8_STAGE(PG8_SB(1, 0), cB + kstep, voffB); PG8_STAGE(PG8_SA(1, 0), cA + kstep, voffA); PG8_STAGE(PG8_SB(1, 1), cB + hstep + kstep, voffB);
        PG8_WAIT_V(6); PG8_BAR;
    }
    for (;;) {
        const bool has_next = S.next(ui + 1, nxt);
        const size_t nH = has_next ? (nxt.half ? 0 : hstep) : cH, nBH = has_next ? (nxt.bq ? 0 : hstep) : cBH;
        const char* nA = has_next ? (const char*)g.A + (size_t)nxt.pm * tstep + (size_t)(nxt.rowoff >> 7) * hstep + (size_t)nxt.k0 * kstep : cA; const char* nB = has_next ? (const char*)g.Bt + (size_t)nxt.pn * tstep + (size_t)(nxt.coloff >> 7) * hstep + (size_t)nxt.k0 * kstep : cB;
        const int nt = cur.nt;
        for (int t = 0; t < nt; t += 2) {
            const bool last = (t == nt - 2);
            const char* a1 = cA + (size_t)(t + 1) * kstep;
            const char* a2 = last ? nA : cA + (size_t)(t + 2) * kstep; const char* b2 = last ? nB : cB + (size_t)(t + 2) * kstep;
            const char* a3 = a2 + kstep; const char* b3 = b2 + kstep;
            if (last && has_next) S.a_ready(nxt);
            if constexpr (SP2) {
            PG8_LDB(B0, 0, 0); PG8_LDB(B1, 0, 1); PG8_SCHED; PG8_LDA(At, 0, 0); PG8_STAGE(PG8_SA(1, 1), a1 + cH, voffA);
            PG8_WAIT_V(8); PG8_WAIT_L(0); PG8_BAR; PG8_MMA(0, 0, At, B0); if (!cur.bq) { PG8_MMA(0, 1, At, B1); } PG8_BAR; PG8_SCHED;
            PG8_LDA(At, 0, 1); PG8_STAGE(PG8_SB(0, 0), b2, voffB); PG8_STAGE(PG8_SB(0, 1), b2 + (last ? nBH : cBH), voffB); PG8_STAGE(PG8_SA(0, 0), a2, voffA);
            PG8_WAIT_V(8); PG8_WAIT_L(0); PG8_BAR; if (!cur.half) { PG8_MMA(1, 0, At, B0); if (!cur.bq) { PG8_MMA(1, 1, At, B1); } } PG8_BAR; PG8_SCHED;
            PG8_LDB(B0, 1, 0); PG8_LDB(B1, 1, 1); PG8_SCHED; PG8_LDA(At, 1, 0); PG8_STAGE(PG8_SA(0, 1), a2 + (last ? nH : cH), voffA);
            PG8_WAIT_V(8); PG8_WAIT_L(0); PG8_BAR; PG8_MMA(0, 0, At, B0); if (!cur.bq) { PG8_MMA(0, 1, At, B1); } PG8_BAR; PG8_SCHED;
            PG8_LDA(At, 1, 1); PG8_STAGE(PG8_SB(1, 0), b3, voffB); PG8_STAGE(PG8_SB(1, 1), b3 + (last ? nBH : cBH), voffB); PG8_STAGE(PG8_SA(1, 0), a3, voffA);
            PG8_WAIT_V(8); PG8_WAIT_L(0); PG8_BAR; if (!cur.half) { PG8_MMA(1, 0, At, B0); if (!cur.bq) { PG8_MMA(1, 1, At, B1); } } PG8_BAR; PG8_SCHED;
            } else {
            PG8_LDB(B0, 0, 0); PG8_SCHED; PG8_LDA(At, 0, 0); PG8_STAGE(PG8_SA(1, 1), a1 + hstep, voffA);
            PG8_WAIT_L(8); PG8_BAR; PG8_WAIT_L(0); PG8_MMA(0, 0, At, B0); PG8_BAR; PG8_SCHED;
            PG8_LDB(B1, 0, 1); PG8_STAGE(PG8_SB(0, 0), b2, voffB);
            PG8_BAR; PG8_WAIT_L(0); PG8_MMA(0, 1, At, B1); PG8_BAR;
            PG8_LDA(At, 0, 1); PG8_STAGE(PG8_SA(0, 0), a2, voffA);
            PG8_BAR; PG8_WAIT_L(0); PG8_MMA(1, 0, At, B0); PG8_BAR; PG8_SCHED;
            PG8_STAGE(PG8_SB(0, 1), b2 + hstep, voffB);
            PG8_WAIT_V(6); PG8_BAR; PG8_MMA(1, 1, At, B1); PG8_BAR;
            PG8_LDB(B0, 1, 0); PG8_SCHED; PG8_LDA(At, 1, 0); PG8_STAGE(PG8_SA(0, 1), a2 + hstep, voffA);
            PG8_WAIT_L(8); PG8_BAR; PG8_WAIT_L(0); PG8_MMA(0, 0, At, B0); PG8_BAR; PG8_SCHED;
            PG8_LDB(B1, 1, 1); PG8_STAGE(PG8_SB(1, 0), b3, voffB);
            PG8_BAR; PG8_WAIT_L(0); PG8_MMA(0, 1, At, B1); PG8_BAR;
            PG8_LDA(At, 1, 1); PG8_STAGE(PG8_SA(1, 0), a3, voffA);
            PG8_BAR; PG8_WAIT_L(0); PG8_MMA(1, 0, At, B0); PG8_BAR; PG8_SCHED;
            PG8_STAGE(PG8_SB(1, 1), b3 + hstep, voffB);
            PG8_WAIT_V(6); PG8_BAR; PG8_MMA(1, 1, At, B1); PG8_BAR;
            }
        }
        if constexpr (ALIGN_EPI) { if (wr == 0) PG8_BAR; }
        if constexpr (!Epi::AFTER_DRAIN) { E(acc, cur, wr, wc, fr, fq); S.done(cur); }
        if (!has_next) break;
        { const float keep = (cur.part == 10) ? 1.f : 0.f;
#pragma unroll
        for (int a = 0; a < 2; ++a)
#pragma unroll
            for (int b = 0; b < 2; ++b)
#pragma unroll
                for (int m = 0; m < 4; ++m)
#pragma unroll
                    for (int n = 0; n < 2; ++n) acc[a][b][m][n] = acc[a][b][m][n] * keep; }
        cur = nxt; cA = nA; cB = nB; cH = nH; cBH = nBH; ++ui;
        if constexpr (ALIGN_EPI) { if (wr == 1) PG8_BAR; }
    }
    PG8_WAIT_V(0);
    if constexpr (!ALIGN_EPI) { if (wr == 0) PG8_BAR; }
    PG8_BAR;
    if constexpr (Epi::AFTER_DRAIN) { E.fused(acc, cur, wr, wc, fr, fq, lds, wid, lane); S.done(cur); }
#undef PG8_SA
#undef PG8_SB
#undef PG8_STAGE
#undef PG8_LDA
#undef PG8_LDB
#undef PG8_MMA
#undef PG8_WAIT_V
#undef PG8_WAIT_L
#undef PG8_BAR
#undef PG8_SCHED
}
}

#define LAS __attribute__((address_space(3)))
typedef unsigned short bf16;
typedef float f32x4 __attribute__((ext_vector_type(4)));
typedef float f32x2 __attribute__((ext_vector_type(2)));
typedef unsigned u32x4 __attribute__((ext_vector_type(4)));
typedef unsigned u32x2 __attribute__((ext_vector_type(2)));
typedef short bf16x8 __attribute__((ext_vector_type(8)));
using pg8::bf2f; using pg8::bflo; using pg8::bfhi; using pg8::sigm; using pg8::silu_; using pg8::cvt_pk_bf16;

constexpr int D = 2048, FF = 5632, NB = 4, SEQ = 2048, NMETA = 16, PADR = 48, LP = 2112  , TP = 2064  ;
constexpr int SB = 16, SS = 16, MP = NB * LP  , MROWS = MP + SB * SS  ;
constexpr int RWD = 1024, RWH = 16, SHC = 3520, CONVD = 3072, SSMH = 32, SSMN = 128, NINP = 12800;
constexpr int PRW_LD = 3584, Z_LD = 2048, XBC_LD = 3072, GATE_LD = 4096;
constexpr float LN_EPS = 1e-5f, ALPHA = 1.189207115f  , GN_EPS = 64e-5f, RMS_EPS = 1e-5f;
constexpr int NPHASE = 17;
constexpr int GATE_PM_HELPED = 28;
constexpr int LDS_BYTES = 163840;

enum { I_XP = 0, I_XS, I_SSH, I_SWKV, I_SCONV, I_SSSM, I_META, I_GU1, I_DN1, I_LN1G, I_LN1B, I_WIN, I_BGATE, I_MU, I_W0, I_W2, I_A0, I_A2, I_G2, I_KK, I_KA, I_RK, I_GNW, I_GNB,
       I_CONVW, I_CONVB, I_DTB, I_ALOG, I_DSKIP, I_NORMW, I_RWO, I_SSMO, I_WO, I_LN2G, I_LN2B, I_GU2, I_DN2, I_LN3G, I_LN3B, N_IN };
constexpr size_t O_YP = 0, O_YS = 16777216, O_PSH = 17301504, O_PWKV = 17315584, O_PCONV = 17577728, O_PSSM = 17614592, O_SSH = 18663168, O_SWKV = 18719488, O_SCONV = 19768064, O_SSSM = 19915520, O_END = 24109824;
constexpr size_t MiB = 1u << 20;
constexpr size_t WS_SBON = 1 * MiB, WS_RWOT = 2 * MiB, WS_SSMOT = 6 * MiB, WS_WOT = 14 * MiB, WS_LORAT = 22 * MiB, WS_WBIG = 25 * MiB, WS_XB = 91 * MiB, WS_ACT = 125 * MiB, WS_PROJ = 219 * MiB, WS_YRW = 432 * MiB, WS_END = 449 * MiB;
constexpr size_t WS_GUT = WS_WBIG, WS_DNT = WS_WBIG + 44 * MiB, WS_WINT = WS_WBIG, WS_WDEC = WS_WBIG;
constexpr size_t WS_C12 = WS_LORAT, WS_KK0 = WS_SBON + 600000;
constexpr size_t OUT_GBUF = 34 * MiB;
constexpr size_t WS_R = WS_ACT, WS_KP = WS_ACT + 17 * MiB, WS_V = WS_ACT + 34 * MiB, WS_KK = WS_ACT + 51 * MiB, WS_BB = WS_ACT + 68 * MiB, WS_ALORA = WS_ACT + 85 * MiB, WS_T1 = WS_ACT;
constexpr size_t WS_XBC = WS_PROJ, WS_PRW = WS_XBC + (size_t)MROWS * XBC_LD * 2, WS_Z = WS_PRW + (size_t)MROWS * PRW_LD * 2, WS_GATE = WS_Z + (size_t)MROWS * Z_LD * 2, WS_PRE = WS_PROJ, WS_SLAB = WS_PROJ + 68 * MiB;
constexpr size_t WS_ACAT = WS_XBC, WS_BCAT = WS_RWOT;
static_assert(WS_GATE + (size_t)MROWS * GATE_LD * 2 <= WS_YRW, "proj region");
static_assert(WS_ALORA + (size_t)MROWS * 512 * 2 <= WS_PROJ, "act region");

struct Params { const float* in[N_IN]; float* out; unsigned char* ws; int ph_lo, ph_hi; };

__device__ __forceinline__ int opaque_idx(int i) { asm volatile("" : "+s"(i)); return i; }
#define PIN(i) (p.in[opaque_idx(i)])
struct Ctx { int tid, lane, wave, gw, ngw; LAS unsigned char* lds; };

__device__ __forceinline__ float wave_sum(float v) {
#pragma unroll
    for (int o = 1; o < 64; o <<= 1) v += __shfl_xor(v, o);
    return v;
}
__device__ __forceinline__ unsigned pk2(float lo, float hi) { return cvt_pk_bf16(lo, hi); }
__device__ __forceinline__ float softplus_(float x) { return fmaxf(x, 0.f) + __logf(1.f + __expf(-fabsf(x))); }

__device__ __forceinline__ const float* xrow_ptr(const Params& p, int row) {
    if (row < MP) { const int b = row / LP, q = row - b * LP; if (q < PADR) return nullptr; const int t = q - PADR;
        return t < NMETA ? PIN(I_META) + (size_t)t * D : PIN(I_XP) + ((size_t)b * SEQ + (t - NMETA)) * D; }
    return PIN(I_XS) + (size_t)(row - MP) * D;
}
__device__ __forceinline__ float* yrow_ptr(const Params& p, int row) {
    if (row < MP) { const int b = row / LP, q = row - b * LP; if (q < PADR + NMETA) return nullptr; return p.out + O_YP + ((size_t)b * SEQ + (q - PADR - NMETA)) * D; }
    return p.out + O_YS + (size_t)(row - MP) * D;
}
__device__ __forceinline__ bool row_is_pad(int row) { return row < MP && (row % LP) < PADR; }

__device__ __forceinline__ void phase_convert_x(const Params& p, const Ctx& c) {
    bf16* XB = (bf16*)(p.ws + WS_XB);
    for (int row = c.gw; row < MROWS; row += c.ngw) { const float* src = xrow_ptr(p, row); const bool ok = src != nullptr; src = ok ? src : PIN(I_META); u32x2* dst = (u32x2*)(XB + (size_t)row * D);
        f32x4 v[8];
#pragma unroll
        for (int j = 0; j < 8; ++j) v[j] = ((const f32x4*)src)[c.lane + 64 * j];
#pragma unroll
        for (int j = 0; j < 8; ++j) { u32x2 w; w.x = ok ? pk2(v[j][0], v[j][1]) : 0u; w.y = ok ? pk2(v[j][2], v[j][3]) : 0u; dst[c.lane + 64 * j] = w; } }
}
enum { MAP_ID = 0, MAP_GU = 1, MAP_WIN = 2 };
__device__ __forceinline__ int map_src_col(int kind, int c) {
    if (kind == MAP_ID) return c;
    if (kind == MAP_GU) { const int pn = c >> 8, bj = (c >> 7) & 1, r = c & 127; return bj * FF + 128 * pn + r; }
    if (c < 3520) return c; if (c < 3552) return 8640 + (c - 3520); if (c < 3584) return -1; if (c < 5632) return 3520 + (c - 3584); if (c < 8704) return 5568 + (c - 5632); return 8672 + (c - 8704);
}
__device__ __forceinline__ void tr_load(const float* W, int K, int Nsrc, int nblk, int kind, int it, int cg, int half, int kr, f32x4 (&v)[16]) {
    const int kb = it / nblk, nb = it - kb * nblk, k0 = 64 * kb, n0 = 64 * nb; int sc = map_src_col(kind, n0 + 32 * half); const bool ok = sc >= 0; sc = ok ? sc : 0;
#pragma unroll
    for (int i = 0; i < 16; ++i) { const f32x4 t = *(const f32x4*)(W + (size_t)(k0 + 4 * i + kr) * Nsrc + sc + 4 * (cg & 7)); v[i] = ok ? t : (f32x4){0.f, 0.f, 0.f, 0.f}; }
}
__device__ __forceinline__ void transpose_w(const float* W, int K, int Nsrc, bf16* WT, int ndst, int kind, const Ctx& c, int item_lo = 0, int item_hi = 1 << 30, int wid = -1, int nworkers = 0, int ldt = 0) {
    if (ldt == 0) ldt = K;
    LAS float* scr = (LAS float*)(c.lds + c.wave * 16640);
    const int nblk = ndst / 64, lane = c.lane; int nitems = (K / 64) * nblk; if (item_hi < nitems) nitems = item_hi;
    const int gw_ = wid < 0 ? c.gw : wid, ngw_ = wid < 0 ? c.ngw : nworkers;
    const int cg = lane & 15, half = cg >> 3, kr = lane >> 4;
    f32x4 v[16];
    int it = item_lo + gw_; if (it < nitems) tr_load(W, K, Nsrc, nblk, kind, it, cg, half, kr, v);
    for (; it < nitems; it += ngw_) {
        const int kb = it / nblk, nb = it - kb * nblk, k0 = 64 * kb, n0 = 64 * nb;
#pragma unroll
        for (int i = 0; i < 16; ++i) { LAS float* d = scr + (4 * i + kr) * 65 + 4 * cg; d[0] = v[i][0]; d[1] = v[i][1]; d[2] = v[i][2]; d[3] = v[i][3]; }
        if (it + ngw_ < nitems) tr_load(W, K, Nsrc, nblk, kind, it + ngw_, cg, half, kr, v);
        asm volatile("s_waitcnt lgkmcnt(0)" ::: "memory");
        const int cc = lane & 7;
#pragma unroll
        for (int j = 0; j < 8; ++j) { const int n = (lane >> 3) + 8 * j; const LAS float* sp = scr + (8 * cc) * 65 + n;
            u32x4 o; o.x = pk2(sp[0 * 65], sp[1 * 65]); o.y = pk2(sp[2 * 65], sp[3 * 65]); o.z = pk2(sp[4 * 65], sp[5 * 65]); o[3] = pk2(sp[6 * 65], sp[7 * 65]);
            *(u32x4*)(WT + (size_t)(n0 + n) * ldt + k0 + 8 * cc) = o; }
        asm volatile("s_waitcnt lgkmcnt(0)" ::: "memory");
    }
}
__device__ __forceinline__ void build_lorat(const Params& p, const Ctx& c) {
    bf16* LT = (bf16*)(p.ws + WS_LORAT); const float* w2 = PIN(I_W2); const float* a2 = PIN(I_A2); const float* g2 = PIN(I_G2);
    for (int n = c.gw; n < 3072; n += c.ngw) { float v[8];
#pragma unroll
        for (int j = 0; j < 8; ++j) { const int k = 8 * c.lane + j; float x = 0.f;
            if (n < 1024) { if (k < 96) x = w2[k * 1024 + n]; }
            else if (n < 2048) { if (k >= 96 && k < 192) x = a2[(k - 96) * 1024 + (n - 1024)]; }
            else { if (k >= 256) x = g2[(k - 256) * 1024 + (n - 2048)]; }
            v[j] = x; }
        u32x4 o; o.x = pk2(v[0], v[1]); o.y = pk2(v[2], v[3]); o.z = pk2(v[4], v[5]); o[3] = pk2(v[6], v[7]);
        *(u32x4*)(LT + (size_t)n * 512 + 8 * c.lane) = o; }
}
template <bool FINAL> __device__ __forceinline__ void phase_ln(const Params& p, const Ctx& c, const float* gam, const float* bet, int K  ) {
    const float* PRE = (const float*)(p.ws + WS_PRE); const float* SLAB = (const float*)(p.ws + WS_SLAB); bf16* XB = (bf16*)(p.ws + WS_XB);
    pg8::StaticOrder S; S.init(MROWS, D, K, (int)gridDim.x, 0, true); const int nseg = S.nseg;
    LAS signed char* tailtab = (LAS signed char*)(c.lds + 150000);
    __syncthreads();
    if (c.tid < (MROWS / 256) * 8) tailtab[c.tid] = -1;
    __syncthreads();
    if (c.tid < S.tail) { pg8::Unit u; S.unit_of(S.G + c.tid, u); tailtab[u.pm * 8 + u.pn] = (signed char)c.tid; }
    __syncthreads();
    f32x4 gv[8], bv[8];
#pragma unroll
    for (int j = 0; j < 8; ++j) { gv[j] = ((const f32x4*)gam)[c.lane + 64 * j]; bv[j] = ((const f32x4*)bet)[c.lane + 64 * j]; }
    for (int row = c.gw; row < MROWS; row += c.ngw) {
        float* yo = nullptr; if (FINAL) { yo = yrow_ptr(p, row); if (!yo) continue; }
        const f32x4* src = (const f32x4*)(PRE + (size_t)row * D); f32x4 v[8]; float s = 0.f;
#pragma unroll
        for (int j = 0; j < 8; ++j) { const int tl = tailtab[(row >> 8) * 8 + j];
            if (tl < 0) v[j] = src[c.lane + 64 * j];
            else { f32x4 a = (f32x4){0.f, 0.f, 0.f, 0.f}; const float* sp = SLAB + ((size_t)tl * nseg * 256 + (row & 255)) * 256 + c.lane * 4;
                for (int sg = 0; sg < nseg; ++sg) a += *(const f32x4*)(sp + (size_t)sg * 65536);
                v[j] = a; }
            s += (v[j][0] + v[j][1]) + (v[j][2] + v[j][3]); }
        const float mean = wave_sum(s) * (1.f / D); float q = 0.f;
#pragma unroll
        for (int j = 0; j < 8; ++j) { v[j] = v[j] - mean; q += (v[j][0] * v[j][0] + v[j][1] * v[j][1]) + (v[j][2] * v[j][2] + v[j][3] * v[j][3]); }
        const float rstd = 1.f / sqrtf(wave_sum(q) * (1.f / D) + LN_EPS);
#pragma unroll
        for (int j = 0; j < 8; ++j) { const f32x4 o = v[j] * rstd * gv[j] + bv[j];
            if (FINAL) ((f32x4*)yo)[c.lane + 64 * j] = o;
            else { u32x2 w; w.x = pk2(o[0], o[1]); w.y = pk2(o[2], o[3]); ((u32x2*)(XB + (size_t)row * D))[c.lane + 64 * j] = w; } }
    }
}
__device__ __forceinline__ float sum8(float v) { v += __shfl_xor(v, 1); v += __shfl_xor(v, 2); v += __shfl_xor(v, 4); return v; }
__device__ __forceinline__ void ld8bf(const bf16* ptr, float (&o)[8]) { const u32x4 w = *(const u32x4*)ptr; o[0] = bflo(w.x); o[1] = bfhi(w.x); o[2] = bflo(w.y); o[3] = bfhi(w.y); o[4] = bflo(w.z); o[5] = bfhi(w.z); o[6] = bflo(w[3]); o[7] = bfhi(w[3]); }
__device__ __forceinline__ void st8bf(bf16* ptr, const float (&v)[8]) { u32x4 w; w.x = pk2(v[0], v[1]); w.y = pk2(v[2], v[3]); w.z = pk2(v[4], v[5]); w[3] = pk2(v[6], v[7]); *(u32x4*)ptr = w; }
__device__ __forceinline__ void ld8f(const float* ptr, float (&o)[8]) { const f32x4 a = *(const f32x4*)ptr, b = *(const f32x4*)(ptr + 4); o[0] = a[0]; o[1] = a[1]; o[2] = a[2]; o[3] = a[3]; o[4] = b[0]; o[5] = b[1]; o[6] = b[2]; o[7] = b[3]; }
__device__ __forceinline__ void phase_prep1(const Params& p, const Ctx& c) {
    const bf16* PRW = (const bf16*)(p.ws + WS_PRW); const bf16* XBC = (const bf16*)(p.ws + WS_XBC); bf16* AL = (bf16*)(p.ws + WS_ALORA); const float* mu = PIN(I_MU);
    for (int row = c.gw; row < MROWS; row += c.ngw) {
        bf16* al = AL + (size_t)row * 512; const int l = c.lane;
        if (row_is_pad(row)) { *(u32x4*)(al + 8 * l) = (u32x4){0u, 0u, 0u, 0u}; continue; }
        const bf16* cur = PRW + (size_t)row * PRW_LD; const bf16* prv = cur - PRW_LD; const float* prvf = nullptr; bool zprev = false;
        if (row < MP) { if ((row % LP) == PADR) { zprev = true; prv = cur; } }
        else { const int s = row - MP; if ((s & 15) == 0) { prvf = PIN(I_SSH) + (size_t)(s >> 4) * SHC; prv = cur; } }
        const int lc = l < 56 ? l : 55, col = 3072 + 8 * lc;
        float pc[8], pp[8], m[8]; ld8bf(cur + col, pc); ld8bf(prv + col, pp); ld8f(mu + col, m);
        if (prvf) ld8f(prvf + col, pp);
        float o[8];
#pragma unroll
        for (int j = 0; j < 8; ++j) { const float pv = zprev ? 0.f : pp[j]; const float ps = pc[j] + (pv - pc[j]) * m[j]; const int cc = 8 * lc + j;
            o[j] = cc < 96 ? tanhf(ps) : (cc < 192 ? ps : sigm(ps)); }
        if (l < 24) st8bf(al + 8 * l, o);
        else if (l < 56) st8bf(al + 256 + 8 * (l - 24), o);
        else *(u32x4*)(al + 192 + 8 * (l - 56)) = (u32x4){0u, 0u, 0u, 0u};
    }
    const int gt = blockIdx.x * 512 + c.tid, ngt = gridDim.x * 512;
    for (int i = gt; i < NB * SHC; i += ngt) { const int b = i / SHC, col = i - b * SHC; p.out[O_PSH + i] = bf2f(PRW[(size_t)(b * LP + LP - 1) * PRW_LD + col]); }
    for (int i = gt; i < SB * SHC; i += ngt) { const int b = i / SHC, col = i - b * SHC; p.out[O_SSH + i] = bf2f(PRW[(size_t)(MP + b * SS + SS - 1) * PRW_LD + col]); }
    for (int i = gt; i < NB * 3 * CONVD; i += ngt) { const int b = i / (3 * CONVD), r = (i / CONVD) % 3, col = i % CONVD; p.out[O_PCONV + i] = bf2f(XBC[(size_t)(b * LP + LP - 3 + r) * XBC_LD + col]); }
    for (int i = gt; i < SB * 3 * CONVD; i += ngt) { const int b = i / (3 * CONVD), r = (i / CONVD) % 3, col = i % CONVD; p.out[O_SCONV + i] = bf2f(XBC[(size_t)(MP + b * SS + SS - 3 + r) * XBC_LD + col]); }
}
__device__ __forceinline__ float sum16(float v) { v += __shfl_xor(v, 1); v += __shfl_xor(v, 2); v += __shfl_xor(v, 4); v += __shfl_xor(v, 8); return v; }
__device__ __forceinline__ void ld4bf(const bf16* ptr, float (&o)[4]) { const u32x2 w = *(const u32x2*)ptr; o[0] = bflo(w.x); o[1] = bfhi(w.x); o[2] = bflo(w.y); o[3] = bfhi(w.y); }
__device__ __forceinline__ void st4bf(bf16* ptr, const float (&v)[4]) { u32x2 w; w.x = pk2(v[0], v[1]); w.y = pk2(v[2], v[3]); *(u32x2*)ptr = w; }
__device__ __forceinline__ void shifted4(const bf16* cur, const bf16* prv, const float* prvf, int col, const float* mu, float (&o)[4]) {
    float pc[4], pp[4]; ld4bf(cur + col, pc);
    if (prv) ld4bf(prv + col, pp); else if (prvf) { const f32x4 t = *(const f32x4*)(prvf + col); pp[0] = t[0]; pp[1] = t[1]; pp[2] = t[2]; pp[3] = t[3]; } else { pp[0] = pp[1] = pp[2] = pp[3] = 0.f; }
    const f32x4 m = *(const f32x4*)(mu + col);
#pragma unroll
    for (int j = 0; j < 4; ++j) o[j] = pc[j] + (pp[j] - pc[j]) * m[j];
}
__device__ __forceinline__ void phase_prep2(const Params& p, const Ctx& c) {
    const bf16* PRW = (const bf16*)(p.ws + WS_PRW); bf16* R = (bf16*)(p.ws + WS_R); bf16* KP = (bf16*)(p.ws + WS_KP); bf16* V = (bf16*)(p.ws + WS_V); bf16* KK = (bf16*)(p.ws + WS_KK); bf16* BB = (bf16*)(p.ws + WS_BB);
    float* SBON = (float*)(p.ws + WS_SBON); const float* mu = PIN(I_MU);
    const int t8 = c.tid & 127, ch = 8 * t8, head = t8 >> 3;
    float mur[8], muk[8], muv[8], wkk[8], wka[8], wrk[8];
    ld8f(mu + ch, mur); ld8f(mu + 1024 + ch, muk); ld8f(mu + 2048 + ch, muv); ld8f(PIN(I_KK) + ch, wkk); ld8f(PIN(I_KA) + ch, wka); ld8f(PIN(I_RK) + ch, wrk);
    for (int row = blockIdx.x * 4 + (c.tid >> 7); row < MROWS; row += gridDim.x * 4) {
        if (row_is_pad(row)) continue;
        const bf16* cur = PRW + (size_t)row * PRW_LD; const bf16* prv = cur - PRW_LD; const float* prvf = nullptr; bool zprev = false;
        if (row < MP) { if ((row % LP) == PADR) { zprev = true; prv = cur; } }
        else { const int s = row - MP; if ((s & 15) == 0) { prvf = PIN(I_SSH) + (size_t)(s >> 4) * SHC; prv = cur; } }
        float rc[8], kc[8], vc[8], rp[8], kp_[8], vp[8], a[8];
        ld8bf(cur + ch, rc); ld8bf(cur + 1024 + ch, kc); ld8bf(cur + 2048 + ch, vc); ld8bf(prv + ch, rp); ld8bf(prv + 1024 + ch, kp_); ld8bf(prv + 2048 + ch, vp);
        ld8bf(BB + (size_t)row * RWD + ch, a);
        if (prvf) { ld8f(prvf + ch, rp); ld8f(prvf + 1024 + ch, kp_); ld8f(prvf + 2048 + ch, vp); }
        float r[8], k[8], v[8], kk[8], ss = 0.f;
#pragma unroll
        for (int j = 0; j < 8; ++j) { const float pr = zprev ? 0.f : rp[j], pk = zprev ? 0.f : kp_[j], pv = zprev ? 0.f : vp[j];
            r[j] = rc[j] + (pr - rc[j]) * mur[j]; k[j] = kc[j] + (pk - kc[j]) * muk[j]; v[j] = vc[j] + (pv - vc[j]) * muv[j]; kk[j] = k[j] * wkk[j]; ss += kk[j] * kk[j]; }
        ss = sum8(ss); const float inv = 1.f / fmaxf(sqrtf(ss), 1e-12f);
        float kp[8], bb[8], sb = 0.f;
#pragma unroll
        for (int j = 0; j < 8; ++j) { kk[j] *= inv; kp[j] = k[j] * (1.f + (a[j] - 1.f) * wka[j]); bb[j] = kk[j] * a[j]; sb += r[j] * kp[j] * wrk[j]; }
        sb = sum8(sb);
        const size_t o = (size_t)row * RWD + ch;
        st8bf(R + o, r); st8bf(KP + o, kp); st8bf(V + o, v); st8bf(KK + o, kk); st8bf(BB + o, bb);
        if ((t8 & 7) == 0) SBON[(size_t)row * RWH + head] = sb;
    }
}
__device__ __forceinline__ void phase_post(const Params& p, const Ctx& c) {
    const float* YRAW = p.out; const bf16* V = (const bf16*)(p.ws + WS_V); const bf16* G = (const bf16*)((const unsigned char*)p.out + OUT_GBUF); const float* SBON = (const float*)(p.ws + WS_SBON); bf16* ACAT = (bf16*)(p.ws + WS_ACAT);
    { const int t8 = c.tid & 127, ch = 8 * t8, head = t8 >> 3;
      float gw[8], gb[8]; ld8f(PIN(I_GNW) + ch, gw); ld8f(PIN(I_GNB) + ch, gb);
      for (int row = blockIdx.x * 4 + (c.tid >> 7); row < MROWS; row += gridDim.x * 4) {
        const size_t o = (size_t)row * RWD + ch, oc = (size_t)row * 3072 + ch;
        if (row_is_pad(row)) { *(u32x4*)(ACAT + oc) = (u32x4){0u, 0u, 0u, 0u}; continue; }
        float y[8], v[8], g[8]; ld8f(YRAW + o, y); ld8bf(V + o, v); ld8bf(G + o, g); const float sb = SBON[(size_t)row * RWH + head];
        float sy = 0.f;
#pragma unroll
        for (int j = 0; j < 8; ++j) sy += y[j];
        const float mean = sum8(sy) * (1.f / 64.f);
        float d[8], q = 0.f;
#pragma unroll
        for (int j = 0; j < 8; ++j) { d[j] = y[j] - mean; q += d[j] * d[j]; }
        const float rstd = 1.f / sqrtf(sum8(q) * (1.f / 64.f) + GN_EPS);
        float ov[8];
#pragma unroll
        for (int j = 0; j < 8; ++j) ov[j] = (d[j] * rstd * gw[j] + gb[j] + sb * v[j]) * g[j];
        st8bf(ACAT + oc, ov);
      } }
    { const bf16* Z = (const bf16*)(p.ws + WS_Z); const float* nw = PIN(I_NORMW);
      for (int it = c.gw; it < MROWS * 4; it += c.ngw) { const int row = it >> 2, g = it & 3; const bf16* ptr = Z + (size_t)row * Z_LD + g * 512 + c.lane * 8;
        const u32x4 w = *(const u32x4*)ptr; float v[8] = {bflo(w.x), bfhi(w.x), bflo(w.y), bfhi(w.y), bflo(w.z), bfhi(w.z), bflo(w[3]), bfhi(w[3])};
        float ss = 0.f;
#pragma unroll
        for (int j = 0; j < 8; ++j) ss += v[j] * v[j];
        const float rs = 1.f / sqrtf(wave_sum(ss) * (1.f / 512.f) + RMS_EPS);
        const f32x4 n0 = *(const f32x4*)(nw + g * 512 + c.lane * 8), n1 = *(const f32x4*)(nw + g * 512 + c.lane * 8 + 4);
        u32x4 o; o.x = pk2(v[0] * rs * n0[0], v[1] * rs * n0[1]); o.y = pk2(v[2] * rs * n0[2], v[3] * rs * n0[3]); o.z = pk2(v[4] * rs * n1[0], v[5] * rs * n1[1]); o[3] = pk2(v[6] * rs * n1[2], v[7] * rs * n1[3]);
        *(u32x4*)(ACAT + (size_t)row * 3072 + 1024 + g * 512 + c.lane * 8) = o; } }
}

constexpr int SC_CH = 32;
constexpr int SC_ARR = SC_CH * 64;
constexpr int SC_BUF = 6 * SC_ARR * 4;
__device__ __forceinline__ float dpp_sum16(float x) {
    x += __builtin_bit_cast(float, __builtin_amdgcn_update_dpp(0, __builtin_bit_cast(int, x), 0xB1, 0xF, 0xF, true));
    x += __builtin_bit_cast(float, __builtin_amdgcn_update_dpp(0, __builtin_bit_cast(int, x), 0x4E, 0xF, 0xF, true));
    x += __builtin_bit_cast(float, __builtin_amdgcn_update_dpp(0, __builtin_bit_cast(int, x), 0x141, 0xF, 0xF, true));
    x += __builtin_bit_cast(float, __builtin_amdgcn_update_dpp(0, __builtin_bit_cast(int, x), 0x140, 0xF, 0xF, true));
    return x;
}
struct ScanHold { u32x4 b[3]; f32x4 w; };
__device__ __forceinline__ void scan_issue(const Params& p, int tid, int row0, int h, int steps, ScanHold& H) {
    asm volatile("" : "+v"(tid));
#pragma unroll
    for (int j = 0; j < 3; ++j) { int pidx = tid + 512 * j; pidx = pidx < 1280 ? pidx : pidx - 256; const int arr = pidx >> 8, wi = pidx & 255; int i = wi >> 3; i = i < steps ? i : steps - 1;
        H.b[j] = *(const u32x4*)((const bf16*)(p.ws + WS_ACT) + (size_t)arr * (17u * 1048576u / 2u) + (size_t)(row0 + i) * RWD + h * 64 + (wi & 7) * 8); }
    { int i = tid >> 4; i = i < steps ? i : steps - 1; H.w = *(const f32x4*)((const float*)(p.ws + WS_WDEC) + (size_t)(row0 + i) * RWD + h * 64 + (tid & 15) * 4); }
}
__device__ __forceinline__ void scan_put(int tid, LAS float* buf, const ScanHold& H) {
    asm volatile("" : "+v"(tid));
#pragma unroll
    for (int j = 0; j < 3; ++j) { int pidx = tid + 512 * j; pidx = pidx < 1280 ? pidx : pidx - 256; const int arr = pidx >> 8, wi = pidx & 255; const u32x4 v = H.b[j];
        LAS f32x4* dst = (LAS f32x4*)(buf + arr * SC_ARR + (wi >> 3) * 64 + (wi & 7) * 8);
        dst[0] = (f32x4){bflo(v.x), bfhi(v.x), bflo(v.y), bfhi(v.y)}; dst[1] = (f32x4){bflo(v.z), bfhi(v.z), bflo(v[3]), bfhi(v[3])}; }
    *(LAS f32x4*)(buf + 5 * SC_ARR + (tid >> 4) * 64 + (tid & 15) * 4) = H.w;
}
struct ScanIn { f32x4 r, k, q, b, w; float v;
    __device__ __forceinline__ void load(const LAS float* bR, const LAS float* bV, int i) { const LAS float* bp = bR + i * 64;
        r = *(const LAS f32x4*)bp; k = *(const LAS f32x4*)(bp + SC_ARR); q = *(const LAS f32x4*)(bp + 3 * SC_ARR); b = *(const LAS f32x4*)(bp + 4 * SC_ARR); w = *(const LAS f32x4*)(bp + 5 * SC_ARR); v = bV[i * 64]; } };
__device__ __forceinline__ float scan_step(float (&S)[4], const ScanIn& x) {
    float pa = S[0] * x.q[0]; float pb = S[2] * x.q[2]; pa = __builtin_fmaf(S[1], x.q[1], pa); pb = __builtin_fmaf(S[3], x.q[3], pb);
    const float sa = -dpp_sum16(pa + pb); const float cv = x.v;
    S[0] = __builtin_fmaf(S[0], x.w[0], __builtin_fmaf(sa, x.b[0], cv * x.k[0])); S[1] = __builtin_fmaf(S[1], x.w[1], __builtin_fmaf(sa, x.b[1], cv * x.k[1]));
    S[2] = __builtin_fmaf(S[2], x.w[2], __builtin_fmaf(sa, x.b[2], cv * x.k[2])); S[3] = __builtin_fmaf(S[3], x.w[3], __builtin_fmaf(sa, x.b[3], cv * x.k[3]));
    float ya = S[0] * x.r[0]; float yb = S[2] * x.r[2]; ya = __builtin_fmaf(S[1], x.r[1], ya); yb = __builtin_fmaf(S[3], x.r[3], yb);
    return dpp_sum16(ya + yb);
}
__device__ __forceinline__ void rwkv_scan_unit(const Params& p, const Ctx& c, int s, int h, int hf) {
    const bool prompt = s < NB; const int row_base = prompt ? s * LP + PADR : MP + (s - NB) * SS; const int T = prompt ? TP : SS;
    const int nch = (T + SC_CH - 1) / SC_CH;
    LAS float* buf0 = (LAS float*)c.lds; LAS float* buf1 = (LAS float*)(c.lds + SC_BUF);
    const int lane = c.lane, ks = lane & 15, vrow = 32 * hf + 4 * c.wave + (lane >> 4);
    float S[4] = {0.f, 0.f, 0.f, 0.f};
    if (!prompt) { const f32x4 a = *(const f32x4*)(PIN(I_SWKV) + (((size_t)(s - NB) * RWH + h) * 64 + vrow) * 64 + ks * 4); S[0] = a[0]; S[1] = a[1]; S[2] = a[2]; S[3] = a[3]; }
    ScanHold H;
    scan_issue(p, c.tid, row_base, h, T < SC_CH ? T : SC_CH, H);
    __syncthreads();
    scan_put(c.tid, buf0, H);
    __syncthreads();
    float* yout = p.out;
    LAS float* ybuf = (LAS float*)(c.lds + 2 * SC_BUF);
    for (int cix = 0; cix < nch; ++cix) {
        LAS float* cur = (cix & 1) ? buf1 : buf0; LAS float* nxt = (cix & 1) ? buf0 : buf1; LAS float* yb = ybuf + (cix & 1) * (SC_CH * 32);
        const int t0 = cix * SC_CH; const int steps = (T - t0) < SC_CH ? (T - t0) : SC_CH;
        const bool more = cix + 1 < nch;
        if (more) { const int t1 = t0 + SC_CH; scan_issue(p, c.tid, row_base + t1, h, (T - t1) < SC_CH ? (T - t1) : SC_CH, H); }
        { const LAS float* bR = cur + ks * 4; const LAS float* bV = cur + 2 * SC_ARR + vrow; LAS float* yw = yb + (vrow & 31);
          ScanIn A, B, C, Dd; A.load(bR, bV, 0); B.load(bR, bV, 1); C.load(bR, bV, 2); Dd.load(bR, bV, 3);
          for (int i = 0; i < steps; i += 4) {
              const int n0 = (i + 4 < steps) ? i + 4 : i;
              const float y0 = scan_step(S, A); A.load(bR, bV, n0);
              yw[i * 32] = y0;
              const float y1 = scan_step(S, B); B.load(bR, bV, n0 + 1);
              yw[(i + 1) * 32] = y1;
              const float y2 = scan_step(S, C); C.load(bR, bV, n0 + 2);
              yw[(i + 2) * 32] = y2;
              const float y3 = scan_step(S, Dd); Dd.load(bR, bV, n0 + 3);
              yw[(i + 3) * 32] = y3;
          } }
        if (more) scan_put(c.tid, nxt, H);
        __syncthreads();
        if (c.tid < 256) { const int i = c.tid >> 3, c4 = (c.tid & 7) * 4; if (i < steps) *(f32x4*)(yout + (size_t)(row_base + t0 + i) * RWD + h * 64 + 32 * hf + c4) = *(const LAS f32x4*)(yb + i * 32 + c4); }
    }
    { float* so = p.out + (prompt ? O_PWKV + (((size_t)s * RWH + h) * 64 + vrow) * 64 : O_SWKV + (((size_t)(s - NB) * RWH + h) * 64 + vrow) * 64) + ks * 4;
      *(f32x4*)so = (f32x4){S[0], S[1], S[2], S[3]}; }
}

__device__ __forceinline__ void phase_bcconv(const Params& p, const Ctx& c) {
    const bf16* XBC = (const bf16*)(p.ws + WS_XBC); bf16* BCC = (bf16*)(p.ws + WS_YRW);
    const int c8 = (c.tid & 127) * 8, ch = 2048 + c8; const float* convw = PIN(I_CONVW); const float* convb = PIN(I_CONVB);
    f32x4 wa[4], wb[4];
#pragma unroll
    for (int k = 0; k < 4; ++k) { wa[k] = *(const f32x4*)(convw + k * CONVD + ch); wb[k] = *(const f32x4*)(convw + k * CONVD + ch + 4); }
    const f32x4 ba = *(const f32x4*)(convb + ch), bb = *(const f32x4*)(convb + ch + 4);
    for (int row = blockIdx.x * 4 + (c.tid >> 7); row < MROWS; row += gridDim.x * 4) {
        u32x4 o = (u32x4){0u, 0u, 0u, 0u};
        if (!row_is_pad(row)) {
            const bool prompt = row < MP; const int q = prompt ? (row % LP) - PADR : (row - MP) & 15;
            f32x4 a0 = ba, a1 = bb;
#pragma unroll
            for (int k = 0; k < 4; ++k) { const int qq = q - 3 + k; f32x4 v0 = (f32x4){0.f, 0.f, 0.f, 0.f}, v1 = v0;
                if (qq >= 0) { const u32x4 w = *(const u32x4*)(XBC + (size_t)(row - 3 + k) * XBC_LD + ch); v0 = (f32x4){bflo(w.x), bfhi(w.x), bflo(w.y), bfhi(w.y)}; v1 = (f32x4){bflo(w.z), bfhi(w.z), bflo(w[3]), bfhi(w[3])}; }
                else if (!prompt) { const float* hs = PIN(I_SCONV) + ((size_t)((row - MP) >> 4) * 3 + (3 + qq)) * CONVD + ch; v0 = *(const f32x4*)hs; v1 = *(const f32x4*)(hs + 4);
                    v0 = (f32x4){bf2f((bf16)(pk2(v0[0], 0.f) & 0xffffu)), bf2f((bf16)(pk2(v0[1], 0.f) & 0xffffu)), bf2f((bf16)(pk2(v0[2], 0.f) & 0xffffu)), bf2f((bf16)(pk2(v0[3], 0.f) & 0xffffu))};
                    v1 = (f32x4){bf2f((bf16)(pk2(v1[0], 0.f) & 0xffffu)), bf2f((bf16)(pk2(v1[1], 0.f) & 0xffffu)), bf2f((bf16)(pk2(v1[2], 0.f) & 0xffffu)), bf2f((bf16)(pk2(v1[3], 0.f) & 0xffffu))}; }
                a0 += v0 * wa[k]; a1 += v1 * wb[k]; }
            o.x = pk2(silu_(a0[0]), silu_(a0[1])); o.y = pk2(silu_(a0[2]), silu_(a0[3])); o.z = pk2(silu_(a1[0]), silu_(a1[1])); o[3] = pk2(silu_(a1[2]), silu_(a1[3]));
        }
        *(u32x4*)(BCC + (size_t)row * 1024 + c8) = o;
    }
}
constexpr int SD_RAW = 0, SD_HB = 44032, SD_BT = 61440, SD_XT = 79872, SD_XD = 89088, SD_XC = 98304, SD_YT = 107520, SD_G = 124928, SD_DT = 134144, SD_ACS = 134400, SD_WT = 134656;
constexpr int RAW_LD = 328, CM_LD = 136, BT_LD = 72, XT_LD = 72, YT_LD = 68;
__device__ __forceinline__ f32x4 mfma16(bf16x8 a, bf16x8 b, f32x4 c) { return __builtin_amdgcn_mfma_f32_16x16x32_bf16(a, b, c, 0, 0, 0); }
__device__ __forceinline__ void ssd_fetch(const Params& p, bool prompt, int s, int row_base, int cix, int hd, int g, int tid, u32x4 (&pre)[6], u32x4& zpre, float& dtraw) {
    const bf16* XBC = (const bf16*)(p.ws + WS_XBC); const bf16* BCC = (const bf16*)(p.ws + WS_YRW);
    asm volatile("" : "+v"(tid));
    if (prompt) {
#pragma unroll
        for (int i = 0; i < 6; ++i) { int idx = tid + 512 * i; idx = idx < 67 * 40 ? idx : 67 * 40 - 1; const int rr = idx / 40, cc = idx - rr * 40; const int q = cix * 64 + rr - 3;
            const bool ok = q >= PADR; const size_t row = (size_t)(row_base + (ok ? q : PADR));
            const bf16* src = cc < 8 ? XBC + row * XBC_LD + hd * 64 + cc * 8 : BCC + row * 1024 + (cc < 24 ? g * 128 + (cc - 8) * 8 : 512 + g * 128 + (cc - 24) * 8);
            const u32x4 v = *(const u32x4*)src; pre[i] = ok ? v : (u32x4){0u, 0u, 0u, 0u}; }
        { const int t = tid >> 3, c8 = (tid & 7) * 8, q = cix * 64 + t; zpre = *(const u32x4*)((const bf16*)(p.ws + WS_Z) + (size_t)(row_base + q) * Z_LD + hd * 64 + c8); }
        { const int q = cix * 64 + (tid & 63); dtraw = bf2f(((const bf16*)(p.ws + WS_PRW))[(size_t)(row_base + q) * PRW_LD + SHC + hd]); }
    } else {
        const float* hsb = PIN(I_SCONV) + (size_t)(s - NB) * 3 * CONVD;
#pragma unroll
        for (int i = 0; i < 6; ++i) { int idx = tid + 512 * i; idx = idx < 67 * 40 ? idx : 67 * 40 - 1; const int rr = idx / 40, cc = idx - rr * 40; const int q = rr - 3;
            const bool okm = q >= 0 && q < SS, okh = q < 0 && cc < 8; const size_t row = (size_t)(row_base + (okm ? q : 0));
            const bf16* src = cc < 8 ? XBC + row * XBC_LD + hd * 64 + cc * 8 : BCC + row * 1024 + (cc < 24 ? g * 128 + (cc - 8) * 8 : 512 + g * 128 + (cc - 24) * 8);
            const u32x4 vm = *(const u32x4*)src;
            const float* hs = hsb + (size_t)(okh ? 3 + q : 0) * CONVD + hd * 64 + (cc < 8 ? cc : 0) * 8; const f32x4 a = *(const f32x4*)hs, b = *(const f32x4*)(hs + 4);
            u32x4 vh; vh.x = pk2(a[0], a[1]); vh.y = pk2(a[2], a[3]); vh.z = pk2(b[0], b[1]); vh[3] = pk2(b[2], b[3]);
            pre[i] = okm ? vm : (okh ? vh : (u32x4){0u, 0u, 0u, 0u}); }
        { const int t = tid >> 3, c8 = (tid & 7) * 8; const bool ok = t < SS; const u32x4 z = *(const u32x4*)((const bf16*)(p.ws + WS_Z) + (size_t)(row_base + (ok ? t : 0)) * Z_LD + hd * 64 + c8); zpre = ok ? z : (u32x4){0u, 0u, 0u, 0u}; }
        { const int q = tid & 63; const bool ok = q < SS; const float d = bf2f(((const bf16*)(p.ws + WS_PRW))[(size_t)(row_base + (ok ? q : 0)) * PRW_LD + SHC + hd]); dtraw = ok ? d : 0.f; }
    }
}
__device__ __forceinline__ void ssd_unit(const Params& p, const Ctx& c, int s, int hd, bool dry = false) {
    const bool prompt = s < NB; const int row_base = prompt ? s * LP : MP + (s - NB) * SS; const int nchunks = prompt ? LP / 64 : 1; const int g = hd >> 3;
    const int tid = c.tid, lane = c.lane, w = c.wave, fr = lane & 15, fq = lane >> 4;
    LAS bf16* RAW = (LAS bf16*)(c.lds + SD_RAW); LAS bf16* Gm = (LAS bf16*)(c.lds + SD_G); LAS bf16* HB = (LAS bf16*)(c.lds + SD_HB);
    LAS bf16* BT = (LAS bf16*)(c.lds + SD_BT); LAS bf16* XT = (LAS bf16*)(c.lds + SD_XT); LAS bf16* XD = (LAS bf16*)(c.lds + SD_XD); LAS bf16* XC = (LAS bf16*)(c.lds + SD_XC);
    LAS float* YT = (LAS float*)(c.lds + SD_YT); LAS float* DT = (LAS float*)(c.lds + SD_DT); LAS float* ACS = (LAS float*)(c.lds + SD_ACS); LAS float* WT = (LAS float*)(c.lds + SD_WT);
    const int bpair = tid & 63, xpair = tid & 31;
    __syncthreads();
    if (tid < 64) { const float* convw = PIN(I_CONVW); const float* convb = PIN(I_CONVB); const int ch = hd * 64 + tid;
        *(LAS f32x4*)(WT + tid * 8) = (f32x4){convw[ch], convw[CONVD + ch], convw[2 * CONVD + ch], convw[3 * CONVD + ch]}; WT[tid * 8 + 4] = convb[ch]; }
    const float dtb = PIN(I_DTB)[hd], aneg = -__expf(PIN(I_ALOG)[hd]), dsk = PIN(I_DSKIP)[hd];
    const int hpt = w & 3, hnt0 = (w >> 2) * 4;
    f32x4 hacc[4];
#pragma unroll
    for (int j = 0; j < 4; ++j) hacc[j] = (f32x4){0.f, 0.f, 0.f, 0.f};
    if (!prompt) { const float* st = PIN(I_SSSM) + ((size_t)(s - NB) * SSMH + hd) * 64 * 128;
#pragma unroll
        for (int j = 0; j < 4; ++j)
#pragma unroll
            for (int r = 0; r < 4; ++r) hacc[j][r] = st[(size_t)(hpt * 16 + fq * 4 + r) * 128 + (hnt0 + j) * 16 + fr]; }
    const int yit = w >> 1, ypt0 = (w & 1) * 2;
    u32x4 pre[6], zpre, zcur = (u32x4){0u, 0u, 0u, 0u}; float dtraw;
    ssd_fetch(p, prompt, s, row_base, 0, hd, g, tid, pre, zpre, dtraw);
    for (int cix = 0; cix <= nchunks; ++cix) {
        if (cix < nchunks) {
            { int tl = tid; asm volatile("" : "+v"(tl));
#pragma unroll
              for (int i = 0; i < 6; ++i) { const int idx = tl + 512 * i; if (idx < 67 * 40) { const int rr = idx / 40, cc = idx - rr * 40; *(LAS u32x4*)(RAW + rr * RAW_LD + cc * 8) = pre[i]; } } }
            if (w == 0) { const int q = cix * 64 + lane; const bool valid = prompt ? (q >= PADR) : (q < SS);
                const float dtv = valid ? softplus_(dtraw + dtb) : 0.f; float a = dtv * aneg;
#pragma unroll
                for (int o = 1; o < 64; o <<= 1) { const float t = __shfl_up(a, o); if (lane >= o) a += t; }
                DT[lane] = dtv; ACS[lane] = a; }
#pragma unroll
            for (int j = 0; j < 4; ++j)
#pragma unroll
                for (int r = 0; r < 4; ++r) HB[(hpt * 16 + fq * 4 + r) * CM_LD + (hnt0 + j) * 16 + fr] = (bf16)(pk2(hacc[j][r], 0.f) & 0xffffu);
        }
        if (cix > 0) { const int t = tid >> 3, c8 = (tid & 7) * 8, q = (cix - 1) * 64 + t;
          if ((prompt || q < SS) && !dry) { const f32x4 y0 = *(const LAS f32x4*)(YT + t * YT_LD + c8), y1 = *(const LAS f32x4*)(YT + t * YT_LD + c8 + 4); const u32x4 xc = *(const LAS u32x4*)(XC + t * XT_LD + c8);
              u32x4 o; o.x = pk2((y0[0] + bflo(xc.x) * dsk) * bflo(zcur.x), (y0[1] + bfhi(xc.x) * dsk) * bfhi(zcur.x)); o.y = pk2((y0[2] + bflo(xc.y) * dsk) * bflo(zcur.y), (y0[3] + bfhi(xc.y) * dsk) * bfhi(zcur.y));
              o.z = pk2((y1[0] + bflo(xc.z) * dsk) * bflo(zcur.z), (y1[1] + bfhi(xc.z) * dsk) * bfhi(zcur.z)); o[3] = pk2((y1[2] + bflo(xc[3]) * dsk) * bflo(zcur[3]), (y1[3] + bfhi(xc[3]) * dsk) * bfhi(zcur[3]));
              *(u32x4*)((bf16*)(p.ws + WS_Z) + (size_t)(row_base + q) * Z_LD + hd * 64 + c8) = o; } }
        if (cix == nchunks) break;
        zcur = zpre;
        if (cix + 1 < nchunks) ssd_fetch(p, prompt, s, row_base, cix + 1, hd, g, tid, pre, zpre, dtraw);
        __syncthreads();
        const float acs_end = ACS[63];
        { const int t0 = 8 * w;
          unsigned t0w[4], t1w[4];
#pragma unroll
          for (int tt = 0; tt < 8; ++tt) { const unsigned bp = *(const LAS unsigned*)(RAW + (t0 + tt + 3) * RAW_LD + 64 + 2 * bpair);
              if (tt & 1) { t0w[tt >> 1] |= bp << 16; t1w[tt >> 1] |= bp & 0xffff0000u; } else { t0w[tt >> 1] = bp & 0xffffu; t1w[tt >> 1] = bp >> 16; } }
          *(LAS u32x4*)(BT + (2 * bpair) * BT_LD + t0) = (u32x4){t0w[0], t0w[1], t0w[2], t0w[3]}; *(LAS u32x4*)(BT + (2 * bpair + 1) * BT_LD + t0) = (u32x4){t1w[0], t1w[1], t1w[2], t1w[3]}; }
        { const int t0 = 4 * (tid >> 5);
          unsigned rx[7];
#pragma unroll
          for (int j = 0; j < 7; ++j) rx[j] = *(const LAS unsigned*)(RAW + (t0 + j) * RAW_LD + 2 * xpair);
          const f32x4 w0 = *(const LAS f32x4*)(WT + (2 * xpair) * 8), w1 = *(const LAS f32x4*)(WT + (2 * xpair + 1) * 8); const float bi0 = WT[(2 * xpair) * 8 + 4], bi1 = WT[(2 * xpair + 1) * 8 + 4];
          const f32x4 dta = *(const LAS f32x4*)(DT + t0), aca = *(const LAS f32x4*)(ACS + t0);
          unsigned xt0[2], xt1[2], xd0[2], xd1[2];
#pragma unroll
          for (int tt = 0; tt < 4; ++tt) { const int q = cix * 64 + t0 + tt; const bool valid = prompt ? (q >= PADR) : (q < SS);
              float x0 = bi0, x1 = bi1;
#pragma unroll
              for (int k = 0; k < 4; ++k) { x0 += bflo(rx[tt + k]) * w0[k]; x1 += bfhi(rx[tt + k]) * w1[k]; }
              x0 = valid ? silu_(x0) : 0.f; x1 = valid ? silu_(x1) : 0.f;
              *(LAS unsigned*)(XC + (t0 + tt) * XT_LD + 2 * xpair) = pk2(x0, x1);
              const float dtt = dta[tt], dec = __expf(acs_end - aca[tt]);
              const unsigned xp = pk2(x0 * dtt, x1 * dtt), xq = pk2(x0 * dtt * dec, x1 * dtt * dec);
              if (tt & 1) { xt0[tt >> 1] |= xp << 16; xt1[tt >> 1] |= xp & 0xffff0000u; xd0[tt >> 1] |= xq << 16; xd1[tt >> 1] |= xq & 0xffff0000u; }
              else { xt0[tt >> 1] = xp & 0xffffu; xt1[tt >> 1] = xp >> 16; xd0[tt >> 1] = xq & 0xffffu; xd1[tt >> 1] = xq >> 16; } }
          *(LAS u32x2*)(XT + (2 * xpair) * XT_LD + t0) = (u32x2){xt0[0], xt0[1]}; *(LAS u32x2*)(XT + (2 * xpair + 1) * XT_LD + t0) = (u32x2){xt1[0], xt1[1]};
          *(LAS u32x2*)(XD + (2 * xpair) * XT_LD + t0) = (u32x2){xd0[0], xd0[1]}; *(LAS u32x2*)(XD + (2 * xpair + 1) * XT_LD + t0) = (u32x2){xd1[0], xd1[1]}; }
        __syncthreads();
        f32x4 yacc[2];
        { f32x4 cbacc[2] = {(f32x4){0.f, 0.f, 0.f, 0.f}, (f32x4){0.f, 0.f, 0.f, 0.f}}; yacc[0] = cbacc[0]; yacc[1] = cbacc[0];
#pragma unroll
          for (int kk = 0; kk < 4; ++kk) { const bf16x8 af = *(const LAS bf16x8*)(RAW + (yit * 16 + fr + 3) * RAW_LD + 192 + kk * 32 + fq * 8);
#pragma unroll
              for (int j = 0; j < 2; ++j) { const bf16x8 bfm = *(const LAS bf16x8*)(RAW + ((ypt0 + j) * 16 + fr + 3) * RAW_LD + 64 + kk * 32 + fq * 8); cbacc[j] = mfma16(af, bfm, cbacc[j]);
                  const bf16x8 hf = *(const LAS bf16x8*)(HB + ((ypt0 + j) * 16 + fr) * CM_LD + kk * 32 + fq * 8); yacc[j] = mfma16(af, hf, yacc[j]); } }
#pragma unroll
          for (int j = 0; j < 2; ++j)
#pragma unroll
              for (int r = 0; r < 4; ++r) { const int i = yit * 16 + fq * 4 + r, jj = (ypt0 + j) * 16 + fr; const float ai = ACS[i];
                  const float gv = (jj <= i) ? cbacc[j][r] * __expf(ai - ACS[jj]) : 0.f; Gm[i * XT_LD + jj] = (bf16)(pk2(gv, 0.f) & 0xffffu);
                  yacc[j][r] *= __expf(ai); } }
        { const float cd = __expf(acs_end);
#pragma unroll
          for (int j = 0; j < 4; ++j) hacc[j] = hacc[j] * cd;
#pragma unroll
          for (int kk = 0; kk < 2; ++kk) { const bf16x8 af = *(const LAS bf16x8*)(XD + (hpt * 16 + fr) * XT_LD + kk * 32 + fq * 8);
#pragma unroll
              for (int j = 0; j < 4; ++j) { const bf16x8 bfm = *(const LAS bf16x8*)(BT + ((hnt0 + j) * 16 + fr) * BT_LD + kk * 32 + fq * 8); hacc[j] = mfma16(af, bfm, hacc[j]); } } }
        __syncthreads();
#pragma unroll
        for (int kk = 0; kk < 2; ++kk) { const bf16x8 af = *(const LAS bf16x8*)(Gm + (yit * 16 + fr) * XT_LD + kk * 32 + fq * 8);
#pragma unroll
            for (int j = 0; j < 2; ++j) { const bf16x8 bfm = *(const LAS bf16x8*)(XT + ((ypt0 + j) * 16 + fr) * XT_LD + kk * 32 + fq * 8); yacc[j] = mfma16(af, bfm, yacc[j]); } }
#pragma unroll
        for (int j = 0; j < 2; ++j)
#pragma unroll
            for (int r = 0; r < 4; ++r) YT[(yit * 16 + fq * 4 + r) * YT_LD + (ypt0 + j) * 16 + fr] = yacc[j][r];
        __syncthreads();
    }
    if (!dry) { float* so = p.out + (prompt ? O_PSSM + ((size_t)s * SSMH + hd) * 64 * 128 : O_SSSM + ((size_t)(s - NB) * SSMH + hd) * 64 * 128);
#pragma unroll
      for (int j = 0; j < 4; ++j)
#pragma unroll
          for (int r = 0; r < 4; ++r) so[(size_t)(hpt * 16 + fq * 4 + r) * 128 + (hnt0 + j) * 16 + fr] = hacc[j][r]; }
}
__device__ __forceinline__ void mixer_unit(const Params& p, const Ctx& c, int u) {
    int kind, s, h, hf = 0;
    if (u < 128) { kind = 0; s = (u >> 1) / RWH; h = (u >> 1) % RWH; hf = u & 1; }
    else if (u < 256) { kind = 1; s = (u - 128) / SSMH; h = (u - 128) % SSMH; }
    else if (u < 768) { const int v = u - 256; kind = 0; s = NB + (v >> 1) / RWH; h = (v >> 1) % RWH; hf = v & 1; }
    else { const int v = u - 768; kind = 1; s = NB + v / SSMH; h = v % SSMH; }
    if (kind == 0) rwkv_scan_unit(p, c, s, h, hf); else ssd_unit(p, c, s, h);
}

__device__ __forceinline__ bool setup_gemm(const Params& p, int ph, pg8::Gemm& g, pg8::EpiGen& E) {
    unsigned char* ws = p.ws;
    E.o0 = nullptr; E.o1 = nullptr; E.o2 = nullptr; E.i0 = nullptr; E.i1 = nullptr; E.f0 = nullptr; E.f1 = nullptr; E.alpha = 0.f; E.scale = 0.f; E.mode = 0; E.PERM = false; E.nseg = 1; E.pn0 = 0; E.midt = -1;
    switch (ph) {
    case 1: case 14: g.A = (const bf16*)(ws + WS_XB); g.Bt = (const bf16*)(ws + WS_GUT); g.M = MROWS; g.N = 2 * FF; g.K = D; E.mode = pg8::EM_SWIGLU; E.PERM = true; E.o0 = ws + WS_ACT; return true;
    case 2: case 15: g.A = (const bf16*)(ws + WS_ACT); g.Bt = (const bf16*)(ws + WS_DNT); g.M = MROWS; g.N = D; g.K = FF; E.mode = pg8::EM_RESID; E.o0 = ws + WS_PRE; E.i0 = ws + WS_XB; E.alpha = ALPHA; E.scale = 0.5f; return true;
    case 4: g.A = (const bf16*)(ws + WS_XB); g.Bt = (const bf16*)(ws + WS_WINT); g.M = MROWS; g.N = 34 * 256; g.K = D; E.mode = pg8::EM_WIN; E.PERM = true; E.o0 = ws + WS_PRW; E.o1 = ws + WS_Z; E.o2 = ws + WS_XBC; E.i1 = ws + WS_GATE; E.f0 = PIN(I_BGATE); return true;
    case 8: g.A = (const bf16*)(ws + WS_XB); g.Bt = (const bf16*)(ws + WS_WINT) + (size_t)34 * 256 * D; g.M = GATE_PM_HELPED * 256; g.N = 16 * 256; g.K = D; E.mode = pg8::EM_WIN; E.PERM = true; E.pn0 = 34; E.i1 = ws + WS_GATE; E.f0 = PIN(I_BGATE); return true;
    case 6: g.A = (const bf16*)(ws + WS_ALORA); g.Bt = (const bf16*)(ws + WS_LORAT); g.M = MROWS; g.N = 3072; g.K = 512; E.mode = pg8::EM_LORA; E.o0 = ws + WS_WDEC; E.o1 = ws + WS_BB; E.o2 = (unsigned char*)p.out + OUT_GBUF; E.f0 = PIN(I_W0); E.f1 = PIN(I_A0); return true;
    case 10: g.A = (const bf16*)(ws + WS_ACAT); g.Bt = (const bf16*)(ws + WS_BCAT); g.M = MROWS; g.N = D; g.K = 3072; E.mode = pg8::EM_MF; E.PERM = true; E.midt = 16; E.o0 = (unsigned char*)p.out; E.i0 = ws + WS_GATE; return true;
    case 12: g.A = (const bf16*)p.out; g.Bt = (const bf16*)(ws + WS_WOT); g.M = MROWS; g.N = D; g.K = D; E.mode = pg8::EM_RESID; E.o0 = ws + WS_PRE; E.i0 = ws + WS_XB; E.alpha = ALPHA; E.scale = 1.0f; return true;
    default: return false;
    }
}

#ifndef PG8_SP2V
#define PG8_SP2V true
#endif
#ifndef MK_XCD_BARRIER
#define MK_XCD_BARRIER 1
#endif
#define XB_TMO      128
#define XB_XCNT(j)  (256  + 64 * (j))
#define XB_XSUB(j)  (1280 + 64 * (j))
#define XB_XGEN(j)  (2304 + 64 * (j))
#define XB_TOP      3328
#define XB_TOPGEN   3392
#define XCD_BAR_WORDS 3456
#define XB_SPIN_CAP (1u << 18)

__device__ __forceinline__ unsigned xb_ld(unsigned* p)              { return __hip_atomic_load(p, __ATOMIC_RELAXED, __HIP_MEMORY_SCOPE_AGENT); }
__device__ __forceinline__ unsigned xb_add(unsigned* p, unsigned v) { return __hip_atomic_fetch_add(p, v, __ATOMIC_RELAXED, __HIP_MEMORY_SCOPE_AGENT); }
__device__ __forceinline__ unsigned xb_xcc_id() { return (unsigned)__builtin_amdgcn_s_getreg((3 << 11) | 20) & 0xFu; }
#define XB_SPIN(cond, bar) do { unsigned _sp = 0; while (cond) { __builtin_amdgcn_s_sleep(1); \
    if ((++_sp & 255u) == 0u) { if (xb_ld(&(bar)[XB_TMO])) break; if (_sp > XB_SPIN_CAP) { atomicAdd(&(bar)[XB_TMO], 1u); break; } } } } while (0)

struct XcdBarrier {
    unsigned* bar; unsigned x;
    volatile LAS unsigned* st;
};

__device__ __forceinline__ XcdBarrier xcd_barrier_post(unsigned* bar, volatile LAS unsigned* st) {
    XcdBarrier b; b.bar = bar; b.x = xb_xcc_id(); b.st = st;
    if (threadIdx.x == 0) (void)xb_add(&bar[XB_XCNT(b.x)], 1u);
    return b;
}
__device__ __forceinline__ void xcd_barrier_complete(unsigned* bar, unsigned x, unsigned& nloc, unsigned& nx) {
    const unsigned G = gridDim.x * gridDim.y * gridDim.z;
    unsigned sum, cnt, mine, sp = 0u;
    for (;;) {
        sum = 0u; cnt = 0u; mine = 0u;
#pragma unroll
        for (unsigned j = 0; j < 16; ++j) { const unsigned c = xb_ld(&bar[XB_XCNT(j)]); sum += c; cnt += (c > 0u) ? 1u : 0u; mine = (j == x) ? c : mine; }
        if (sum == G) break;
        __builtin_amdgcn_s_sleep(1);
        if ((++sp & 255u) == 0u) { if (xb_ld(&bar[XB_TMO])) break; if (sp > XB_SPIN_CAP) { atomicAdd(&bar[XB_TMO], 1u); break; } }
    }
    nloc = mine > 0u ? mine : 1u; nx = cnt > 0u ? cnt : 1u;
}

__device__ __forceinline__ void xcd_barrier(const XcdBarrier& b) {
    asm volatile("s_waitcnt vmcnt(0)" ::: "memory");
    __syncthreads();
    if (threadIdx.x == 0) {
        unsigned* bar = b.bar;
        __builtin_amdgcn_s_waitcnt(0);
        unsigned nloc = b.st[0], nx = b.st[1];
        if (nloc == 0u) { xcd_barrier_complete(bar, b.x, nloc, nx); b.st[0] = nloc; b.st[1] = nx; }
        const unsigned old = xb_add(&bar[XB_XSUB(b.x)], 1u);
        const unsigned gen = old / nloc;
        if (old + 1u == (gen + 1u) * nloc) {
            __builtin_amdgcn_fence(__ATOMIC_RELEASE, "agent");
            asm volatile("s_waitcnt vmcnt(0)" ::: "memory");
            const unsigned og = xb_add(&bar[XB_TOP], 1u);
            const unsigned tg = og / nx;
            if (og + 1u == (tg + 1u) * nx) xb_add(&bar[XB_TOPGEN], 1u);
            else XB_SPIN(xb_ld(&bar[XB_TOPGEN]) == tg, bar);
            __builtin_amdgcn_fence(__ATOMIC_ACQUIRE, "agent");
            xb_add(&bar[XB_XGEN(b.x)], 1u);
            asm volatile("s_waitcnt vmcnt(0)" ::: "memory");
        } else {
            XB_SPIN(xb_ld(&bar[XB_XGEN(b.x)]) == gen, bar);
            __builtin_amdgcn_fence(__ATOMIC_ACQUIRE, "agent");
            asm volatile("s_waitcnt vmcnt(0)" ::: "memory");
        }
    }
    __syncthreads();
}

template <int PH> __device__ __forceinline__ void run_gemm(const Params& p, const Ctx& c) {
    pg8::Gemm g; pg8::EpiGen E; setup_gemm(p, PH, g, E);
    pg8::StaticOrder S; S.init(g.M, g.N, g.K, (int)gridDim.x, (int)blockIdx.x, PH == 2 || PH == 12 || PH == 15);
    if constexpr (PH == 10) { if (4 * (S.nwg % S.G) <= S.G) S.qtail = S.nwg % S.G; }
    if constexpr (PH == 10) S.split2 = 16;
    if constexpr (PH == 4) { S.ext_n = (MROWS / 256 - GATE_PM_HELPED) * 16; S.ext_pm0 = GATE_PM_HELPED; S.ext_pn0 = 34; S.ext_w = 16; }
    E.nseg = S.nseg; E.o1 = (PH == 2 || PH == 12 || PH == 15) ? (void*)(p.ws + WS_SLAB) : E.o1;
    pg8::gemm_phase<pg8::EpiGen, pg8::StaticOrder, true, PG8_SP2V>(c.lds, g, S, E);
}
__device__ __forceinline__ void ffn2_weights_slice(const Params& p, const Ctx& c, int lo, int hi, int first) {
    if ((int)blockIdx.x < first) return;
    __syncthreads();
    const int wid = ((int)blockIdx.x - first) * 8 + c.wave, nw = ((int)gridDim.x - first) * 8;
    if (lo < 5632) transpose_w(PIN(I_GU2), D, 2 * FF, (bf16*)(p.ws + WS_GUT), 2 * FF, MAP_GU, c, lo, hi < 5632 ? hi : 5632, wid, nw);
    if (hi > 5632) transpose_w(PIN(I_DN2), FF, D, (bf16*)(p.ws + WS_DNT), D, MAP_ID, c, (lo > 5632 ? lo : 5632) - 5632, hi - 5632, wid, nw);
}
__device__ __forceinline__ void phase_mixers(const Params& p, const Ctx& c) {
    const int G = (int)gridDim.x, b = (int)blockIdx.x;
    int u0, ustep, uend, Gh, ch; bool helper;
    if (G == 256) { Gh = 128; ch = b - 128; helper = b >= 128;
        if (b < 128) { u0 = b; ustep = 128; uend = 768; }
        else { u0 = b; ustep = 128; uend = 1280; } }
    else { Gh = G; ch = b; helper = true; u0 = b; ustep = G; uend = 1280; }
    for (int u = u0; u < uend; u += ustep) { if (G == 256 && (b < 128 ? (u >= 128 && u < 256) : (u >= 256 && u < 768))) continue; mixer_unit(p, c, u); }
    if (helper) { __syncthreads();
        pg8::Gemm g; pg8::EpiGen E; setup_gemm(p, 8, g, E);
        pg8::StaticOrder S; S.init(g.M, g.N, g.K, Gh, ch); if (2 * (S.nwg % S.G) <= S.G) S.htail = S.nwg % S.G;
        pg8::gemm_phase<pg8::EpiGen, pg8::StaticOrder, true, PG8_SP2V>(c.lds, g, S, E); }
}
__global__ void __launch_bounds__(512, 2) __attribute__((target("no-packed-fp32-ops"))) mega_fwd(Params p) {
    extern __shared__ __attribute__((aligned(16))) unsigned char lds_raw[];
    const int lo = p.ph_lo, hi = p.ph_hi;
#define MKCTX Ctx c; { int t_ = threadIdx.x; asm volatile("" : "+v"(t_)); c.tid = t_; c.lane = t_ & 63; c.wave = __builtin_amdgcn_readfirstlane(t_ >> 6); c.gw = blockIdx.x * 8 + c.wave; c.ngw = gridDim.x * 8; c.lds = (LAS unsigned char*)lds_raw; }
#define IN(k) (lo <= (k) && (k) < hi)
#if MK_XCD_BARRIER
    { volatile LAS unsigned* st = (volatile LAS unsigned*)((LAS unsigned char*)lds_raw + LDS_BYTES - 64); if (threadIdx.x < 2) st[threadIdx.x] = 0u; __syncthreads(); }
    const XcdBarrier xbar = xcd_barrier_post((unsigned*)p.ws, (volatile LAS unsigned*)((LAS unsigned char*)lds_raw + LDS_BYTES - 64));
#define SEAM(k) do { if (lo <= (k) && (k) + 1 < hi) { if ((k) == 0) cg::this_grid().sync(); else xcd_barrier(xbar); } } while (0)
#else
#define SEAM(k) do { if (lo <= (k) && (k) + 1 < hi) cg::this_grid().sync(); } while (0)
#endif
#ifndef PROBE_DOUBLE
#define PROBE_DOUBLE 0
#endif
#ifdef PROBE_TIME_PHASE
    unsigned long long pt0_ = 0, pt1_ = 0;
#define PT_A(k) if ((k) == PROBE_TIME_PHASE) pt0_ = __builtin_amdgcn_s_memrealtime();
#define PT_B(k) if ((k) == PROBE_TIME_PHASE) pt1_ = __builtin_amdgcn_s_memrealtime();
#else
#define PT_A(k)
#define PT_B(k)
#endif
#ifdef PROBE_OWN_WORK
#define PT_END(k) PT_B(k) SEAM(k);
#else
#define PT_END(k) SEAM(k); PT_B(k)
#endif
#define PH(k, ...) do { PT_A(k) if (IN(k)) { { MKCTX __VA_ARGS__ } if (((PROBE_DOUBLE >> (k)) & 1) != 0) { cg::this_grid().sync(); { MKCTX __VA_ARGS__ } } } PT_END(k) } while (0)
#ifdef PROBE_P0_SEG
    { MKCTX unsigned long long q0_ = 0, q1_ = 0;
#define P0SEG(k, ...) do { if ((k) == PROBE_P0_SEG) q0_ = __builtin_amdgcn_s_memrealtime(); __VA_ARGS__ cg::this_grid().sync(); if ((k) == PROBE_P0_SEG) q1_ = __builtin_amdgcn_s_memrealtime(); } while (0)
      P0SEG(0, phase_convert_x(p, c););
      P0SEG(1, transpose_w(PIN(I_GU1), D, 2 * FF, (bf16*)(p.ws + WS_GUT), 2 * FF, MAP_GU, c););
      P0SEG(2, transpose_w(PIN(I_DN1), FF, D, (bf16*)(p.ws + WS_DNT), D, MAP_ID, c););
      P0SEG(3, transpose_w(PIN(I_RWO), RWD, D, (bf16*)(p.ws + WS_BCAT), D, MAP_ID, c, 0, 1 << 30, -1, 0, 3072); transpose_w(PIN(I_SSMO), D, D, (bf16*)(p.ws + WS_BCAT) + 1024, D, MAP_ID, c, 0, 1 << 30, -1, 0, 3072); transpose_w(PIN(I_WO), D, D, (bf16*)(p.ws + WS_WOT), D, MAP_ID, c););
      P0SEG(4, build_lorat(p, c););
      pt0_ = q0_; pt1_ = q1_; }
#else
    PH(0, phase_convert_x(p, c);
        transpose_w(PIN(I_GU1), D, 2 * FF, (bf16*)(p.ws + WS_GUT), 2 * FF, MAP_GU, c);
        transpose_w(PIN(I_DN1), FF, D, (bf16*)(p.ws + WS_DNT), D, MAP_ID, c);
        );
#endif
    PH(1, run_gemm<1>(p, c););
    PH(2, run_gemm<2>(p, c););
    PH(3, phase_ln<false>(p, c, PIN(I_LN1G), PIN(I_LN1B), FF); transpose_w(PIN(I_WIN), D, 12768, (bf16*)(p.ws + WS_WINT), NINP, MAP_WIN, c););
    PH(4, run_gemm<4>(p, c););
    PH(5, phase_prep1(p, c); build_lorat(p, c););
    PH(6, run_gemm<6>(p, c););
    PH(7, phase_prep2(p, c); phase_bcconv(p, c););
    PH(8, phase_mixers(p, c););
    PH(9, phase_post(p, c); __syncthreads(); transpose_w(PIN(I_RWO), RWD, D, (bf16*)(p.ws + WS_BCAT), D, MAP_ID, c, 0, 1 << 30, -1, 0, 3072); transpose_w(PIN(I_SSMO), D, D, (bf16*)(p.ws + WS_BCAT) + 1024, D, MAP_ID, c, 0, 1 << 30, -1, 0, 3072); transpose_w(PIN(I_WO), D, D, (bf16*)(p.ws + WS_WOT), D, MAP_ID, c););
    PH(10, run_gemm<10>(p, c); ffn2_weights_slice(p, c, 0, 4200, 64););

    PH(12, run_gemm<12>(p, c); ffn2_weights_slice(p, c, 4200, 6000, 128););
    PH(13, phase_ln<false>(p, c, PIN(I_LN2G), PIN(I_LN2B), D); ffn2_weights_slice(p, c, 6000, 8448, 0););
    PH(14, run_gemm<14>(p, c););
    PH(15, run_gemm<15>(p, c););
    PH(16, phase_ln<true>(p, c, PIN(I_LN3G), PIN(I_LN3B), FF););
#ifdef PROBE_EXTRA_BARRIERS
    for (int i_ = 0; i_ < 16; ++i_) xcd_barrier(xbar);
#endif
#undef PH
#ifdef PROBE_TIME_PHASE
#ifndef PROBE_BLOCK
#define PROBE_BLOCK 0
#endif
    if (blockIdx.x == PROBE_BLOCK) { const unsigned long long te = __builtin_amdgcn_s_memrealtime(); const unsigned long long want = (pt1_ - pt0_) * 8ull;
        while (__builtin_amdgcn_s_memrealtime() - te < want) __builtin_amdgcn_s_sleep(32); }
#endif
#undef IN
#undef MKCTX
#undef SEAM
}

extern "C" void kernel_launch(void* const* d_in, const int* in_sizes, int n_in, void* d_out, int out_size, void* d_ws, size_t ws_size, hipStream_t stream) {
    static int grid = 0;
    if (!grid) {
        if (n_in != N_IN || (size_t)out_size != O_END || ws_size < WS_END) { fprintf(stderr, "kernel_launch: unexpected shapes (n_in %d, out %d, ws %zu)\n", n_in, out_size, ws_size); grid = -1; return; }
        int dev = 0, cus = 0, per_cu = 0;
        hipGetDevice(&dev); hipDeviceGetAttribute(&cus, hipDeviceAttributeMultiprocessorCount, dev);
        hipFuncSetAttribute((const void*)mega_fwd, hipFuncAttributeMaxDynamicSharedMemorySize, LDS_BYTES);
        hipOccupancyMaxActiveBlocksPerMultiprocessor(&per_cu, (const void*)mega_fwd, 512, LDS_BYTES);
        if (per_cu < 1) { fprintf(stderr, "kernel_launch: occupancy query says %d blocks per CU\n", per_cu); per_cu = 1; }
        grid = cus;
    }
    if (grid < 0) return;
    if (hipMemsetAsync(d_ws, 0, 16384, stream) != hipSuccess) fprintf(stderr, "kernel_launch: memset failed\n");
    Params p{};
    for (int i = 0; i < N_IN; ++i) p.in[i] = (const float*)d_in[i];
    p.out = (float*)d_out; p.ws = (unsigned char*)d_ws;
#if MK_SINGLE_LAUNCH
    p.ph_lo = 0; p.ph_hi = NPHASE;
    void* args[] = {&p};
    hipError_t e = hipLaunchCooperativeKernel((const void*)mega_fwd, dim3(grid), dim3(512), args, LDS_BYTES, stream);
    if (e != hipSuccess) fprintf(stderr, "cooperative launch failed: %s (grid %d)\n", hipGetErrorString(e), grid);
#else
    for (int ph = 0; ph < NPHASE; ++ph) { p.ph_lo = ph; p.ph_hi = ph + 1; hipLaunchKernelGGL(mega_fwd, dim3(grid), dim3(512), LDS_BYTES, stream, p); }
#endif
}
```

```cpp
#include <hip/hip_runtime.h>
#include <hip/hip_cooperative_groups.h>
#include <cstdio>
#include <cstdint>
namespace cg = cooperative_groups;

#ifndef MK_SINGLE_LAUNCH
#define MK_SINGLE_LAUNCH 1
#endif

namespace pg8 {
#define PG8_LAS __attribute__((address_space(3)))
typedef unsigned short bf16_t;
typedef short bf16x8 __attribute__((ext_vector_type(8)));
typedef float f32x4 __attribute__((ext_vector_type(4)));
typedef unsigned u32x4 __attribute__((ext_vector_type(4)));
constexpr int BM = 256, BK = 64, HALF = 128, HTB = HALF * BK * 2  , STAGE_BYTES = 8 * HTB, NXCD = 8, WGM = 8;

__host__ __device__ __forceinline__ int lds_byte(int r, int c) { const int st = (r >> 4) * 2 + (c >> 5), rr = r & 15, cc = c & 31, ob = rr * 64 + cc * 2; return st * 1024 + (ob ^ (((ob >> 9) & 1) << 5)); }
__host__ __device__ __forceinline__ void stage_rc(int b, int& R, int& C) { const int st = b / 1024, sb = b % 1024, swz = sb ^ (((sb >> 9) & 1) << 5); R = (st >> 1) * 16 + swz / 64; C = (st & 1) * 32 + (swz % 64) / 2; }
__host__ __device__ __forceinline__ int perm32(int rho) { const int n = rho >> 4, i = rho & 15; return 8 * (i >> 2) + 4 * n + (i & 3); }

struct Unit { int pm, pn, k0, nt, part, tl, half, rowoff, bq, coloff; };
struct Gemm { const bf16_t* A; const bf16_t* Bt; int M, N, K; };

struct StaticOrder {
    int nM, nN, nwg, G, c, ntK;
    int ext_n = 0, ext_pm0 = 0, ext_pn0 = 0, ext_w = 1;
    int split2 = 0;
    int force_q = 0;
    int qtail = 0;
    int htail = 0;
    int tail, nseg;
    __host__ __device__ void init(int M, int N, int K, int G_, int c_, bool split_tail = false) { nM = M / BM; nN = N / BM; nwg = nM * nN; G = G_; c = c_; ntK = K / BK; tail = 0; nseg = 1;
        if (split_tail && nwg > G && 2 * (nwg - G) <= G) { tail = nwg - G; nseg = G / tail; const int P = ntK / 2; if (nseg > P / 2) nseg = P / 2; if (nseg < 1) nseg = 1; } }
    __host__ __device__ void unit_of(int L, Unit& u) const {
        int wgid = L; { const int q = nwg / NXCD, r = nwg % NXCD, xcd = wgid % NXCD, off = wgid / NXCD; wgid = (xcd < r ? xcd * (q + 1) : r * (q + 1) + (xcd - r) * q) + off; }
        const int nig = WGM * nN, gid = wgid / nig, fm = gid * WGM, gsz = (nM - fm) < WGM ? (nM - fm) : WGM;
        u.pm = fm + ((wgid % nig) % gsz); u.pn = (wgid % nig) / gsz; u.k0 = 0; u.nt = ntK; u.part = 0; u.tl = 0; u.half = 0; u.rowoff = 0; u.bq = 0; u.coloff = 0; }
    __host__ __device__ bool next(int i, Unit& u) const {
        if (split2 > 0) { if (!next1(i >> 1, u)) return false; if ((i & 1) == 0) { u.nt = split2; u.part = 10; } else { u.k0 = split2; u.nt = ntK - split2; } return true; }
        return next1(i, u);
    }
    __host__ __device__ bool next1(int i, Unit& u) const {
        if (qtail > 0 && i >= nwg / G) { if (i > nwg / G || c >= 4 * qtail) return false; unit_of((nwg / G) * G + (c >> 2), u); u.half = 1; u.rowoff = 128 * (c & 1); u.bq = 1; u.coloff = 128 * ((c >> 1) & 1); return true; }
        if (htail > 0 && i >= nwg / G) { if (i > nwg / G || c >= 2 * htail) return false; unit_of((nwg / G) * G + (c >> 1), u); u.half = 1; u.rowoff = 128 * (c & 1); return true; }
        if (tail > 0 && i >= 1) {
            if (i > 1 || c >= tail * nseg) return false;
            const int tl = c % tail, sg = c / tail, P = ntK / 2; unit_of(G + tl, u);
            const int p0 = (sg * P) / nseg, p1 = ((sg + 1) * P) / nseg; u.k0 = 2 * p0; u.nt = 2 * (p1 - p0); u.part = 2 + sg; u.tl = tl; return true; }
        const long L = (long)i * G + c; if (L >= nwg + ext_n) return false;
        if (L >= nwg) { const int e = (int)L - nwg; u.pm = ext_pm0 + e / ext_w; u.pn = ext_pn0 + e % ext_w; u.k0 = 0; u.nt = ntK; u.part = 0; u.tl = 0; u.half = 0; u.rowoff = 0; u.bq = 0; u.coloff = 0; return true; }
        unit_of((int)L, u); if (force_q) { u.half = 1; u.bq = 1; } return true;
    }
    __device__ __forceinline__ void a_ready(const Unit&) const {}
    __device__ __forceinline__ void done(const Unit&) const {}
};


__device__ __forceinline__ unsigned cvt_pk_bf16(float lo, float hi) { unsigned r; asm volatile("v_cvt_pk_bf16_f32 %0, %1, %2" : "=v"(r) : "v"(lo), "v"(hi)); return r; }

__device__ __forceinline__ float bf2f(unsigned short h) { return __uint_as_float(((unsigned)h) << 16); }
__device__ __forceinline__ float bflo(unsigned w) { return __uint_as_float(w << 16); }
__device__ __forceinline__ float bfhi(unsigned w) { return __uint_as_float(w & 0xffff0000u); }
__device__ __forceinline__ float sigm(float x) { return __builtin_amdgcn_rcpf(1.0f + __expf(-x)); }
__device__ __forceinline__ float silu_(float x) { return x * __builtin_amdgcn_rcpf(1.0f + __expf(-x)); }
typedef unsigned u32x2 __attribute__((ext_vector_type(2)));

enum { EM_SWIGLU = 0, EM_RESID = 1, EM_WIN = 2, EM_LORA = 3, EM_M1 = 4, EM_M2 = 5, EM_MF = 6 };
struct EpiGen {
    static constexpr bool AFTER_DRAIN = false;
    int mode; bool PERM; int nseg, pn0, midt, dry;
    void* o0; void* o1; void* o2; const void* i0; const void* i1; const float* f0; const float* f1;
    float alpha, scale;
    __device__ __forceinline__ void mid(f32x4 (&acc)[2][2][4][2], const Unit& u, int wr, int wc, int fr, int fq) const {
        const int row0 = u.pm * BM + u.rowoff + wr * 64 + fr; const int nai = u.half ? 1 : 2, nbj = u.bq ? 1 : 2; const bf16_t* Gt = (const bf16_t*)i0; const int col0 = u.pn * BM + u.coloff + wc * 32 + 8 * fq;
#pragma unroll
        for (int ai = 0; ai < 2; ++ai) if (ai < nai)
#pragma unroll
            for (int m = 0; m < 4; ++m) { const size_t r = (size_t)(row0 + ai * HALF + m * 16);
#pragma unroll
                for (int bj = 0; bj < 2; ++bj) if (bj < nbj) { const int c = col0 + bj * HALF; const u32x4 ga = *(const u32x4*)(Gt + r * 4096 + c), gb = *(const u32x4*)(Gt + r * 4096 + 2048 + c);
                    f32x4& a0 = acc[ai][bj][m][0]; f32x4& a1 = acc[ai][bj][m][1];
                    a0[0] *= bflo(ga.x) * __builtin_amdgcn_rcpf(bflo(gb.x)); a0[1] *= bfhi(ga.x) * __builtin_amdgcn_rcpf(bfhi(gb.x)); a0[2] *= bflo(ga.y) * __builtin_amdgcn_rcpf(bflo(gb.y)); a0[3] *= bfhi(ga.y) * __builtin_amdgcn_rcpf(bfhi(gb.y));
                    a1[0] *= bflo(ga.z) * __builtin_amdgcn_rcpf(bflo(gb.z)); a1[1] *= bfhi(ga.z) * __builtin_amdgcn_rcpf(bfhi(gb.z)); a1[2] *= bflo(ga[3]) * __builtin_amdgcn_rcpf(bflo(gb[3])); a1[3] *= bfhi(ga[3]) * __builtin_amdgcn_rcpf(bfhi(gb[3])); }
                asm volatile("" ::: "memory"); }
    }
    __device__ __forceinline__ void operator()(f32x4 (&acc)[2][2][4][2], const Unit& u, int wr, int wc, int fr, int fq) const {
        if (dry) return;
        if (mode == EM_MF && u.part == 10) { mid(acc, u, wr, wc, fr, fq); return; }
        const int row0 = u.pm * BM + u.rowoff + wr * 64 + fr; const int nai = u.half ? 1 : 2;
        if (mode == EM_SWIGLU) {
            bf16_t* O = (bf16_t*)o0; const int col0 = u.pn * 128 + wc * 32 + 8 * fq;
#pragma unroll
            for (int ai = 0; ai < 2; ++ai) if (ai < nai)
#pragma unroll
                for (int m = 0; m < 4; ++m) { bf16_t* rowp = O + (size_t)(row0 + ai * HALF + m * 16) * 5632 + col0;
                    const f32x4 g0 = acc[ai][0][m][0], g1 = acc[ai][0][m][1], u0 = acc[ai][1][m][0], u1 = acc[ai][1][m][1];
                    f32x4 v0, v1;
#pragma unroll
                    for (int j = 0; j < 4; ++j) { v0[j] = silu_(g0[j]) * u0[j]; v1[j] = silu_(g1[j]) * u1[j]; }
                    u32x4 w; w.x = cvt_pk_bf16(v0[0], v0[1]); w.y = cvt_pk_bf16(v0[2], v0[3]); w.z = cvt_pk_bf16(v1[0], v1[1]); w.w = cvt_pk_bf16(v1[2], v1[3]);
                    *(u32x4*)rowp = w; }
        } else if (mode == EM_RESID) {
            const bf16_t* R = (const bf16_t*)i0; const int col0 = u.pn * BM + wc * 32 + 4 * fq; const bool whole = u.part == 0; const float al = (whole || u.part == 2) ? alpha : 0.f;
            float* C = whole ? (float*)o0 : (float*)o1 + (size_t)(u.tl * nseg + (u.part - 2)) * 65536; const int ldc = whole ? 2048 : 256; const int ro = whole ? row0 : wr * 64 + fr, co = whole ? col0 : wc * 32 + 4 * fq;
#pragma unroll
            for (int ai = 0; ai < 2; ++ai) if (ai < nai)
#pragma unroll
                for (int m = 0; m < 4; ++m) { const size_t off = (size_t)(row0 + ai * HALF + m * 16) * 2048 + col0; float* crow = C + (size_t)(ro + ai * HALF + m * 16) * ldc + co;
#pragma unroll
                    for (int bj = 0; bj < 2; ++bj)
#pragma unroll
                        for (int n = 0; n < 2; ++n) { const u32x2 rv = *(const u32x2*)(R + off + bj * HALF + n * 16);
                            f32x4 o; o[0] = al * bflo(rv.x) + scale * acc[ai][bj][m][n][0]; o[1] = al * bfhi(rv.x) + scale * acc[ai][bj][m][n][1];
                            o[2] = al * bflo(rv.y) + scale * acc[ai][bj][m][n][2]; o[3] = al * bfhi(rv.y) + scale * acc[ai][bj][m][n][3];
                            *(f32x4*)(crow + bj * HALF + n * 16) = o; } }
        } else if (mode == EM_WIN) {
            const int pn = u.pn + pn0; bf16_t* O; int ld, colt, act;
            if (pn < 14) { O = (bf16_t*)o0; ld = 3584; colt = pn * BM; act = 0; }
            else if (pn < 22) { O = (bf16_t*)o1; ld = 2048; colt = (pn - 14) * BM; act = 1; }
            else if (pn < 34) { O = (bf16_t*)o2; ld = 3072; colt = (pn - 22) * BM; act = 0; }
            else { O = (bf16_t*)const_cast<void*>(i1); ld = 4096; colt = (pn - 34) * BM; act = 2; }
            const int col0 = colt + wc * 32 + 8 * fq;
            f32x4 bv[2][2];
#pragma unroll
            for (int bj = 0; bj < 2; ++bj)
#pragma unroll
                for (int n = 0; n < 2; ++n) bv[bj][n] = (act == 2) ? *(const f32x4*)(f0 + col0 + bj * HALF + 4 * n) : (f32x4){0.f, 0.f, 0.f, 0.f};
#pragma unroll
            for (int ai = 0; ai < 2; ++ai) if (ai < nai)
#pragma unroll
                for (int m = 0; m < 4; ++m) { bf16_t* rowp = O + (size_t)(row0 + ai * HALF + m * 16) * ld + col0;
#pragma unroll
                    for (int bj = 0; bj < 2; ++bj) { f32x4 v0 = acc[ai][bj][m][0] + bv[bj][0], v1 = acc[ai][bj][m][1] + bv[bj][1];
                        if (act == 1) {
#pragma unroll
                            for (int j = 0; j < 4; ++j) { v0[j] = silu_(v0[j]); v1[j] = silu_(v1[j]); } }
                        else if (act == 2) {
#pragma unroll
                            for (int j = 0; j < 4; ++j) { v0[j] = sigm(v0[j]); v1[j] = sigm(v1[j]); } }
                        u32x4 w; w.x = cvt_pk_bf16(v0[0], v0[1]); w.y = cvt_pk_bf16(v0[2], v0[3]); w.z = cvt_pk_bf16(v1[0], v1[1]); w.w = cvt_pk_bf16(v1[2], v1[3]);
                        *(u32x4*)(rowp + bj * HALF) = w; } }
        } else if (mode == EM_LORA) {
            const int pn = u.pn; const int col0 = (pn & 3) * BM + wc * 32 + 4 * fq;
            if (pn < 4) {
#pragma unroll
                for (int ai = 0; ai < 2; ++ai) if (ai < nai)
#pragma unroll
                    for (int m = 0; m < 4; ++m) { const size_t off = (size_t)(row0 + ai * HALF + m * 16) * 1024 + col0;
#pragma unroll
                        for (int bj = 0; bj < 2; ++bj)
#pragma unroll
                            for (int n = 0; n < 2; ++n) { const int c = col0 + bj * HALF + n * 16; const f32x4 a = acc[ai][bj][m][n]; const f32x4 b = *(const f32x4*)(f0 + c); f32x4 o;
#pragma unroll
                                for (int j = 0; j < 4; ++j) o[j] = __expf(-0.6065306597f * sigm(a[j] + b[j]));
                                *(f32x4*)((float*)o0 + off + bj * HALF + n * 16) = o; } }
            } else if (pn < 8) {
#pragma unroll
                for (int ai = 0; ai < 2; ++ai) if (ai < nai)
#pragma unroll
                    for (int m = 0; m < 4; ++m) { const size_t off = (size_t)(row0 + ai * HALF + m * 16) * 1024 + col0;
#pragma unroll
                        for (int bj = 0; bj < 2; ++bj)
#pragma unroll
                            for (int n = 0; n < 2; ++n) { const int c = col0 + bj * HALF + n * 16; const f32x4 a = acc[ai][bj][m][n]; const f32x4 b = *(const f32x4*)(f1 + c);
                                u32x2 w; w.x = cvt_pk_bf16(sigm(a[0] + b[0]), sigm(a[1] + b[1])); w.y = cvt_pk_bf16(sigm(a[2] + b[2]), sigm(a[3] + b[3]));
                                *(u32x2*)((bf16_t*)o1 + off + bj * HALF + n * 16) = w; } }
            } else {
#pragma unroll
                for (int ai = 0; ai < 2; ++ai) if (ai < nai)
#pragma unroll
                    for (int m = 0; m < 4; ++m) { const size_t off = (size_t)(row0 + ai * HALF + m * 16) * 1024 + col0;
#pragma unroll
                        for (int bj = 0; bj < 2; ++bj)
#pragma unroll
                            for (int n = 0; n < 2; ++n) { const f32x4 a = acc[ai][bj][m][n];
                                u32x2 w; w.x = cvt_pk_bf16(a[0], a[1]); w.y = cvt_pk_bf16(a[2], a[3]); *(u32x2*)((bf16_t*)o2 + off + bj * HALF + n * 16) = w; } }
            }
        } else if (mode == EM_M1) {
            float* C = (float*)o0; const bf16_t* Gt = (const bf16_t*)i0; const int col0 = u.pn * BM + wc * 32 + 4 * fq;
#pragma unroll
            for (int ai = 0; ai < 2; ++ai) if (ai < nai)
#pragma unroll
                for (int m = 0; m < 4; ++m) { const size_t r = (size_t)(row0 + ai * HALF + m * 16);
#pragma unroll
                    for (int bj = 0; bj < 2; ++bj)
#pragma unroll
                        for (int n = 0; n < 2; ++n) { const int c = col0 + bj * HALF + n * 16; const u32x2 gv = *(const u32x2*)(Gt + r * 4096 + c); const f32x4 a = acc[ai][bj][m][n];
                            f32x4 o; o[0] = bflo(gv.x) * a[0]; o[1] = bfhi(gv.x) * a[1]; o[2] = bflo(gv.y) * a[2]; o[3] = bfhi(gv.y) * a[3];
                            *(f32x4*)(C + r * 2048 + c) = o; } }
        } else if (mode == EM_MF) {
            bf16_t* O = (bf16_t*)o0; const bf16_t* Gt = (const bf16_t*)i0; const int col0 = u.pn * BM + u.coloff + wc * 32 + 8 * fq; const int nbj = u.bq ? 1 : 2;
#pragma unroll
            for (int ai = 0; ai < 2; ++ai) if (ai < nai)
#pragma unroll
                for (int m = 0; m < 4; ++m) { const size_t r = (size_t)(row0 + ai * HALF + m * 16);
#pragma unroll
                    for (int bj = 0; bj < 2; ++bj) if (bj < nbj) { const int c = col0 + bj * HALF; const u32x4 gv = *(const u32x4*)(Gt + r * 4096 + 2048 + c); const f32x4 a0 = acc[ai][bj][m][0], a1 = acc[ai][bj][m][1];
                        u32x4 w; w.x = cvt_pk_bf16(bflo(gv.x) * a0[0], bfhi(gv.x) * a0[1]); w.y = cvt_pk_bf16(bflo(gv.y) * a0[2], bfhi(gv.y) * a0[3]);
                        w.z = cvt_pk_bf16(bflo(gv.z) * a1[0], bfhi(gv.z) * a1[1]); w.w = cvt_pk_bf16(bflo(gv.w) * a1[2], bfhi(gv.w) * a1[3]);
                        *(u32x4*)(O + r * 2048 + c) = w; } }
        } else {
            bf16_t* O = (bf16_t*)o0; const bf16_t* Gt = (const bf16_t*)i0; const float* T1 = (const float*)i1; const int col0 = u.pn * BM + wc * 32 + 8 * fq;
#pragma unroll
            for (int ai = 0; ai < 2; ++ai) if (ai < nai)
#pragma unroll
                for (int m = 0; m < 4; ++m) { const size_t r = (size_t)(row0 + ai * HALF + m * 16);
#pragma unroll
                    for (int bj = 0; bj < 2; ++bj) { const int c = col0 + bj * HALF; const u32x4 gv = *(const u32x4*)(Gt + r * 4096 + 2048 + c);
                        const f32x4 t0 = *(const f32x4*)(T1 + r * 2048 + c), t1 = *(const f32x4*)(T1 + r * 2048 + c + 4); const f32x4 a0 = acc[ai][bj][m][0], a1 = acc[ai][bj][m][1];
                        u32x4 w; w.x = cvt_pk_bf16(t0[0] + bflo(gv.x) * a0[0], t0[1] + bfhi(gv.x) * a0[1]); w.y = cvt_pk_bf16(t0[2] + bflo(gv.y) * a0[2], t0[3] + bfhi(gv.y) * a0[3]);
                        w.z = cvt_pk_bf16(t1[0] + bflo(gv.z) * a1[0], t1[1] + bfhi(gv.z) * a1[1]); w.w = cvt_pk_bf16(t1[2] + bflo(gv.w) * a1[2], t1[3] + bfhi(gv.w) * a1[3]);
                        *(u32x4*)(O + r * 2048 + c) = w; } }
        }
    }
};
template <class Epi, class Sched, bool ALIGN_EPI = false, bool SP2 = false>
__device__ __forceinline__ void gemm_phase(PG8_LAS unsigned char* lds, const Gemm g, const Sched& S, const Epi& E) {
    const int tid = threadIdx.x, wid = __builtin_amdgcn_readfirstlane(tid >> 6), lane = tid & 63, wr = wid >> 2, wc = wid & 3, fr = lane & 15, fq = lane >> 4;
    const int K = g.K;
    unsigned voffA[2], voffB[2];
#pragma unroll
    for (int i = 0; i < 2; ++i) { int R, C; stage_rc(tid * 16 + i * 8192, R, C); const int Rb = E.PERM ? ((R & ~31) + perm32(R & 31)) : R;
        voffA[i] = (unsigned)(R * K + C) * 2u; voffB[i] = (unsigned)(Rb * K + C) * 2u; }
    const size_t kstep = (size_t)(BK * 2);
    const size_t hstep = (size_t)HALF * K * 2;
    const size_t tstep = 2 * hstep;
    const unsigned ldsw = (unsigned)wid * 1024u;
    const int aoff = lds_byte(wr * 64 + fr, fq * 8), boff = lds_byte(wc * 32 + fr, fq * 8);
#define PG8_SA(b, h) (((b) * 2 + (h)) * HTB)
#define PG8_SB(b, h) ((4 + (b) * 2 + (h)) * HTB)
#define PG8_STAGE(bufoff, gbase, voff) do { _Pragma("unroll") for (int _i = 0; _i < 2; ++_i) \
        __builtin_amdgcn_global_load_lds((const unsigned*)((const char*)(gbase) + (voff)[_i]), (PG8_LAS unsigned*)(lds + (bufoff) + ldsw + _i * 8192), 16, 0, 0); } while (0)
#define PG8_LDA(dst, b, h) do { _Pragma("unroll") for (int m = 0; m < 4; ++m) _Pragma("unroll") for (int k = 0; k < 2; ++k) dst[m][k] = *(const PG8_LAS bf16x8*)(lds + PG8_SA(b, h) + aoff + m * 2048 + k * 1024); } while (0)
#define PG8_LDB(dst, b, h) do { _Pragma("unroll") for (int n = 0; n < 2; ++n) _Pragma("unroll") for (int k = 0; k < 2; ++k) dst[n][k] = *(const PG8_LAS bf16x8*)(lds + PG8_SB(b, h) + boff + n * 2048 + k * 1024); } while (0)
#define PG8_MMA(ai, bj, At, Bt) do { __builtin_amdgcn_s_setprio(1); _Pragma("unroll") for (int m = 0; m < 4; ++m) _Pragma("unroll") for (int n = 0; n < 2; ++n) _Pragma("unroll") for (int k = 0; k < 2; ++k) \
        acc[ai][bj][m][n] = __builtin_amdgcn_mfma_f32_16x16x32_bf16(Bt[n][k], At[m][k], acc[ai][bj][m][n], 0, 0, 0); __builtin_amdgcn_s_setprio(0); } while (0)
#define PG8_WAIT_V(n) asm volatile("s_waitcnt vmcnt(" #n ")" ::: "memory")
#define PG8_WAIT_L(n) asm volatile("s_waitcnt lgkmcnt(" #n ")" ::: "memory")
#define PG8_BAR __builtin_amdgcn_s_barrier()
#define PG8_SCHED __builtin_amdgcn_sched_barrier(0)
    Unit cur, nxt; int ui = 0;
    if (!S.next(0, cur)) return;
    f32x4 acc[2][2][4][2];
#pragma unroll
    for (int a = 0; a < 2; ++a)
#pragma unroll
        for (int b = 0; b < 2; ++b)
#pragma unroll
            for (int m = 0; m < 4; ++m)
#pragma unroll
                for (int n = 0; n < 2; ++n) acc[a][b][m][n] = (f32x4){0.f, 0.f, 0.f, 0.f};
    bf16x8 At[4][2], B0[2][2], B1[2][2];
    size_t cH = cur.half ? 0 : hstep, cBH = cur.bq ? 0 : hstep;
    const char* cA = (const char*)g.A + (size_t)cur.pm * tstep + (size_t)(cur.rowoff >> 7) * hstep + (size_t)cur.k0 * kstep; const char* cB = (const char*)g.Bt + (size_t)cur.pn * tstep + (size_t)(cur.coloff >> 7) * hstep + (size_t)cur.k0 * kstep;
    S.a_ready(cur);
    if constexpr (SP2) {
        PG8_STAGE(PG8_SB(0, 0), cB, voffB); PG8_STAGE(PG8_SB(0, 1), cB + cBH, voffB); PG8_STAGE(PG8_SA(0, 0), cA, voffA); PG8_STAGE(PG8_SA(0, 1), cA + cH, voffA);
        if (wr == 1) PG8_BAR;
        PG8_WAIT_V(2); PG8_BAR;
        PG8_STAGE(PG8_SB(1, 0), cB + kstep, voffB); PG8_STAGE(PG8_SA(1, 0), cA + kstep, voffA); PG8_STAGE(PG8_SB(1, 1), cB + cBH + kstep, voffB);
        PG8_WAIT_V(6); PG8_BAR;
    } else {
        PG8_STAGE(PG8_SB(0, 0), cB, voffB); PG8_STAGE(PG8_SA(0, 0), cA, voffA); PG8_STAGE(PG8_SB(0, 1), cB + hstep, voffB); PG8_STAGE(PG8_SA(0, 1), cA + hstep, voffA);
        if (wr == 1) PG8_BAR;
        PG8_WAIT_V(4); PG8_BAR;
        PG8_STAGE(PG8_SB(1, 0), cB + kstep, voffB); PG8_STAGE(PG8_SA(1, 0), cA + kstep, voffA); PG8_STAGE(PG8_SB(1, 1), cB + hstep + kstep, voffB);
        PG8_WAIT_V(6); PG8_BAR;
    }
    for (;;) {
        const bool has_next = S.next(ui + 1, nxt);
        const size_t nH = has_next ? (nxt.half ? 0 : hstep) : cH, nBH = has_next ? (nxt.bq ? 0 : hstep) : cBH;
        const char* nA = has_next ? (const char*)g.A + (size_t)nxt.pm * tstep + (size_t)(nxt.rowoff >> 7) * hstep + (size_t)nxt.k0 * kstep : cA; const char* nB = has_next ? (const char*)g.Bt + (size_t)nxt.pn * tstep + (size_t)(nxt.coloff >> 7) * hstep + (size_t)nxt.k0 * kstep : cB;
        const int nt = cur.nt;
        for (int t = 0; t < nt; t += 2) {
            const bool last = (t == nt - 2);
            const char* a1 = cA + (size_t)(t + 1) * kstep;
            const char* a2 = last ? nA : cA + (size_t)(t + 2) * kstep; const char* b2 = last ? nB : cB + (size_t)(t + 2) * kstep;
            const char* a3 = a2 + kstep; const char* b3 = b2 + kstep;
            if (last && has_next) S.a_ready(nxt);
            if constexpr (SP2) {
            PG8_LDB(B0, 0, 0); PG8_LDB(B1, 0, 1); PG8_SCHED; PG8_LDA(At, 0, 0); PG8_STAGE(PG8_SA(1, 1), a1 + cH, voffA);
            PG8_WAIT_V(8); PG8_WAIT_L(0); PG8_BAR; PG8_MMA(0, 0, At, B0); if (!cur.bq) { PG8_MMA(0, 1, At, B1); } PG8_BAR; PG8_SCHED;
            PG8_LDA(At, 0, 1); PG8_STAGE(PG8_SB(0, 0), b2, voffB); PG8_STAGE(PG8_SB(0, 1), b2 + (last ? nBH : cBH), voffB); PG8_STAGE(PG8_SA(0, 0), a2, voffA);
            PG8_WAIT_V(8); PG8_WAIT_L(0); PG8_BAR; if (!cur.half) { PG8_MMA(1, 0, At, B0); if (!cur.bq) { PG8_MMA(1, 1, At, B1); } } PG8_BAR; PG8_SCHED;
            PG8_LDB(B0, 1, 0); PG8_LDB(B1, 1, 1); PG8_SCHED; PG8_LDA(At, 1, 0); PG8_STAGE(PG8_SA(0, 1), a2 + (last ? nH : cH), voffA);
            PG8_WAIT_V(8); PG8_WAIT_L(0); PG8_BAR; PG8_MMA(0, 0, At, B0); if (!cur.bq) { PG8_MMA(0, 1, At, B1); } PG8_BAR; PG8_SCHED;
            PG8_LDA(At, 1, 1); PG8_STAGE(PG8_SB(1, 0), b3, voffB); PG8_STAGE(PG8_SB(1, 1), b3 + (last ? nBH : cBH), voffB); PG8_STAGE(PG8_SA(1, 0), a3, voffA);
            PG8_WAIT_V(8); PG8_WAIT_L(0); PG8_BAR; if (!cur.half) { PG8_MMA(1, 0, At, B0); if (!cur.bq) { PG8_MMA(1, 1, At, B1); } } PG8_BAR; PG8_SCHED;
            } else {
            PG8_LDB(B0, 0, 0); PG8_SCHED; PG8_LDA(At, 0, 0); PG8_STAGE(PG8_SA(1, 1), a1 + hstep, voffA);
            PG8_WAIT_L(8); PG8_BAR; PG8_WAIT_L(0); PG8_MMA(0, 0, At, B0); PG8_BAR; PG8_SCHED;
            PG8_LDB(B1, 0, 1); PG8_STAGE(PG8_SB(0, 0), b2, voffB);
            PG8_BAR; PG8_WAIT_L(0); PG8_MMA(0, 1, At, B1); PG8_BAR;
            PG8_LDA(At, 0, 1); PG8_STAGE(PG8_SA(0, 0), a2, voffA);
            PG8_BAR; PG8_WAIT_L(0); PG8_MMA(1, 0, At, B0); PG8_BAR; PG8_SCHED;
            PG8_STAGE(PG8_SB(0, 1), b2 + hstep, voffB);
            PG8_WAIT_V(6); PG8_BAR; PG8_MMA(1, 1, At, B1); PG8_BAR;
            PG8_LDB(B0, 1, 0); PG8_SCHED; PG8_LDA(At, 1, 0); PG8_STAGE(PG8_SA(0, 1), a2 + hstep, voffA);
            PG8_WAIT_L(8); PG8_BAR; PG8_WAIT_L(0); PG8_MMA(0, 0, At, B0); PG8_BAR; PG8_SCHED;
            PG8_LDB(B1, 1, 1); PG8_STAGE(PG8_SB(1, 0), b3, voffB);
            PG8_BAR; PG8_WAIT_L(0); PG8_MMA(0, 1, At, B1); PG8_BAR;
            PG8_LDA(At, 1, 1); PG8_STAGE(PG8_SA(1, 0), a3, voffA);
            PG8_BAR; PG8_WAIT_L(0); PG8_MMA(1, 0, At, B0); PG8_BAR; PG8_SCHED;
            PG8_STAGE(PG8_SB(1, 1), b3 + hstep, voffB);
            PG8_WAIT_V(6); PG8_BAR; PG8_MMA(1, 1, At, B1); PG8_BAR;
            }
        }
        if constexpr (ALIGN_EPI) { if (wr == 0) PG8_BAR; }
        if constexpr (!Epi::AFTER_DRAIN) { E(acc, cur, wr, wc, fr, fq); S.done(cur); }
        if (!has_next) break;
        { const float keep = (cur.part == 10) ? 1.f : 0.f;
#pragma unroll
        for (int a = 0; a < 2; ++a)
#pragma unroll
            for (int b = 0; b < 2; ++b)
#pragma unroll
                for (int m = 0; m < 4; ++m)
#pragma unroll
                    for (int n = 0; n < 2; ++n) acc[a][b][m][n] = acc[a][b][m][n] * keep; }
        cur = nxt; cA = nA; cB = nB; cH = nH; cBH = nBH; ++ui;
        if constexpr (ALIGN_EPI) { if (wr == 1) PG8_BAR; }
    }
    PG8_WAIT_V(0);
    if constexpr (!ALIGN_EPI) { if (wr == 0) PG8_BAR; }
    PG8_BAR;
    if constexpr (Epi::AFTER_DRAIN) { E.fused(acc, cur, wr, wc, fr, fq, lds, wid, lane); S.done(cur); }
#undef PG8_SA
#undef PG8_SB
#undef PG8_STAGE
#undef PG8_LDA
#undef PG8_LDB
#undef PG8_MMA
#undef PG8_WAIT_V
#undef PG8_WAIT_L
#undef PG8_BAR
#undef PG8_SCHED
}
}

#define LAS __attribute__((address_space(3)))
typedef unsigned short bf16;
typedef float f32x4 __attribute__((ext_vector_type(4)));
typedef float f32x2 __attribute__((ext_vector_type(2)));
typedef unsigned u32x4 __attribute__((ext_vector_type(4)));
typedef unsigned u32x2 __attribute__((ext_vector_type(2)));
typedef short bf16x8 __attribute__((ext_vector_type(8)));
using pg8::bf2f; using pg8::bflo; using pg8::bfhi; using pg8::sigm; using pg8::silu_; using pg8::cvt_pk_bf16;

constexpr int D = 2048, FF = 5632, NB = 4, SEQ = 2048, NMETA = 16, PADR = 48, LP = 2112  , TP = 2064  ;
constexpr int SB = 16, SS = 16, MP = NB * LP  , MROWS = MP + SB * SS  ;
constexpr int RWD = 1024, RWH = 16, SHC = 3520, CONVD = 3072, SSMH = 32, SSMN = 128, NINP = 12800;
constexpr int PRW_LD = 3584, Z_LD = 2048, XBC_LD = 3072, GATE_LD = 4096;
constexpr float LN_EPS = 1e-5f, ALPHA = 1.189207115f  , GN_EPS = 64e-5f, RMS_EPS = 1e-5f;
constexpr int NPHASE = 17;
constexpr int GATE_PM_HELPED = 28;
constexpr int LDS_BYTES = 163840;

enum { I_XP = 0, I_XS, I_SSH, I_SWKV, I_SCONV, I_SSSM, I_META, I_GU1, I_DN1, I_LN1G, I_LN1B, I_WIN, I_BGATE, I_MU, I_W0, I_W2, I_A0, I_A2, I_G2, I_KK, I_KA, I_RK, I_GNW, I_GNB,
       I_CONVW, I_CONVB, I_DTB, I_ALOG, I_DSKIP, I_NORMW, I_RWO, I_SSMO, I_WO, I_LN2G, I_LN2B, I_GU2, I_DN2, I_LN3G, I_LN3B, N_IN };
constexpr size_t O_YP = 0, O_YS = 16777216, O_PSH = 17301504, O_PWKV = 17315584, O_PCONV = 17577728, O_PSSM = 17614592, O_SSH = 18663168, O_SWKV = 18719488, O_SCONV = 19768064, O_SSSM = 19915520, O_END = 24109824;
constexpr size_t MiB = 1u << 20;
constexpr size_t WS_SBON = 1 * MiB, WS_RWOT = 2 * MiB, WS_SSMOT = 6 * MiB, WS_WOT = 14 * MiB, WS_LORAT = 22 * MiB, WS_WBIG = 25 * MiB, WS_XB = 91 * MiB, WS_ACT = 125 * MiB, WS_PROJ = 219 * MiB, WS_YRW = 432 * MiB, WS_END = 449 * MiB;
constexpr size_t WS_GUT = WS_WBIG, WS_DNT = WS_WBIG + 44 * MiB, WS_WINT = WS_WBIG, WS_WDEC = WS_WBIG;
constexpr size_t WS_C12 = WS_LORAT, WS_KK0 = WS_SBON + 600000;
constexpr size_t WS_DTB = WS_LORAT, WS_ACB = WS_LORAT + 1536 * 1024;
constexpr size_t OUT_GBUF = 34 * MiB;
constexpr size_t WS_R = WS_ACT, WS_KP = WS_ACT + 17 * MiB, WS_V = WS_ACT + 34 * MiB, WS_KK = WS_ACT + 51 * MiB, WS_BB = WS_ACT + 68 * MiB, WS_ALORA = WS_ACT + 85 * MiB, WS_T1 = WS_ACT;
constexpr size_t WS_XBC = WS_PROJ, WS_PRW = WS_XBC + (size_t)MROWS * XBC_LD * 2, WS_Z = WS_PRW + (size_t)MROWS * PRW_LD * 2, WS_GATE = WS_Z + (size_t)MROWS * Z_LD * 2, WS_PRE = WS_PROJ, WS_SLAB = WS_PROJ + 68 * MiB;
constexpr size_t WS_ACAT = WS_XBC, WS_BCAT = WS_RWOT;
static_assert(WS_GATE + (size_t)MROWS * GATE_LD * 2 <= WS_YRW, "proj region");
static_assert(WS_ALORA + (size_t)MROWS * 512 * 2 <= WS_PROJ, "act region");

struct Params { const float* in[N_IN]; float* out; unsigned char* ws; int ph_lo, ph_hi; };

__device__ __forceinline__ int opaque_idx(int i) { asm volatile("" : "+s"(i)); return i; }
#define PIN(i) (p.in[opaque_idx(i)])
struct Ctx { int tid, lane, wave, gw, ngw, vc, pass; LAS unsigned char* lds; };

__device__ __forceinline__ float wave_sum(float v) {
#pragma unroll
    for (int o = 1; o < 64; o <<= 1) v += __shfl_xor(v, o);
    return v;
}
__device__ __forceinline__ unsigned pk2(float lo, float hi) { return cvt_pk_bf16(lo, hi); }
__device__ __forceinline__ float softplus_(float x) { return fmaxf(x, 0.f) + __logf(1.f + __expf(-fabsf(x))); }

__device__ __forceinline__ const float* xrow_ptr(const Params& p, int row) {
    if (row < MP) { const int b = row / LP, q = row - b * LP; if (q < PADR) return nullptr; const int t = q - PADR;
        return t < NMETA ? PIN(I_META) + (size_t)t * D : PIN(I_XP) + ((size_t)b * SEQ + (t - NMETA)) * D; }
    return PIN(I_XS) + (size_t)(row - MP) * D;
}
__device__ __forceinline__ float* yrow_ptr(const Params& p, int row) {
    if (row < MP) { const int b = row / LP, q = row - b * LP; if (q < PADR + NMETA) return nullptr; return p.out + O_YP + ((size_t)b * SEQ + (q - PADR - NMETA)) * D; }
    return p.out + O_YS + (size_t)(row - MP) * D;
}
__device__ __forceinline__ bool row_is_pad(int row) { return row < MP && (row % LP) < PADR; }

__device__ __forceinline__ void phase_convert_x(const Params& p, const Ctx& c) {
    bf16* XB = (bf16*)(p.ws + WS_XB);
    for (int row = c.gw; row < MROWS; row += c.ngw) { const float* src = xrow_ptr(p, row); const bool ok = src != nullptr; src = ok ? src : PIN(I_META); u32x2* dst = (u32x2*)(XB + (size_t)row * D);
        f32x4 v[8];
#pragma unroll
        for (int j = 0; j < 8; ++j) v[j] = __builtin_nontemporal_load((const f32x4*)src + c.lane + 64 * j);
#pragma unroll
        for (int j = 0; j < 8; ++j) { u32x2 w; w.x = ok ? pk2(v[j][0], v[j][1]) : 0u; w.y = ok ? pk2(v[j][2], v[j][3]) : 0u; dst[c.lane + 64 * j] = w; } }
}
enum { MAP_ID = 0, MAP_GU = 1, MAP_WIN = 2 };
__device__ __forceinline__ int map_src_col(int kind, int c) {
    if (kind == MAP_ID) return c;
    if (kind == MAP_GU) { const int pn = c >> 8, bj = (c >> 7) & 1, r = c & 127; return bj * FF + 128 * pn + r; }
    if (c < 3520) return c; if (c < 3552) return 8640 + (c - 3520); if (c < 3584) return -1; if (c < 5632) return 3520 + (c - 3584); if (c < 8704) return 5568 + (c - 5632); return 8672 + (c - 8704);
}
__device__ __forceinline__ void tr_load(const float* W, int K, int Nsrc, int nblk, int kind, int it, int cg, int half, int kr, f32x4 (&v)[16]) {
    const int kb = it / nblk, nb = it - kb * nblk, k0 = 64 * kb, n0 = 64 * nb; int sc = map_src_col(kind, n0 + 32 * half); const bool ok = sc >= 0; sc = ok ? sc : 0;
#pragma unroll
    for (int i = 0; i < 16; ++i) { const f32x4 t = __builtin_nontemporal_load((const f32x4*)(W + (size_t)(k0 + 4 * i + kr) * Nsrc + sc + 4 * (cg & 7))); v[i] = ok ? t : (f32x4){0.f, 0.f, 0.f, 0.f}; }
}
__device__ __forceinline__ void transpose_w(const float* W, int K, int Nsrc, bf16* WT, int ndst, int kind, const Ctx& c, int item_lo = 0, int item_hi = 1 << 30, int wid = -1, int nworkers = 0, int ldt = 0) {
    if (ldt == 0) ldt = K;
    LAS float* scr = (LAS float*)(c.lds + c.wave * 16640);
    const int nblk = ndst / 64, lane = c.lane; int nitems = (K / 64) * nblk; if (item_hi < nitems) nitems = item_hi;
    const int gw_ = wid < 0 ? c.gw : wid, ngw_ = wid < 0 ? c.ngw : nworkers;
    const int cg = lane & 15, half = cg >> 3, kr = lane >> 4;
    f32x4 v[16];
    int it = item_lo + gw_; if (it < nitems) tr_load(W, K, Nsrc, nblk, kind, it, cg, half, kr, v);
    for (; it < nitems; it += ngw_) {
        const int kb = it / nblk, nb = it - kb * nblk, k0 = 64 * kb, n0 = 64 * nb;
#pragma unroll
        for (int i = 0; i < 16; ++i) { LAS float* d = scr + (4 * i + kr) * 65 + 4 * cg; d[0] = v[i][0]; d[1] = v[i][1]; d[2] = v[i][2]; d[3] = v[i][3]; }
        if (it + ngw_ < nitems) tr_load(W, K, Nsrc, nblk, kind, it + ngw_, cg, half, kr, v);
        asm volatile("s_waitcnt lgkmcnt(0)" ::: "memory");
        const int cc = lane & 7;
#pragma unroll
        for (int j = 0; j < 8; ++j) { const int n = (lane >> 3) + 8 * j; const LAS float* sp = scr + (8 * cc) * 65 + n;
            u32x4 o; o.x = pk2(sp[0 * 65], sp[1 * 65]); o.y = pk2(sp[2 * 65], sp[3 * 65]); o.z = pk2(sp[4 * 65], sp[5 * 65]); o[3] = pk2(sp[6 * 65], sp[7 * 65]);
            *(u32x4*)(WT + (size_t)(n0 + n) * ldt + k0 + 8 * cc) = o; }
        asm volatile("s_waitcnt lgkmcnt(0)" ::: "memory");
    }
}
struct LoratHold { float v[2][8]; };
__device__ __forceinline__ void lorat_issue(const Params& p, const Ctx& c, int n0, LoratHold& H) {
    const float* w2 = PIN(I_W2); const float* a2 = PIN(I_A2); const float* g2 = PIN(I_G2);
#pragma unroll
    for (int e = 0; e < 2; ++e) { int n = n0 + e * c.ngw; n = n < 3072 ? n : 3071;
        const float* src = n < 1024 ? w2 + n : (n < 2048 ? a2 + (n - 1024) : g2 + (n - 2048)); const int klo = n < 1024 ? 0 : (n < 2048 ? 96 : 256), khi = n < 1024 ? 96 : (n < 2048 ? 192 : 512);
#pragma unroll
        for (int j = 0; j < 8; ++j) { const int k = 8 * c.lane + j; const bool ok = k >= klo && k < khi; const float x = src[(size_t)(ok ? k - klo : 0) * 1024]; H.v[e][j] = ok ? x : 0.f; } }
}
__device__ __forceinline__ void lorat_store(const Params& p, const Ctx& c, int n0, const LoratHold& H) {
    bf16* LT = (bf16*)(p.ws + WS_LORAT);
#pragma unroll
    for (int e = 0; e < 2; ++e) { const int n = n0 + e * c.ngw; if (n < 3072) {
        u32x4 o; o.x = pk2(H.v[e][0], H.v[e][1]); o.y = pk2(H.v[e][2], H.v[e][3]); o.z = pk2(H.v[e][4], H.v[e][5]); o[3] = pk2(H.v[e][6], H.v[e][7]);
        *(u32x4*)(LT + (size_t)n * 512 + 8 * c.lane) = o; } }
}
__device__ __forceinline__ void lorat_rest(const Params& p, const Ctx& c) {
    for (int n0 = c.gw + 2 * c.ngw; n0 < 3072; n0 += 2 * c.ngw) { LoratHold H; lorat_issue(p, c, n0, H); lorat_store(p, c, n0, H); }
}
template <bool FINAL> __device__ __forceinline__ void phase_ln(const Params& p, const Ctx& c, const float* gam, const float* bet, int K  , int wid = -1, int nworkers = 0  ) {
    const float* PRE = (const float*)(p.ws + WS_PRE); const float* SLAB = (const float*)(p.ws + WS_SLAB); bf16* XB = (bf16*)(p.ws + WS_XB);
    pg8::StaticOrder S; S.init(MROWS, D, K, (int)gridDim.x, 0, true); const int nseg = S.nseg;
    LAS signed char* tailtab = (LAS signed char*)(c.lds + 150000);
    __syncthreads();
    if (c.tid < (MROWS / 256) * 8) tailtab[c.tid] = -1;
    __syncthreads();
    if (c.tid < S.tail) { pg8::Unit u; S.unit_of(S.G + c.tid, u); tailtab[u.pm * 8 + u.pn] = (signed char)c.tid; }
    __syncthreads();
    f32x4 gv[8], bv[8];
#pragma unroll
    for (int j = 0; j < 8; ++j) { gv[j] = ((const f32x4*)gam)[c.lane + 64 * j]; bv[j] = ((const f32x4*)bet)[c.lane + 64 * j]; }
    const int lw_ = wid < 0 ? c.gw : wid, lnw_ = wid < 0 ? c.ngw : nworkers;
    for (int row = lw_; row < MROWS; row += lnw_) {
        float* yo = nullptr; if (FINAL) { yo = yrow_ptr(p, row); if (!yo) continue; }
        const f32x4* src = (const f32x4*)(PRE + (size_t)row * D); f32x4 v[8]; float s = 0.f;
        const u32x2 tt = *(const LAS u32x2*)(tailtab + (row >> 8) * 8);
        if ((tt.x & tt.y) == 0xffffffffu) {
#pragma unroll
            for (int j = 0; j < 8; ++j) v[j] = src[c.lane + 64 * j];
#pragma unroll
            for (int j = 0; j < 8; ++j) s += (v[j][0] + v[j][1]) + (v[j][2] + v[j][3]);
        } else
#pragma unroll
        for (int j = 0; j < 8; ++j) { const int tl = tailtab[(row >> 8) * 8 + j];
            if (tl < 0) v[j] = src[c.lane + 64 * j];
            else { f32x4 a = (f32x4){0.f, 0.f, 0.f, 0.f}; const float* sp = SLAB + ((size_t)tl * nseg * 256 + (row & 255)) * 256 + c.lane * 4;
                if ((nseg & 15) == 0) {
                    for (int sg = 0; sg < nseg; sg += 16) { f32x4 t[16];
#pragma unroll
                        for (int u = 0; u < 16; ++u) t[u] = *(const f32x4*)(sp + (size_t)(sg + u) * 65536);
                        a += (((t[0] + t[1]) + (t[2] + t[3])) + ((t[4] + t[5]) + (t[6] + t[7]))) + (((t[8] + t[9]) + (t[10] + t[11])) + ((t[12] + t[13]) + (t[14] + t[15]))); } }
                else if ((nseg & 7) == 0) {
                    for (int sg = 0; sg < nseg; sg += 8) { f32x4 t[8];
#pragma unroll
                        for (int u = 0; u < 8; ++u) t[u] = *(const f32x4*)(sp + (size_t)(sg + u) * 65536);
                        a += ((t[0] + t[1]) + (t[2] + t[3])) + ((t[4] + t[5]) + (t[6] + t[7])); } }
                else for (int sg = 0; sg < nseg; ++sg) a += *(const f32x4*)(sp + (size_t)sg * 65536);
                v[j] = a; }
            s += (v[j][0] + v[j][1]) + (v[j][2] + v[j][3]); }
        const float mean = wave_sum(s) * (1.f / D); float q = 0.f;
#pragma unroll
        for (int j = 0; j < 8; ++j) { v[j] = v[j] - mean; q += (v[j][0] * v[j][0] + v[j][1] * v[j][1]) + (v[j][2] * v[j][2] + v[j][3] * v[j][3]); }
        const float rstd = 1.f / sqrtf(wave_sum(q) * (1.f / D) + LN_EPS);
#pragma unroll
        for (int j = 0; j < 8; ++j) { const f32x4 o = v[j] * rstd * gv[j] + bv[j];
            if (FINAL) __builtin_nontemporal_store(o, (f32x4*)yo + c.lane + 64 * j);
            else { u32x2 w; w.x = pk2(o[0], o[1]); w.y = pk2(o[2], o[3]); ((u32x2*)(XB + (size_t)row * D))[c.lane + 64 * j] = w; } }
    }
}
__device__ __forceinline__ float sum8(float v) { v += __shfl_xor(v, 1); v += __shfl_xor(v, 2); v += __shfl_xor(v, 4); return v; }
__device__ __forceinline__ void ld8bf(const bf16* ptr, float (&o)[8]) { const u32x4 w = *(const u32x4*)ptr; o[0] = bflo(w.x); o[1] = bfhi(w.x); o[2] = bflo(w.y); o[3] = bfhi(w.y); o[4] = bflo(w.z); o[5] = bfhi(w.z); o[6] = bflo(w[3]); o[7] = bfhi(w[3]); }
__device__ __forceinline__ void st8bf(bf16* ptr, const float (&v)[8]) { u32x4 w; w.x = pk2(v[0], v[1]); w.y = pk2(v[2], v[3]); w.z = pk2(v[4], v[5]); w[3] = pk2(v[6], v[7]); *(u32x4*)ptr = w; }
__device__ __forceinline__ void ld8f(const float* ptr, float (&o)[8]) { const f32x4 a = *(const f32x4*)ptr, b = *(const f32x4*)(ptr + 4); o[0] = a[0]; o[1] = a[1]; o[2] = a[2]; o[3] = a[3]; o[4] = b[0]; o[5] = b[1]; o[6] = b[2]; o[7] = b[3]; }
__device__ __forceinline__ void phase_prep1(const Params& p, const Ctx& c) {
    const bf16* PRW = (const bf16*)(p.ws + WS_PRW); const bf16* XBC = (const bf16*)(p.ws + WS_XBC); bf16* AL = (bf16*)(p.ws + WS_ALORA); const float* mu = PIN(I_MU);
    const int l = c.lane, lc = l < 56 ? l : 55, col = 3072 + 8 * lc; float m[8]; ld8f(mu + col, m);
    for (int row0 = c.gw; row0 < MROWS; row0 += 4 * c.ngw) {
        u32x4 qc[4], qp[4]; const float* prvf[4]; bool zprev[4], live[4], pad[4];
#pragma unroll
        for (int e = 0; e < 4; ++e) { const int row = row0 + e * c.ngw; const bool in = row < MROWS; pad[e] = in && row_is_pad(row); live[e] = in && !pad[e]; const int rr = live[e] ? row : PADR + 1;
            const bf16* cur = PRW + (size_t)rr * PRW_LD; const bf16* prv = cur - PRW_LD; prvf[e] = nullptr; zprev[e] = false;
            if (rr < MP) { if ((rr % LP) == PADR) { zprev[e] = true; prv = cur; } }
            else { const int sq = rr - MP; if ((sq & 15) == 0) { prvf[e] = PIN(I_SSH) + (size_t)(sq >> 4) * SHC; prv = cur; } }
            qc[e] = *(const u32x4*)(cur + col); qp[e] = *(const u32x4*)(prv + col); }
#pragma unroll
        for (int e = 0; e < 4; ++e) { const int row = row0 + e * c.ngw; bf16* al = AL + (size_t)row * 512;
            if (pad[e]) { *(u32x4*)(al + 8 * l) = (u32x4){0u, 0u, 0u, 0u}; continue; }
            if (!live[e]) continue;
            float pc[8], pp[8]; { const u32x4 w = qc[e]; pc[0] = bflo(w.x); pc[1] = bfhi(w.x); pc[2] = bflo(w.y); pc[3] = bfhi(w.y); pc[4] = bflo(w.z); pc[5] = bfhi(w.z); pc[6] = bflo(w[3]); pc[7] = bfhi(w[3]); }
            { const u32x4 w = qp[e]; pp[0] = bflo(w.x); pp[1] = bfhi(w.x); pp[2] = bflo(w.y); pp[3] = bfhi(w.y); pp[4] = bflo(w.z); pp[5] = bfhi(w.z); pp[6] = bflo(w[3]); pp[7] = bfhi(w[3]); }
            if (prvf[e]) ld8f(prvf[e] + col, pp);
            float o[8];
#pragma unroll
            for (int j = 0; j < 8; ++j) { const float pv = zprev[e] ? 0.f : pp[j]; const float ps = pc[j] + (pv - pc[j]) * m[j]; const int cc = 8 * lc + j;
                o[j] = cc < 96 ? tanhf(ps) : (cc < 192 ? ps : sigm(ps)); }
            if (l < 24) st8bf(al + 8 * l, o);
            else if (l < 56) st8bf(al + 256 + 8 * (l - 24), o);
            else *(u32x4*)(al + 192 + 8 * (l - 56)) = (u32x4){0u, 0u, 0u, 0u}; }
    }
    const int gt = blockIdx.x * 512 + c.tid, ngt = gridDim.x * 512;
    for (int i = gt; i < NB * SHC; i += ngt) { const int b = i / SHC, col = i - b * SHC; p.out[O_PSH + i] = bf2f(PRW[(size_t)(b * LP + LP - 1) * PRW_LD + col]); }
    for (int i = gt; i < SB * SHC; i += ngt) { const int b = i / SHC, col = i - b * SHC; p.out[O_SSH + i] = bf2f(PRW[(size_t)(MP + b * SS + SS - 1) * PRW_LD + col]); }
    for (int i = gt; i < NB * 3 * CONVD; i += ngt) { const int b = i / (3 * CONVD), r = (i / CONVD) % 3, col = i % CONVD; p.out[O_PCONV + i] = bf2f(XBC[(size_t)(b * LP + LP - 3 + r) * XBC_LD + col]); }
    for (int i = gt; i < SB * 3 * CONVD; i += ngt) { const int b = i / (3 * CONVD), r = (i / CONVD) % 3, col = i % CONVD; p.out[O_SCONV + i] = bf2f(XBC[(size_t)(MP + b * SS + SS - 3 + r) * XBC_LD + col]); }
}
__device__ __forceinline__ float sum16(float v) { v += __shfl_xor(v, 1); v += __shfl_xor(v, 2); v += __shfl_xor(v, 4); v += __shfl_xor(v, 8); return v; }
__device__ __forceinline__ void ld4bf(const bf16* ptr, float (&o)[4]) { const u32x2 w = *(const u32x2*)ptr; o[0] = bflo(w.x); o[1] = bfhi(w.x); o[2] = bflo(w.y); o[3] = bfhi(w.y); }
__device__ __forceinline__ void st4bf(bf16* ptr, const float (&v)[4]) { u32x2 w; w.x = pk2(v[0], v[1]); w.y = pk2(v[2], v[3]); *(u32x2*)ptr = w; }
__device__ __forceinline__ void shifted4(const bf16* cur, const bf16* prv, const float* prvf, int col, const float* mu, float (&o)[4]) {
    float pc[4], pp[4]; ld4bf(cur + col, pc);
    if (prv) ld4bf(prv + col, pp); else if (prvf) { const f32x4 t = *(const f32x4*)(prvf + col); pp[0] = t[0]; pp[1] = t[1]; pp[2] = t[2]; pp[3] = t[3]; } else { pp[0] = pp[1] = pp[2] = pp[3] = 0.f; }
    const f32x4 m = *(const f32x4*)(mu + col);
#pragma unroll
    for (int j = 0; j < 4; ++j) o[j] = pc[j] + (pp[j] - pc[j]) * m[j];
}
__device__ __forceinline__ void phase_prep2(const Params& p, const Ctx& c) {
    const bf16* PRW = (const bf16*)(p.ws + WS_PRW); bf16* R = (bf16*)(p.ws + WS_R); bf16* KP = (bf16*)(p.ws + WS_KP); bf16* V = (bf16*)(p.ws + WS_V); bf16* KK = (bf16*)(p.ws + WS_KK); bf16* BB = (bf16*)(p.ws + WS_BB);
    float* SBON = (float*)(p.ws + WS_SBON); const float* mu = PIN(I_MU);
    const int t8 = c.tid & 127, ch = 8 * t8, head = t8 >> 3;
    float mur[8], muk[8], muv[8], wkk[8], wka[8], wrk[8];
    ld8f(mu + ch, mur); ld8f(mu + 1024 + ch, muk); ld8f(mu + 2048 + ch, muv); ld8f(PIN(I_KK) + ch, wkk); ld8f(PIN(I_KA) + ch, wka); ld8f(PIN(I_RK) + ch, wrk);
    for (int row = blockIdx.x * 4 + (c.tid >> 7); row < MROWS; row += gridDim.x * 4) {
        if (row_is_pad(row)) continue;
        const bf16* cur = PRW + (size_t)row * PRW_LD; const bf16* prv = cur - PRW_LD; const float* prvf = nullptr; bool zprev = false;
        if (row < MP) { if ((row % LP) == PADR) { zprev = true; prv = cur; } }
        else { const int s = row - MP; if ((s & 15) == 0) { prvf = PIN(I_SSH) + (size_t)(s >> 4) * SHC; prv = cur; } }
        float rc[8], kc[8], vc[8], rp[8], kp_[8], vp[8], a[8];
        ld8bf(cur + ch, rc); ld8bf(cur + 1024 + ch, kc); ld8bf(cur + 2048 + ch, vc); ld8bf(prv + ch, rp); ld8bf(prv + 1024 + ch, kp_); ld8bf(prv + 2048 + ch, vp);
        ld8bf(BB + (size_t)row * RWD + ch, a);
        if (prvf) { ld8f(prvf + ch, rp); ld8f(prvf + 1024 + ch, kp_); ld8f(prvf + 2048 + ch, vp); }
        float r[8], k[8], v[8], kk[8], ss = 0.f;
#pragma unroll
        for (int j = 0; j < 8; ++j) { const float pr = zprev ? 0.f : rp[j], pk = zprev ? 0.f : kp_[j], pv = zprev ? 0.f : vp[j];
            r[j] = rc[j] + (pr - rc[j]) * mur[j]; k[j] = kc[j] + (pk - kc[j]) * muk[j]; v[j] = vc[j] + (pv - vc[j]) * muv[j]; kk[j] = k[j] * wkk[j]; ss += kk[j] * kk[j]; }
        ss = sum8(ss); const float inv = 1.f / fmaxf(sqrtf(ss), 1e-12f);
        float kp[8], bb[8], sb = 0.f;
#pragma unroll
        for (int j = 0; j < 8; ++j) { kk[j] *= inv; kp[j] = k[j] * (1.f + (a[j] - 1.f) * wka[j]); bb[j] = kk[j] * a[j]; sb += r[j] * kp[j] * wrk[j]; }
        sb = sum8(sb);
        const size_t o = (size_t)row * RWD + ch;
        st8bf(R + o, r); st8bf(KP + o, kp); st8bf(V + o, v); st8bf(KK + o, kk); st8bf(BB + o, bb);
        if ((t8 & 7) == 0) SBON[(size_t)row * RWH + head] = sb;
    }
}
__device__ __forceinline__ void phase_post(const Params& p, const Ctx& c) {
    const float* YRAW = p.out; const bf16* V = (const bf16*)(p.ws + WS_V); const bf16* G = (const bf16*)((const unsigned char*)p.out + OUT_GBUF); const float* SBON = (const float*)(p.ws + WS_SBON); bf16* ACAT = (bf16*)(p.ws + WS_ACAT);
    { const int t8 = c.tid & 127, ch = 8 * t8, head = t8 >> 3;
      float gw[8], gb[8]; ld8f(PIN(I_GNW) + ch, gw); ld8f(PIN(I_GNB) + ch, gb);
      const int step = gridDim.x * 4;
      for (int row0 = blockIdx.x * 4 + (c.tid >> 7); row0 < MROWS; row0 += 2 * step) {
        f32x4 ya[2], yb[2]; u32x4 vw[2], gq[2]; float sbv[2]; bool in[2], live[2];
#pragma unroll
        for (int e = 0; e < 2; ++e) { const int row = row0 + e * step; in[e] = row < MROWS; live[e] = in[e] && !row_is_pad(row); const int rr = live[e] ? row : PADR;
            const size_t o = (size_t)rr * RWD + ch; ya[e] = *(const f32x4*)(YRAW + o); yb[e] = *(const f32x4*)(YRAW + o + 4); vw[e] = *(const u32x4*)(V + o); gq[e] = *(const u32x4*)(G + o); sbv[e] = SBON[(size_t)rr * RWH + head]; }
#pragma unroll
        for (int e = 0; e < 2; ++e) { if (!in[e]) continue; const int row = row0 + e * step; const size_t oc = (size_t)row * 3072 + ch;
            if (!live[e]) { *(u32x4*)(ACAT + oc) = (u32x4){0u, 0u, 0u, 0u}; continue; }
            float y[8] = {ya[e][0], ya[e][1], ya[e][2], ya[e][3], yb[e][0], yb[e][1], yb[e][2], yb[e][3]};
            float v[8] = {bflo(vw[e].x), bfhi(vw[e].x), bflo(vw[e].y), bfhi(vw[e].y), bflo(vw[e].z), bfhi(vw[e].z), bflo(vw[e][3]), bfhi(vw[e][3])};
            float g[8] = {bflo(gq[e].x), bfhi(gq[e].x), bflo(gq[e].y), bfhi(gq[e].y), bflo(gq[e].z), bfhi(gq[e].z), bflo(gq[e][3]), bfhi(gq[e][3])};
            const float sb = sbv[e]; float sy = 0.f;
#pragma unroll
            for (int j = 0; j < 8; ++j) sy += y[j];
            const float mean = sum8(sy) * (1.f / 64.f);
            float d[8], q = 0.f;
#pragma unroll
            for (int j = 0; j < 8; ++j) { d[j] = y[j] - mean; q += d[j] * d[j]; }
            const float rstd = 1.f / sqrtf(sum8(q) * (1.f / 64.f) + GN_EPS);
            float ov[8];
#pragma unroll
            for (int j = 0; j < 8; ++j) ov[j] = (d[j] * rstd * gw[j] + gb[j] + sb * v[j]) * g[j];
            st8bf(ACAT + oc, ov); }
      } }
    { const bf16* Z = (const bf16*)(p.ws + WS_Z); const float* nw = PIN(I_NORMW);
      f32x4 n0[4], n1[4];
#pragma unroll
      for (int g = 0; g < 4; ++g) { n0[g] = *(const f32x4*)(nw + g * 512 + c.lane * 8); n1[g] = *(const f32x4*)(nw + g * 512 + c.lane * 8 + 4); }
      for (int row0 = c.gw; row0 < MROWS; row0 += 2 * c.ngw) { u32x4 wq[2][4];
#pragma unroll
        for (int e = 0; e < 2; ++e) { int rr = row0 + e * c.ngw; rr = rr < MROWS ? rr : row0; const bf16* ptr = Z + (size_t)rr * Z_LD + c.lane * 8;
#pragma unroll
            for (int g = 0; g < 4; ++g) wq[e][g] = *(const u32x4*)(ptr + g * 512); }
#pragma unroll
        for (int e = 0; e < 2; ++e) { const int row = row0 + e * c.ngw; if (row >= MROWS) continue;
#pragma unroll
        for (int g = 0; g < 4; ++g) { const u32x4 (&w)[4] = wq[e]; float v[8] = {bflo(w[g].x), bfhi(w[g].x), bflo(w[g].y), bfhi(w[g].y), bflo(w[g].z), bfhi(w[g].z), bflo(w[g][3]), bfhi(w[g][3])};
            float ss = 0.f;
#pragma unroll
            for (int j = 0; j < 8; ++j) ss += v[j] * v[j];
            const float rs = 1.f / sqrtf(wave_sum(ss) * (1.f / 512.f) + RMS_EPS);
            u32x4 o; o.x = pk2(v[0] * rs * n0[g][0], v[1] * rs * n0[g][1]); o.y = pk2(v[2] * rs * n0[g][2], v[3] * rs * n0[g][3]); o.z = pk2(v[4] * rs * n1[g][0], v[5] * rs * n1[g][1]); o[3] = pk2(v[6] * rs * n1[g][2], v[7] * rs * n1[g][3]);
            *(u32x4*)(ACAT + (size_t)row * 3072 + 1024 + g * 512 + c.lane * 8) = o; } } } }
}

constexpr int SC_CH = 32;
constexpr int SC_ARR = SC_CH * 64;
constexpr int SC_BUF = 6 * SC_ARR * 4;
__device__ __forceinline__ float dpp_sum16(float x) {
    x += __builtin_bit_cast(float, __builtin_amdgcn_update_dpp(0, __builtin_bit_cast(int, x), 0xB1, 0xF, 0xF, true));
    x += __builtin_bit_cast(float, __builtin_amdgcn_update_dpp(0, __builtin_bit_cast(int, x), 0x4E, 0xF, 0xF, true));
    x += __builtin_bit_cast(float, __builtin_amdgcn_update_dpp(0, __builtin_bit_cast(int, x), 0x141, 0xF, 0xF, true));
    x += __builtin_bit_cast(float, __builtin_amdgcn_update_dpp(0, __builtin_bit_cast(int, x), 0x140, 0xF, 0xF, true));
    return x;
}
struct ScanHold { u32x4 b[3]; f32x4 w; };
__device__ __forceinline__ void scan_issue(const Params& p, int tid, int row0, int h, int steps, ScanHold& H) {
    asm volatile("" : "+v"(tid));
#pragma unroll
    for (int j = 0; j < 3; ++j) { int pidx = tid + 512 * j; pidx = pidx < 1280 ? pidx : pidx - 256; const int arr = pidx >> 8, wi = pidx & 255; int i = wi >> 3; i = i < steps ? i : steps - 1;
        H.b[j] = *(const u32x4*)((const bf16*)(p.ws + WS_ACT) + (size_t)arr * (17u * 1048576u / 2u) + (size_t)(row0 + i) * RWD + h * 64 + (wi & 7) * 8); }
    { int i = tid >> 4; i = i < steps ? i : steps - 1; H.w = *(const f32x4*)((const float*)(p.ws + WS_WDEC) + (size_t)(row0 + i) * RWD + h * 64 + (tid & 15) * 4); }
}
__device__ __forceinline__ void scan_put(int tid, LAS float* buf, const ScanHold& H) {
    asm volatile("" : "+v"(tid));
#pragma unroll
    for (int j = 0; j < 3; ++j) { int pidx = tid + 512 * j; pidx = pidx < 1280 ? pidx : pidx - 256; const int arr = pidx >> 8, wi = pidx & 255; const u32x4 v = H.b[j];
        LAS f32x4* dst = (LAS f32x4*)(buf + arr * SC_ARR + (wi >> 3) * 64 + (wi & 7) * 8);
        dst[0] = (f32x4){bflo(v.x), bfhi(v.x), bflo(v.y), bfhi(v.y)}; dst[1] = (f32x4){bflo(v.z), bfhi(v.z), bflo(v[3]), bfhi(v[3])}; }
    *(LAS f32x4*)(buf + 5 * SC_ARR + (tid >> 4) * 64 + (tid & 15) * 4) = H.w;
}
struct ScanIn { f32x4 r, k, q, b, w; float v;
    __device__ __forceinline__ void load(const LAS float* bR, const LAS float* bV, int i) { const LAS float* bp = bR + i * 64;
        r = *(const LAS f32x4*)bp; k = *(const LAS f32x4*)(bp + SC_ARR); q = *(const LAS f32x4*)(bp + 3 * SC_ARR); b = *(const LAS f32x4*)(bp + 4 * SC_ARR); w = *(const LAS f32x4*)(bp + 5 * SC_ARR); v = bV[i * 64]; } };
__device__ __forceinline__ float scan_step(float (&S)[4], const ScanIn& x) {
    float pa = S[0] * x.q[0]; float pb = S[2] * x.q[2]; pa = __builtin_fmaf(S[1], x.q[1], pa); pb = __builtin_fmaf(S[3], x.q[3], pb);
    const float sa = -dpp_sum16(pa + pb); const float cv = x.v;
    S[0] = __builtin_fmaf(S[0], x.w[0], __builtin_fmaf(sa, x.b[0], cv * x.k[0])); S[1] = __builtin_fmaf(S[1], x.w[1], __builtin_fmaf(sa, x.b[1], cv * x.k[1]));
    S[2] = __builtin_fmaf(S[2], x.w[2], __builtin_fmaf(sa, x.b[2], cv * x.k[2])); S[3] = __builtin_fmaf(S[3], x.w[3], __builtin_fmaf(sa, x.b[3], cv * x.k[3]));
    float ya = S[0] * x.r[0]; float yb = S[2] * x.r[2]; ya = __builtin_fmaf(S[1], x.r[1], ya); yb = __builtin_fmaf(S[3], x.r[3], yb);
    return ya + yb;
}
__device__ __forceinline__ float scan_ysum2(float pa, float pb, bool hi) {
    const float send = hi ? pa : pb, keep = hi ? pb : pa;
    float z = keep + __builtin_bit_cast(float, __builtin_amdgcn_update_dpp(0, __builtin_bit_cast(int, send), 0x128, 0xF, 0xF, true));
    z += __builtin_bit_cast(float, __builtin_amdgcn_update_dpp(0, __builtin_bit_cast(int, z), 0xB1, 0xF, 0xF, true));
    z += __builtin_bit_cast(float, __builtin_amdgcn_update_dpp(0, __builtin_bit_cast(int, z), 0x4E, 0xF, 0xF, true));
    z += __builtin_bit_cast(float, __builtin_amdgcn_update_dpp(0, __builtin_bit_cast(int, z), 0x141, 0xF, 0xF, true));
    return z;
}
__device__ __forceinline__ void rwkv_scan_unit(const Params& p, const Ctx& c, int s, int h, int hf) {
    const bool prompt = s < NB; const int row_base = prompt ? s * LP + PADR : MP + (s - NB) * SS; const int T = prompt ? TP : SS;
    const int nch = (T + SC_CH - 1) / SC_CH;
    LAS float* buf0 = (LAS float*)c.lds; LAS float* buf1 = (LAS float*)(c.lds + SC_BUF);
    const int lane = c.lane, ks = lane & 15, vrow = 32 * hf + 4 * c.wave + (lane >> 4);
    float S[4] = {0.f, 0.f, 0.f, 0.f};
    if (!prompt) { const f32x4 a = *(const f32x4*)(PIN(I_SWKV) + (((size_t)(s - NB) * RWH + h) * 64 + vrow) * 64 + ks * 4); S[0] = a[0]; S[1] = a[1]; S[2] = a[2]; S[3] = a[3]; }
    ScanHold H;
    scan_issue(p, c.tid, row_base, h, T < SC_CH ? T : SC_CH, H);
    __syncthreads();
    scan_put(c.tid, buf0, H);
    __syncthreads();
    float* yout = p.out;
    LAS float* ybuf = (LAS float*)(c.lds + 2 * SC_BUF);
    for (int cix = 0; cix < nch; ++cix) {
        LAS float* cur = (cix & 1) ? buf1 : buf0; LAS float* nxt = (cix & 1) ? buf0 : buf1; LAS float* yb = ybuf + (cix & 1) * (SC_CH * 32);
        const int t0 = cix * SC_CH; const int steps = (T - t0) < SC_CH ? (T - t0) : SC_CH;
        const bool more = cix + 1 < nch;
        if (more) { const int t1 = t0 + SC_CH; scan_issue(p, c.tid, row_base + t1, h, (T - t1) < SC_CH ? (T - t1) : SC_CH, H); }
        { const LAS float* bR = cur + ks * 4; const LAS float* bV = cur + 2 * SC_ARR + vrow; LAS float* yw = yb + (vrow & 31);
          const bool hi = (ks & 8) != 0; const int hi1 = hi ? 1 : 0;
          ScanIn A, B, C, Dd; A.load(bR, bV, 0); B.load(bR, bV, 1); C.load(bR, bV, 2); Dd.load(bR, bV, 3);
          for (int i = 0; i < steps; i += 4) {
              const int n0 = (i + 4 < steps) ? i + 4 : i;
              const float y0 = scan_step(S, A); A.load(bR, bV, n0);
              const float y1 = scan_step(S, B); B.load(bR, bV, n0 + 1);
              yw[(i + hi1) * 32] = scan_ysum2(y0, y1, hi);
              const float y2 = scan_step(S, C); C.load(bR, bV, n0 + 2);
              const float y3 = scan_step(S, Dd); Dd.load(bR, bV, n0 + 3);
              yw[(i + 2 + hi1) * 32] = scan_ysum2(y2, y3, hi);
          } }
        if (more) scan_put(c.tid, nxt, H);
        __syncthreads();
        if (c.tid < 256) { const int i = c.tid >> 3, c4 = (c.tid & 7) * 4; if (i < steps) *(f32x4*)(yout + (size_t)(row_base + t0 + i) * RWD + h * 64 + 32 * hf + c4) = *(const LAS f32x4*)(yb + i * 32 + c4); }
    }
    { float* so = p.out + (prompt ? O_PWKV + (((size_t)s * RWH + h) * 64 + vrow) * 64 : O_SWKV + (((size_t)(s - NB) * RWH + h) * 64 + vrow) * 64) + ks * 4;
      *(f32x4*)so = (f32x4){S[0], S[1], S[2], S[3]}; }
}

__device__ __forceinline__ void phase_bcconv(const Params& p, const Ctx& c) {
    const bf16* XBC = (const bf16*)(p.ws + WS_XBC); bf16* BCC = (bf16*)(p.ws + WS_YRW);
    const int c8 = (c.tid & 127) * 8, ch = 2048 + c8; const float* convw = PIN(I_CONVW); const float* convb = PIN(I_CONVB);
    f32x4 wa[4], wb[4];
#pragma unroll
    for (int k = 0; k < 4; ++k) { wa[k] = *(const f32x4*)(convw + k * CONVD + ch); wb[k] = *(const f32x4*)(convw + k * CONVD + ch + 4); }
    const f32x4 ba = *(const f32x4*)(convb + ch), bb = *(const f32x4*)(convb + ch + 4);
    const int step = gridDim.x * 4;
    for (int row0 = blockIdx.x * 4 + (c.tid >> 7); row0 < MROWS; row0 += 2 * step) {
        u32x4 tw[2][4]; bool live[2], in[2];
#pragma unroll
        for (int e = 0; e < 2; ++e) { const int row = row0 + e * step; in[e] = row < MROWS; live[e] = in[e] && !row_is_pad(row); const int rr = live[e] ? row : PADR;
#pragma unroll
            for (int k = 0; k < 4; ++k) tw[e][k] = *(const u32x4*)(XBC + (size_t)(rr - 3 + k) * XBC_LD + ch); }
#pragma unroll
        for (int e = 0; e < 2; ++e) { if (!in[e]) continue; const int row = row0 + e * step;
            u32x4 o = (u32x4){0u, 0u, 0u, 0u};
            if (live[e]) {
                const bool prompt = row < MP; const int q = prompt ? (row % LP) - PADR : (row - MP) & 15;
                f32x4 a0 = ba, a1 = bb;
#pragma unroll
                for (int k = 0; k < 4; ++k) { const int qq = q - 3 + k; f32x4 v0 = (f32x4){0.f, 0.f, 0.f, 0.f}, v1 = v0;
                    if (qq >= 0) { const u32x4 w = tw[e][k]; v0 = (f32x4){bflo(w.x), bfhi(w.x), bflo(w.y), bfhi(w.y)}; v1 = (f32x4){bflo(w.z), bfhi(w.z), bflo(w[3]), bfhi(w[3])}; }
                    else if (!prompt) { const float* hs = PIN(I_SCONV) + ((size_t)((row - MP) >> 4) * 3 + (3 + qq)) * CONVD + ch; v0 = *(const f32x4*)hs; v1 = *(const f32x4*)(hs + 4);
                        v0 = (f32x4){bf2f((bf16)(pk2(v0[0], 0.f) & 0xffffu)), bf2f((bf16)(pk2(v0[1], 0.f) & 0xffffu)), bf2f((bf16)(pk2(v0[2], 0.f) & 0xffffu)), bf2f((bf16)(pk2(v0[3], 0.f) & 0xffffu))};
                        v1 = (f32x4){bf2f((bf16)(pk2(v1[0], 0.f) & 0xffffu)), bf2f((bf16)(pk2(v1[1], 0.f) & 0xffffu)), bf2f((bf16)(pk2(v1[2], 0.f) & 0xffffu)), bf2f((bf16)(pk2(v1[3], 0.f) & 0xffffu))}; }
                    a0 += v0 * wa[k]; a1 += v1 * wb[k]; }
                o.x = pk2(silu_(a0[0]), silu_(a0[1])); o.y = pk2(silu_(a0[2]), silu_(a0[3])); o.z = pk2(silu_(a1[0]), silu_(a1[1])); o[3] = pk2(silu_(a1[2]), silu_(a1[3]));
            }
            *(u32x4*)(BCC + (size_t)row * 1024 + c8) = o; }
    }
    { float* DTB = (float*)(p.ws + WS_DTB); float* ACB = (float*)(p.ws + WS_ACB); const bf16* PRWp = (const bf16*)(p.ws + WS_PRW);
      for (int it = c.gw; it < (MP / 64) * (SSMH / 8); it += c.ngw) { const int ck = it / (SSMH / 8), hg = it - ck * (SSMH / 8), row = ck * 64 + c.lane; const bool valid = (row % LP) >= PADR;
          const u32x4 w = *(const u32x4*)(PRWp + (size_t)row * PRW_LD + SHC + 8 * hg);
          const f32x4 b0 = *(const f32x4*)(PIN(I_DTB) + 8 * hg), b1 = *(const f32x4*)(PIN(I_DTB) + 8 * hg + 4), l0 = *(const f32x4*)(PIN(I_ALOG) + 8 * hg), l1 = *(const f32x4*)(PIN(I_ALOG) + 8 * hg + 4);
          float raw[8] = {bflo(w.x), bfhi(w.x), bflo(w.y), bfhi(w.y), bflo(w.z), bfhi(w.z), bflo(w[3]), bfhi(w[3])}; float dtv[8], a[8];
#pragma unroll
          for (int j = 0; j < 8; ++j) { const float bias = j < 4 ? b0[j & 3] : b1[j & 3], alog = j < 4 ? l0[j & 3] : l1[j & 3]; dtv[j] = valid ? softplus_(raw[j] + bias) : 0.f; a[j] = dtv[j] * -__expf(alog); }
#pragma unroll
          for (int o = 1; o < 64; o <<= 1) {
#pragma unroll
              for (int j = 0; j < 8; ++j) { const float t = __shfl_up(a[j], o); if (c.lane >= o) a[j] += t; } }
          float* dp = DTB + (size_t)row * SSMH + 8 * hg; float* ap = ACB + (size_t)row * SSMH + 8 * hg;
          *(f32x4*)dp = (f32x4){dtv[0], dtv[1], dtv[2], dtv[3]}; *(f32x4*)(dp + 4) = (f32x4){dtv[4], dtv[5], dtv[6], dtv[7]};
          *(f32x4*)ap = (f32x4){a[0], a[1], a[2], a[3]}; *(f32x4*)(ap + 4) = (f32x4){a[4], a[5], a[6], a[7]}; } }
}

constexpr int SD_RAW = 0, SD_HB = 44032, SD_BT = 61440, SD_XT = 79872, SD_XD = 89088, SD_XC = 98304, SD_YT = 107520, SD_G = 124928, SD_DT = 134144, SD_ACS = 134400, SD_WT = 134656;
constexpr int RAW_LD = 328, CM_LD = 136, BT_LD = 72, XT_LD = 72, YT_LD = 68;
__device__ __forceinline__ f32x4 mfma16(bf16x8 a, bf16x8 b, f32x4 c) { return __builtin_amdgcn_mfma_f32_16x16x32_bf16(a, b, c, 0, 0, 0); }
__device__ __forceinline__ void ssd_fetch(const Params& p, bool prompt, int s, int row_base, int cix, int hd, int g, int tid, u32x4 (&pre)[6], u32x4& zpre, float& dtraw, float& acsv) {
    const bf16* XBC = (const bf16*)(p.ws + WS_XBC); const bf16* BCC = (const bf16*)(p.ws + WS_YRW);
    asm volatile("" : "+v"(tid));
    if (prompt) {
#pragma unroll
        for (int i = 0; i < 6; ++i) { int idx = tid + 512 * i; idx = idx < 67 * 40 ? idx : 67 * 40 - 1; const int rr = idx / 40, cc = idx - rr * 40; const int q = cix * 64 + rr - 3;
            const bool ok = q >= PADR; const size_t row = (size_t)(row_base + (ok ? q : PADR));
            const bf16* src = cc < 8 ? XBC + row * XBC_LD + hd * 64 + cc * 8 : BCC + row * 1024 + (cc < 24 ? g * 128 + (cc - 8) * 8 : 512 + g * 128 + (cc - 24) * 8);
            const u32x4 v = *(const u32x4*)src; pre[i] = ok ? v : (u32x4){0u, 0u, 0u, 0u}; }
        { const int t = tid >> 3, c8 = (tid & 7) * 8, q = cix * 64 + t; zpre = *(const u32x4*)((const bf16*)(p.ws + WS_Z) + (size_t)(row_base + q) * Z_LD + hd * 64 + c8); }
        { const int q = cix * 64 + (tid & 63); dtraw = ((const float*)(p.ws + WS_DTB))[(size_t)(row_base + q) * SSMH + hd]; acsv = ((const float*)(p.ws + WS_ACB))[(size_t)(row_base + q) * SSMH + hd]; }
    } else { acsv = 0.f;
        const float* hsb = PIN(I_SCONV) + (size_t)(s - NB) * 3 * CONVD;
#pragma unroll
        for (int i = 0; i < 6; ++i) { int idx = tid + 512 * i; idx = idx < 67 * 40 ? idx : 67 * 40 - 1; const int rr = idx / 40, cc = idx - rr * 40; const int q = rr - 3;
            const bool okm = q >= 0 && q < SS, okh = q < 0 && cc < 8; const size_t row = (size_t)(row_base + (okm ? q : 0));
            const bf16* src = cc < 8 ? XBC + row * XBC_LD + hd * 64 + cc * 8 : BCC + row * 1024 + (cc < 24 ? g * 128 + (cc - 8) * 8 : 512 + g * 128 + (cc - 24) * 8);
            const u32x4 vm = *(const u32x4*)src;
            const float* hs = hsb + (size_t)(okh ? 3 + q : 0) * CONVD + hd * 64 + (cc < 8 ? cc : 0) * 8; const f32x4 a = *(const f32x4*)hs, b = *(const f32x4*)(hs + 4);
            u32x4 vh; vh.x = pk2(a[0], a[1]); vh.y = pk2(a[2], a[3]); vh.z = pk2(b[0], b[1]); vh[3] = pk2(b[2], b[3]);
            pre[i] = okm ? vm : (okh ? vh : (u32x4){0u, 0u, 0u, 0u}); }
        { const int t = tid >> 3, c8 = (tid & 7) * 8; const bool ok = t < SS; const u32x4 z = *(const u32x4*)((const bf16*)(p.ws + WS_Z) + (size_t)(row_base + (ok ? t : 0)) * Z_LD + hd * 64 + c8); zpre = ok ? z : (u32x4){0u, 0u, 0u, 0u}; }
        { const int q = tid & 63; const bool ok = q < SS; const float d = bf2f(((const bf16*)(p.ws + WS_PRW))[(size_t)(row_base + (ok ? q : 0)) * PRW_LD + SHC + hd]); dtraw = ok ? d : 0.f; }
    }
}
__device__ __forceinline__ void ssd_unit(const Params& p, const Ctx& c, int s, int hd, bool dry = false) {
    const bool prompt = s < NB; const int row_base = prompt ? s * LP : MP + (s - NB) * SS; const int nchunks = prompt ? LP / 64 : 1; const int g = hd >> 3;
    const int tid = c.tid, lane = c.lane, w = c.wave, fr = lane & 15, fq = lane >> 4;
    LAS bf16* RAW = (LAS bf16*)(c.lds + SD_RAW); LAS bf16* Gm = (LAS bf16*)(c.lds + SD_G); LAS bf16* HB = (LAS bf16*)(c.lds + SD_HB);
    LAS bf16* BT = (LAS bf16*)(c.lds + SD_BT); LAS bf16* XT = (LAS bf16*)(c.lds + SD_XT); LAS bf16* XD = (LAS bf16*)(c.lds + SD_XD); LAS bf16* XC = (LAS bf16*)(c.lds + SD_XC);
    LAS float* YT = (LAS float*)(c.lds + SD_YT); LAS float* DT = (LAS float*)(c.lds + SD_DT); LAS float* ACS = (LAS float*)(c.lds + SD_ACS); LAS float* WT = (LAS float*)(c.lds + SD_WT);
    const int bpair = tid & 63, xpair = tid & 31;
    __syncthreads();
    if (tid < 64) { const float* convw = PIN(I_CONVW); const float* convb = PIN(I_CONVB); const int ch = hd * 64 + tid;
        *(LAS f32x4*)(WT + tid * 8) = (f32x4){convw[ch], convw[CONVD + ch], convw[2 * CONVD + ch], convw[3 * CONVD + ch]}; WT[tid * 8 + 4] = convb[ch]; }
    const float dtb = PIN(I_DTB)[hd], aneg = -__expf(PIN(I_ALOG)[hd]), dsk = PIN(I_DSKIP)[hd];
    const int hpt = w & 3, hnt0 = (w >> 2) * 4;
    f32x4 hacc[4];
#pragma unroll
    for (int j = 0; j < 4; ++j) hacc[j] = (f32x4){0.f, 0.f, 0.f, 0.f};
    if (!prompt) { const float* st = PIN(I_SSSM) + ((size_t)(s - NB) * SSMH + hd) * 64 * 128;
#pragma unroll
        for (int j = 0; j < 4; ++j)
#pragma unroll
            for (int r = 0; r < 4; ++r) hacc[j][r] = __builtin_nontemporal_load(st + (size_t)(hpt * 16 + fq * 4 + r) * 128 + (hnt0 + j) * 16 + fr); }
    const int yit = w >> 1, ypt0 = (w & 1) * 2;
    u32x4 pre[6], zpre, zcur = (u32x4){0u, 0u, 0u, 0u}; float dtraw, acsv;
    ssd_fetch(p, prompt, s, row_base, 0, hd, g, tid, pre, zpre, dtraw, acsv);
    for (int cix = 0; cix <= nchunks; ++cix) {
        if (cix < nchunks) {
            { int tl = tid; asm volatile("" : "+v"(tl));
#pragma unroll
              for (int i = 0; i < 6; ++i) { const int idx = tl + 512 * i; if (idx < 67 * 40) { const int rr = idx / 40, cc = idx - rr * 40; *(LAS u32x4*)(RAW + rr * RAW_LD + cc * 8) = pre[i]; } } }
            if (w == 0) {
                if (prompt) { DT[lane] = dtraw; ACS[lane] = acsv; }
                else { const int q = cix * 64 + lane; const bool valid = q < SS;
                    const float dtv = valid ? softplus_(dtraw + dtb) : 0.f; float a = dtv * aneg;
#pragma unroll
                    for (int o = 1; o < 64; o <<= 1) { const float t = __shfl_up(a, o); if (lane >= o) a += t; }
                    DT[lane] = dtv; ACS[lane] = a; } }
#pragma unroll
            for (int j = 0; j < 4; ++j)
#pragma unroll
                for (int r = 0; r < 4; ++r) HB[(hpt * 16 + fq * 4 + r) * CM_LD + (hnt0 + j) * 16 + fr] = (bf16)(pk2(hacc[j][r], 0.f) & 0xffffu);
        }
        if (cix > 0) { const int t = tid >> 3, c8 = (tid & 7) * 8, q = (cix - 1) * 64 + t;
          if ((prompt || q < SS) && !dry) { const f32x4 y0 = *(const LAS f32x4*)(YT + t * YT_LD + c8), y1 = *(const LAS f32x4*)(YT + t * YT_LD + c8 + 4); const u32x4 xc = *(const LAS u32x4*)(XC + t * XT_LD + c8);
              u32x4 o; o.x = pk2((y0[0] + bflo(xc.x) * dsk) * bflo(zcur.x), (y0[1] + bfhi(xc.x) * dsk) * bfhi(zcur.x)); o.y = pk2((y0[2] + bflo(xc.y) * dsk) * bflo(zcur.y), (y0[3] + bfhi(xc.y) * dsk) * bfhi(zcur.y));
              o.z = pk2((y1[0] + bflo(xc.z) * dsk) * bflo(zcur.z), (y1[1] + bfhi(xc.z) * dsk) * bfhi(zcur.z)); o[3] = pk2((y1[2] + bflo(xc[3]) * dsk) * bflo(zcur[3]), (y1[3] + bfhi(xc[3]) * dsk) * bfhi(zcur[3]));
              *(u32x4*)((bf16*)(p.ws + WS_Z) + (size_t)(row_base + q) * Z_LD + hd * 64 + c8) = o; } }
        if (cix == nchunks) break;
        zcur = zpre;
        if (cix + 1 < nchunks) ssd_fetch(p, prompt, s, row_base, cix + 1, hd, g, tid, pre, zpre, dtraw, acsv);
        __syncthreads();
        const float acs_end = ACS[63];
        { const int t0 = 8 * w;
          unsigned t0w[4], t1w[4];
#pragma unroll
          for (int tt = 0; tt < 8; ++tt) { const unsigned bp = *(const LAS unsigned*)(RAW + (t0 + tt + 3) * RAW_LD + 64 + 2 * bpair);
              if (tt & 1) { t0w[tt >> 1] |= bp << 16; t1w[tt >> 1] |= bp & 0xffff0000u; } else { t0w[tt >> 1] = bp & 0xffffu; t1w[tt >> 1] = bp >> 16; } }
          *(LAS u32x4*)(BT + (2 * bpair) * BT_LD + t0) = (u32x4){t0w[0], t0w[1], t0w[2], t0w[3]}; *(LAS u32x4*)(BT + (2 * bpair + 1) * BT_LD + t0) = (u32x4){t1w[0], t1w[1], t1w[2], t1w[3]}; }
        { const int t0 = 4 * (tid >> 5);
          unsigned rx[7];
#pragma unroll
          for (int j = 0; j < 7; ++j) rx[j] = *(const LAS unsigned*)(RAW + (t0 + j) * RAW_LD + 2 * xpair);
          const f32x4 w0 = *(const LAS f32x4*)(WT + (2 * xpair) * 8), w1 = *(const LAS f32x4*)(WT + (2 * xpair + 1) * 8); const float bi0 = WT[(2 * xpair) * 8 + 4], bi1 = WT[(2 * xpair + 1) * 8 + 4];
          const f32x4 dta = *(const LAS f32x4*)(DT + t0), aca = *(const LAS f32x4*)(ACS + t0);
          unsigned xt0[2], xt1[2], xd0[2], xd1[2];
#pragma unroll
          for (int tt = 0; tt < 4; ++tt) { const int q = cix * 64 + t0 + tt; const bool valid = prompt ? (q >= PADR) : (q < SS);
              float x0 = bi0, x1 = bi1;
#pragma unroll
              for (int k = 0; k < 4; ++k) { x0 += bflo(rx[tt + k]) * w0[k]; x1 += bfhi(rx[tt + k]) * w1[k]; }
              x0 = valid ? silu_(x0) : 0.f; x1 = valid ? silu_(x1) : 0.f;
              *(LAS unsigned*)(XC + (t0 + tt) * XT_LD + 2 * xpair) = pk2(x0, x1);
              const float dtt = dta[tt], dec = __expf(acs_end - aca[tt]);
              const unsigned xp = pk2(x0 * dtt, x1 * dtt), xq = pk2(x0 * dtt * dec, x1 * dtt * dec);
              if (tt & 1) { xt0[tt >> 1] |= xp << 16; xt1[tt >> 1] |= xp & 0xffff0000u; xd0[tt >> 1] |= xq << 16; xd1[tt >> 1] |= xq & 0xffff0000u; }
              else { xt0[tt >> 1] = xp & 0xffffu; xt1[tt >> 1] = xp >> 16; xd0[tt >> 1] = xq & 0xffffu; xd1[tt >> 1] = xq >> 16; } }
          *(LAS u32x2*)(XT + (2 * xpair) * XT_LD + t0) = (u32x2){xt0[0], xt0[1]}; *(LAS u32x2*)(XT + (2 * xpair + 1) * XT_LD + t0) = (u32x2){xt1[0], xt1[1]};
          *(LAS u32x2*)(XD + (2 * xpair) * XT_LD + t0) = (u32x2){xd0[0], xd0[1]}; *(LAS u32x2*)(XD + (2 * xpair + 1) * XT_LD + t0) = (u32x2){xd1[0], xd1[1]}; }
        __syncthreads();
        f32x4 yacc[2];
        { f32x4 cbacc[2] = {(f32x4){0.f, 0.f, 0.f, 0.f}, (f32x4){0.f, 0.f, 0.f, 0.f}}; yacc[0] = cbacc[0]; yacc[1] = cbacc[0];
#pragma unroll
          for (int kk = 0; kk < 4; ++kk) { const bf16x8 af = *(const LAS bf16x8*)(RAW + (yit * 16 + fr + 3) * RAW_LD + 192 + kk * 32 + fq * 8);
#pragma unroll
              for (int j = 0; j < 2; ++j) { const bf16x8 bfm = *(const LAS bf16x8*)(RAW + ((ypt0 + j) * 16 + fr + 3) * RAW_LD + 64 + kk * 32 + fq * 8); cbacc[j] = mfma16(af, bfm, cbacc[j]);
                  const bf16x8 hf = *(const LAS bf16x8*)(HB + ((ypt0 + j) * 16 + fr) * CM_LD + kk * 32 + fq * 8); yacc[j] = mfma16(af, hf, yacc[j]); } }
#pragma unroll
          for (int j = 0; j < 2; ++j)
#pragma unroll
              for (int r = 0; r < 4; ++r) { const int i = yit * 16 + fq * 4 + r, jj = (ypt0 + j) * 16 + fr; const float ai = ACS[i];
                  const float gv = (jj <= i) ? cbacc[j][r] * __expf(ai - ACS[jj]) : 0.f; Gm[i * XT_LD + jj] = (bf16)(pk2(gv, 0.f) & 0xffffu);
                  yacc[j][r] *= __expf(ai); } }
        { const float cd = __expf(acs_end);
#pragma unroll
          for (int j = 0; j < 4; ++j) hacc[j] = hacc[j] * cd;
#pragma unroll
          for (int kk = 0; kk < 2; ++kk) { const bf16x8 af = *(const LAS bf16x8*)(XD + (hpt * 16 + fr) * XT_LD + kk * 32 + fq * 8);
#pragma unroll
              for (int j = 0; j < 4; ++j) { const bf16x8 bfm = *(const LAS bf16x8*)(BT + ((hnt0 + j) * 16 + fr) * BT_LD + kk * 32 + fq * 8); hacc[j] = mfma16(af, bfm, hacc[j]); } } }
        __syncthreads();
#pragma unroll
        for (int kk = 0; kk < 2; ++kk) { const bf16x8 af = *(const LAS bf16x8*)(Gm + (yit * 16 + fr) * XT_LD + kk * 32 + fq * 8);
#pragma unroll
            for (int j = 0; j < 2; ++j) { const bf16x8 bfm = *(const LAS bf16x8*)(XT + ((ypt0 + j) * 16 + fr) * XT_LD + kk * 32 + fq * 8); yacc[j] = mfma16(af, bfm, yacc[j]); } }
#pragma unroll
        for (int j = 0; j < 2; ++j)
#pragma unroll
            for (int r = 0; r < 4; ++r) YT[(yit * 16 + fq * 4 + r) * YT_LD + (ypt0 + j) * 16 + fr] = yacc[j][r];
        __syncthreads();
    }
    if (!dry) { float* so = p.out + (prompt ? O_PSSM + ((size_t)s * SSMH + hd) * 64 * 128 : O_SSSM + ((size_t)(s - NB) * SSMH + hd) * 64 * 128);
#pragma unroll
      for (int j = 0; j < 4; ++j)
#pragma unroll
          for (int r = 0; r < 4; ++r) __builtin_nontemporal_store(hacc[j][r], so + (size_t)(hpt * 16 + fq * 4 + r) * 128 + (hnt0 + j) * 16 + fr); }
}
__device__ __forceinline__ void mixer_unit(const Params& p, const Ctx& c, int u) {
    int kind, s, h, hf = 0;
    if (u < 128) { kind = 0; s = (u >> 1) / RWH; h = (u >> 1) % RWH; hf = u & 1; }
    else if (u < 256) { kind = 1; s = (u - 128) / SSMH; h = (u - 128) % SSMH; }
    else if (u < 768) { const int v = u - 256; kind = 0; s = NB + (v >> 1) / RWH; h = (v >> 1) % RWH; hf = v & 1; }
    else { const int v = u - 768; kind = 1; s = NB + v / SSMH; h = v % SSMH; }
    if (kind == 0) rwkv_scan_unit(p, c, s, h, hf); else ssd_unit(p, c, s, h);
}

__device__ __forceinline__ bool setup_gemm(const Params& p, int ph, pg8::Gemm& g, pg8::EpiGen& E) {
    unsigned char* ws = p.ws;
    E.o0 = nullptr; E.o1 = nullptr; E.o2 = nullptr; E.i0 = nullptr; E.i1 = nullptr; E.f0 = nullptr; E.f1 = nullptr; E.alpha = 0.f; E.scale = 0.f; E.mode = 0; E.PERM = false; E.nseg = 1; E.pn0 = 0; E.midt = -1; E.dry = 0;
    switch (ph) {
    case 1: case 14: g.A = (const bf16*)(ws + WS_XB); g.Bt = (const bf16*)(ws + WS_GUT); g.M = MROWS; g.N = 2 * FF; g.K = D; E.mode = pg8::EM_SWIGLU; E.PERM = true; E.o0 = ws + WS_ACT; return true;
    case 2: case 15: g.A = (const bf16*)(ws + WS_ACT); g.Bt = (const bf16*)(ws + WS_DNT); g.M = MROWS; g.N = D; g.K = FF; E.mode = pg8::EM_RESID; E.o0 = ws + WS_PRE; E.i0 = ws + WS_XB; E.alpha = ALPHA; E.scale = 0.5f; return true;
    case 4: g.A = (const bf16*)(ws + WS_XB); g.Bt = (const bf16*)(ws + WS_WINT); g.M = MROWS; g.N = 34 * 256; g.K = D; E.mode = pg8::EM_WIN; E.PERM = true; E.o0 = ws + WS_PRW; E.o1 = ws + WS_Z; E.o2 = ws + WS_XBC; E.i1 = ws + WS_GATE; E.f0 = PIN(I_BGATE); return true;
    case 8: g.A = (const bf16*)(ws + WS_XB); g.Bt = (const bf16*)(ws + WS_WINT) + (size_t)34 * 256 * D; g.M = GATE_PM_HELPED * 256; g.N = 16 * 256; g.K = D; E.mode = pg8::EM_WIN; E.PERM = true; E.pn0 = 34; E.i1 = ws + WS_GATE; E.f0 = PIN(I_BGATE); return true;
    case 6: g.A = (const bf16*)(ws + WS_ALORA); g.Bt = (const bf16*)(ws + WS_LORAT); g.M = MROWS; g.N = 3072; g.K = 512; E.mode = pg8::EM_LORA; E.o0 = ws + WS_WDEC; E.o1 = ws + WS_BB; E.o2 = (unsigned char*)p.out + OUT_GBUF; E.f0 = PIN(I_W0); E.f1 = PIN(I_A0); return true;
    case 10: g.A = (const bf16*)(ws + WS_ACAT); g.Bt = (const bf16*)(ws + WS_BCAT); g.M = MROWS; g.N = D; g.K = 3072; E.mode = pg8::EM_MF; E.PERM = true; E.midt = 16; E.o0 = (unsigned char*)p.out; E.i0 = ws + WS_GATE; return true;
    case 12: g.A = (const bf16*)p.out; g.Bt = (const bf16*)(ws + WS_WOT); g.M = MROWS; g.N = D; g.K = D; E.mode = pg8::EM_RESID; E.o0 = ws + WS_PRE; E.i0 = ws + WS_XB; E.alpha = ALPHA; E.scale = 1.0f; return true;
    default: return false;
    }
}

constexpr int WIN_COPY_SPLIT = 5888;
#ifndef PG8_SP2V
#define PG8_SP2V true
#endif
#ifndef PG8_ALIGN_EPI
#define PG8_ALIGN_EPI true
#endif
#ifndef MK_XCD_BARRIER
#define MK_XCD_BARRIER 1
#endif
#define XB_TMO      128
#define XB_XCNT(j)  (256  + 64 * (j))
#define XB_XSUB(j)  (1280 + 64 * (j))
#define XB_XGEN(j)  (2304 + 64 * (j))
#define XB_TOP      3328
#define XB_TOPGEN   3392
#define XCD_BAR_WORDS 3456
#define XB_SPIN_CAP (1u << 18)

__device__ __forceinline__ unsigned xb_ld(unsigned* p)              { return __hip_atomic_load(p, __ATOMIC_RELAXED, __HIP_MEMORY_SCOPE_AGENT); }
__device__ __forceinline__ unsigned xb_add(unsigned* p, unsigned v) { return __hip_atomic_fetch_add(p, v, __ATOMIC_RELAXED, __HIP_MEMORY_SCOPE_AGENT); }
__device__ __forceinline__ unsigned xb_xcc_id() { return (unsigned)__builtin_amdgcn_s_getreg((3 << 11) | 20) & 0xFu; }
#define XB_SPIN(cond, bar) do { unsigned _sp = 0; while (cond) { __builtin_amdgcn_s_sleep(1); \
    if ((++_sp & 255u) == 0u) { if (xb_ld(&(bar)[XB_TMO])) break; if (_sp > XB_SPIN_CAP) { atomicAdd(&(bar)[XB_TMO], 1u); break; } } } } while (0)

struct XcdBarrier {
    unsigned* bar; unsigned x;
    volatile LAS unsigned* st;
};

__device__ __forceinline__ XcdBarrier xcd_barrier_post(unsigned* bar, volatile LAS unsigned* st) {
    XcdBarrier b; b.bar = bar; b.x = xb_xcc_id(); b.st = st;
    if (threadIdx.x == 0) (void)xb_add(&bar[XB_XCNT(b.x)], 1u);
    return b;
}
__device__ __forceinline__ void xcd_barrier_complete(unsigned* bar, unsigned x, unsigned& nloc, unsigned& nx) {
    const unsigned G = gridDim.x * gridDim.y * gridDim.z;
    unsigned sum, cnt, mine, sp = 0u;
    for (;;) {
        sum = 0u; cnt = 0u; mine = 0u;
#pragma unroll
        for (unsigned j = 0; j < 16; ++j) { const unsigned c = xb_ld(&bar[XB_XCNT(j)]); sum += c; cnt += (c > 0u) ? 1u : 0u; mine = (j == x) ? c : mine; }
        if (sum == G) break;
        __builtin_amdgcn_s_sleep(1);
        if ((++sp & 255u) == 0u) { if (xb_ld(&bar[XB_TMO])) break; if (sp > XB_SPIN_CAP) { atomicAdd(&bar[XB_TMO], 1u); break; } }
    }
    nloc = mine > 0u ? mine : 1u; nx = cnt > 0u ? cnt : 1u;
}

__device__ __forceinline__ void xcd_barrier(const XcdBarrier& b) {
    asm volatile("s_waitcnt vmcnt(0)" ::: "memory");
    __syncthreads();
    if (threadIdx.x == 0) {
        unsigned* bar = b.bar;
        __builtin_amdgcn_s_waitcnt(0);
        unsigned nloc = b.st[0], nx = b.st[1];
        if (nloc == 0u) { xcd_barrier_complete(bar, b.x, nloc, nx); b.st[0] = nloc; b.st[1] = nx; }
        const unsigned old = xb_add(&bar[XB_XSUB(b.x)], 1u);
        const unsigned gen = old / nloc;
        if (old + 1u == (gen + 1u) * nloc) {
            __builtin_amdgcn_fence(__ATOMIC_RELEASE, "agent");
            asm volatile("s_waitcnt vmcnt(0)" ::: "memory");
            const unsigned og = xb_add(&bar[XB_TOP], 1u);
            const unsigned tg = og / nx;
            if (og + 1u == (tg + 1u) * nx) xb_add(&bar[XB_TOPGEN], 1u);
            else XB_SPIN(xb_ld(&bar[XB_TOPGEN]) == tg, bar);
            __builtin_amdgcn_fence(__ATOMIC_ACQUIRE, "agent");
            xb_add(&bar[XB_XGEN(b.x)], 1u);
            asm volatile("s_waitcnt vmcnt(0)" ::: "memory");
        } else {
            XB_SPIN(xb_ld(&bar[XB_XGEN(b.x)]) == gen, bar);
            __builtin_amdgcn_fence(__ATOMIC_ACQUIRE, "agent");
            asm volatile("s_waitcnt vmcnt(0)" ::: "memory");
        }
    }
    __syncthreads();
}

template <int PH> __device__ __forceinline__ void run_gemm(const Params& p, const Ctx& c) {
    pg8::Gemm g; pg8::EpiGen E; setup_gemm(p, PH, g, E);
    pg8::StaticOrder S; S.init(g.M, g.N, g.K, (int)gridDim.x, c.vc, PH == 2 || PH == 12 || PH == 15);
    if constexpr (PH == 10) { if (4 * (S.nwg % S.G) <= S.G) S.qtail = S.nwg % S.G; }
    if constexpr (PH == 10) S.split2 = 16;
    if constexpr (PH == 4) { S.ext_n = (MROWS / 256 - GATE_PM_HELPED) * 16; S.ext_pm0 = GATE_PM_HELPED; S.ext_pn0 = 34; S.ext_w = 16; }
    E.nseg = S.nseg; E.o1 = (PH == 2 || PH == 12 || PH == 15) ? (void*)(p.ws + WS_SLAB) : E.o1;
#ifdef PROBE_QPASS
    if (c.pass) { E.dry = 1;
#ifndef PROBE_DRYONLY
        S.force_q = 1;
#endif
    }
#endif
    pg8::gemm_phase<pg8::EpiGen, pg8::StaticOrder, PG8_ALIGN_EPI, PG8_SP2V>(c.lds, g, S, E);
}
__device__ __forceinline__ void ffn2_weights_slice(const Params& p, const Ctx& c, int lo, int hi, int first) {
    if (c.vc < first) return;
    __syncthreads();
    const int wid = (c.vc - first) * 8 + c.wave, nw = ((int)gridDim.x - first) * 8;
    if (lo < 5632) transpose_w(PIN(I_GU2), D, 2 * FF, (bf16*)(p.ws + WS_GUT), 2 * FF, MAP_GU, c, lo, hi < 5632 ? hi : 5632, wid, nw);
    if (hi > 5632) transpose_w(PIN(I_DN2), FF, D, (bf16*)(p.ws + WS_DNT), D, MAP_ID, c, (lo > 5632 ? lo : 5632) - 5632, hi - 5632, wid, nw);
}
constexpr int DN_ITEMS = (FF / 64) * (D / 64), DN_TAIL_ITEMS = 1280;
__device__ __forceinline__ void tail_copy(const Params& p, const Ctx& c, int nunits, const float* W, int K, int Nsrc, bf16* WT, int ndst, int lo, int hi, int ldt) {
    const int G = (int)gridDim.x, maxu = (nunits + G - 1) / G; int first = nunits - (maxu - 1) * G; if (first >= G) first = 0;
    if (c.vc < first) return;
    __syncthreads();
    transpose_w(W, K, Nsrc, WT, ndst, MAP_ID, c, lo, hi, (c.vc - first) * 8 + c.wave, (G - first) * 8, ldt);
}
__device__ __forceinline__ void dn_tail_slice(const Params& p, const Ctx& c, const float* W, int lo, int hi) { tail_copy(p, c, 34 * 44, W, FF, D, (bf16*)(p.ws + WS_DNT), D, lo, hi, 0); }
__device__ __forceinline__ void extra_copy(const Params& p, const Ctx& c, int first, const float* W, int K, int Nsrc, bf16* WT, int ndst, int ldt) {
    if (c.vc < first) return;
    transpose_w(W, K, Nsrc, WT, ndst, MAP_ID, c, 0, 1 << 30, (c.vc - first) * 8 + c.wave, ((int)gridDim.x - first) * 8, ldt);
}
__device__ __forceinline__ void phase_mixers(const Params& p, const Ctx& c) {
    const int G = (int)gridDim.x, b = (int)blockIdx.x;
    int u0, ustep, uend, Gh, ch; bool helper;
    if (G == 256) { Gh = 128; ch = b - 128; helper = b >= 128;
        if (b < 128) { u0 = b; ustep = 128; uend = 896; }
        else { u0 = b; ustep = 128; uend = 1280; } }
    else { Gh = G; ch = b; helper = true; u0 = b; ustep = G; uend = 1280; }
#ifdef PROBE_SSD
    unsigned long long ps0_ = 0, ps1_ = 0;
    for (int u = u0; u < uend; u += ustep) { if (G == 256 && (b < 128 ? (u >= 128 && u < 256) : (u >= 256 && u < 896))) continue;
        const bool tm = (b == 128) && (PROBE_SSD == 0 ? (u == u0) : (u != u0)); if (tm && ps0_ == 0) ps0_ = __builtin_amdgcn_s_memrealtime();
        mixer_unit(p, c, u);
        if (tm) ps1_ = __builtin_amdgcn_s_memrealtime(); }
    if (b == 128) { const unsigned long long te = __builtin_amdgcn_s_memrealtime(), want = (ps1_ - ps0_) * 8ull; while (__builtin_amdgcn_s_memrealtime() - te < want) __builtin_amdgcn_s_sleep(32); }
#else
    for (int u = u0; u < uend; u += ustep) { if (G == 256 && (b < 128 ? (u >= 128 && u < 256) : (u >= 256 && u < 896))) continue; mixer_unit(p, c, u); }
#endif
    if (helper) { __syncthreads();
        pg8::Gemm g; pg8::EpiGen E; setup_gemm(p, 8, g, E);
        pg8::StaticOrder S; S.init(g.M, g.N, g.K, Gh, ch); if (2 * (S.nwg % S.G) <= S.G) S.htail = S.nwg % S.G;
        pg8::gemm_phase<pg8::EpiGen, pg8::StaticOrder, PG8_ALIGN_EPI, PG8_SP2V>(c.lds, g, S, E); }
}
__global__ void __launch_bounds__(512, 2) __attribute__((target("no-packed-fp32-ops"))) mega_fwd(Params p) {
    extern __shared__ __attribute__((aligned(16))) unsigned char lds_raw[];
    const int lo = p.ph_lo, hi = p.ph_hi;
#define MKCTX Ctx c; { int t_ = threadIdx.x; asm volatile("" : "+v"(t_)); c.tid = t_; c.lane = t_ & 63; c.wave = __builtin_amdgcn_readfirstlane(t_ >> 6); c.gw = blockIdx.x * 8 + c.wave; c.ngw = gridDim.x * 8; c.lds = (LAS unsigned char*)lds_raw; c.vc = (int)blockIdx.x; }
#define IN(k) (lo <= (k) && (k) < hi)
#if MK_XCD_BARRIER
    { volatile LAS unsigned* st = (volatile LAS unsigned*)((LAS unsigned char*)lds_raw + LDS_BYTES - 64); if (threadIdx.x < 2) st[threadIdx.x] = 0u; __syncthreads(); }
    if (p.ph_lo == 0x40000000) cg::this_grid().sync();
    const XcdBarrier xbar = xcd_barrier_post((unsigned*)p.ws, (volatile LAS unsigned*)((LAS unsigned char*)lds_raw + LDS_BYTES - 64));
#define SEAM(k) do { if (lo <= (k) && (k) + 1 < hi) xcd_barrier(xbar); } while (0)
#else
#define SEAM(k) do { if (lo <= (k) && (k) + 1 < hi) cg::this_grid().sync(); } while (0)
#endif
#ifndef PROBE_DOUBLE
#define PROBE_DOUBLE 0
#endif
#ifdef PROBE_TIME_PHASE
    unsigned long long pt0_ = 0, pt1_ = 0;
#define PT_A(k) if ((k) == PROBE_TIME_PHASE) pt0_ = __builtin_amdgcn_s_memrealtime();
#define PT_B(k) if ((k) == PROBE_TIME_PHASE) pt1_ = __builtin_amdgcn_s_memrealtime();
#else
#define PT_A(k)
#define PT_B(k)
#endif
#ifdef PROBE_OWN_WORK
#define PT_END(k) PT_B(k) SEAM(k);
#else
#define PT_END(k) SEAM(k); PT_B(k)
#endif
#define PH(k, ...) do { PT_A(k) if (IN(k)) { { MKCTX c.pass = 0; __VA_ARGS__ } if (((PROBE_DOUBLE >> (k)) & 1) != 0) { if (blockIdx.x == 0 && threadIdx.x == 0) ((volatile unsigned*)p.ws)[3800] = 1u; cg::this_grid().sync(); { MKCTX c.pass = (int)((volatile unsigned*)p.ws)[3800]; __VA_ARGS__ } } } PT_END(k) } while (0)
#ifdef PROBE_P0_SEG
    { MKCTX unsigned long long q0_ = 0, q1_ = 0;
#define P0SEG(k, ...) do { if ((k) == PROBE_P0_SEG) q0_ = __builtin_amdgcn_s_memrealtime(); __VA_ARGS__ cg::this_grid().sync(); if ((k) == PROBE_P0_SEG) q1_ = __builtin_amdgcn_s_memrealtime(); } while (0)
      P0SEG(0, phase_convert_x(p, c););
      P0SEG(1, transpose_w(PIN(I_GU1), D, 2 * FF, (bf16*)(p.ws + WS_GUT), 2 * FF, MAP_GU, c););
      P0SEG(2, transpose_w(PIN(I_DN1), FF, D, (bf16*)(p.ws + WS_DNT), D, MAP_ID, c););
      P0SEG(3, transpose_w(PIN(I_RWO), RWD, D, (bf16*)(p.ws + WS_BCAT), D, MAP_ID, c, 0, 1 << 30, -1, 0, 3072); transpose_w(PIN(I_SSMO), D, D, (bf16*)(p.ws + WS_BCAT) + 1024, D, MAP_ID, c, 0, 1 << 30, -1, 0, 3072); transpose_w(PIN(I_WO), D, D, (bf16*)(p.ws + WS_WOT), D, MAP_ID, c););
      P0SEG(4, build_lorat(p, c););
      pt0_ = q0_; pt1_ = q1_; }
#else
    PH(0, phase_convert_x(p, c);
        transpose_w(PIN(I_GU1), D, 2 * FF, (bf16*)(p.ws + WS_GUT), 2 * FF, MAP_GU, c);
        transpose_w(PIN(I_DN1), FF, D, (bf16*)(p.ws + WS_DNT), D, MAP_ID, c, 0, DN_ITEMS - DN_TAIL_ITEMS);
        );
#endif
    PH(1, run_gemm<1>(p, c); dn_tail_slice(p, c, PIN(I_DN1), DN_ITEMS - DN_TAIL_ITEMS, DN_ITEMS););
    PH(2, run_gemm<2>(p, c););
    PH(3, { const int G = (int)gridDim.x, nln = G / 2;
            if (c.vc < nln) { phase_ln<false>(p, c, PIN(I_LN1G), PIN(I_LN1B), FF, c.vc * 8 + c.wave, nln * 8);
                __syncthreads(); transpose_w(PIN(I_SSMO), D, D, (bf16*)(p.ws + WS_BCAT) + 1024, D, MAP_ID, c, 512, 1 << 30, c.vc * 8 + c.wave, nln * 8, 3072);
                transpose_w(PIN(I_WIN), D, 12768, (bf16*)(p.ws + WS_WINT), NINP, MAP_WIN, c, WIN_COPY_SPLIT, 1 << 30, c.vc * 8 + c.wave, nln * 8); }
            else transpose_w(PIN(I_WIN), D, 12768, (bf16*)(p.ws + WS_WINT), NINP, MAP_WIN, c, 0, WIN_COPY_SPLIT, (c.vc - nln) * 8 + c.wave, (G - nln) * 8); });
    PH(4, run_gemm<4>(p, c);
        tail_copy(p, c, 34 * 34 + (MROWS / 256 - GATE_PM_HELPED) * 16, PIN(I_RWO), RWD, D, (bf16*)(p.ws + WS_BCAT), D, 0, 1 << 30, 3072);
        tail_copy(p, c, 34 * 34 + (MROWS / 256 - GATE_PM_HELPED) * 16, PIN(I_SSMO), D, D, (bf16*)(p.ws + WS_BCAT) + 1024, D, 0, 512, 3072););
    PH(5, { LoratHold H; lorat_issue(p, c, c.gw, H); phase_prep1(p, c); lorat_store(p, c, c.gw, H); lorat_rest(p, c); });
    PH(6, run_gemm<6>(p, c););
    PH(7, phase_prep2(p, c); phase_bcconv(p, c););
    PH(8, phase_mixers(p, c););
    PH(9, phase_post(p, c););
    PH(10, run_gemm<10>(p, c); ffn2_weights_slice(p, c, 0, 8448 - DN_TAIL_ITEMS, 64); extra_copy(p, c, 64, PIN(I_WO), D, D, (bf16*)(p.ws + WS_WOT), D, 0););

    PH(12, run_gemm<12>(p, c););
    PH(13, phase_ln<false>(p, c, PIN(I_LN2G), PIN(I_LN2B), D););
    PH(14, run_gemm<14>(p, c); dn_tail_slice(p, c, PIN(I_DN2), DN_ITEMS - DN_TAIL_ITEMS, DN_ITEMS););
    PH(15, run_gemm<15>(p, c););
    PH(16, phase_ln<true>(p, c, PIN(I_LN3G), PIN(I_LN3B), FF););
#ifdef PROBE_EXTRA_BARRIERS
    for (int i_ = 0; i_ < 16; ++i_) xcd_barrier(xbar);
#endif
#undef PH
#ifdef PROBE_TIME_PHASE
#ifndef PROBE_BLOCK
#define PROBE_BLOCK 0
#endif
    if (blockIdx.x == PROBE_BLOCK) { const unsigned long long te = __builtin_amdgcn_s_memrealtime(); const unsigned long long want = (pt1_ - pt0_) * 8ull;
        while (__builtin_amdgcn_s_memrealtime() - te < want) __builtin_amdgcn_s_sleep(32); }
#endif
#undef IN
#undef MKCTX
#undef SEAM
}

extern "C" void kernel_launch(void* const* d_in, const int* in_sizes, int n_in, void* d_out, int out_size, void* d_ws, size_t ws_size, hipStream_t stream) {
    static int grid = 0;
    if (!grid) {
        if (n_in != N_IN || (size_t)out_size != O_END || ws_size < WS_END) { fprintf(stderr, "kernel_launch: unexpected shapes (n_in %d, out %d, ws %zu)\n", n_in, out_size, ws_size); grid = -1; return; }
        int dev = 0, cus = 0, per_cu = 0;
        hipGetDevice(&dev); hipDeviceGetAttribute(&cus, hipDeviceAttributeMultiprocessorCount, dev);
        hipFuncSetAttribute((const void*)mega_fwd, hipFuncAttributeMaxDynamicSharedMemorySize, LDS_BYTES);
        hipOccupancyMaxActiveBlocksPerMultiprocessor(&per_cu, (const void*)mega_fwd, 512, LDS_BYTES);
        if (per_cu < 1) { fprintf(stderr, "kernel_launch: occupancy query says %d blocks per CU\n", per_cu); per_cu = 1; }
        grid = cus;
    }
    if (grid < 0) return;
    if (hipMemsetAsync(d_ws, 0, 16384, stream) != hipSuccess) fprintf(stderr, "kernel_launch: memset failed\n");
    Params p{};
    for (int i = 0; i < N_IN; ++i) p.in[i] = (const float*)d_in[i];
    p.out = (float*)d_out; p.ws = (unsigned char*)d_ws;
#if MK_SINGLE_LAUNCH
    p.ph_lo = 0; p.ph_hi = NPHASE;
    void* args[] = {&p};
    hipError_t e = hipLaunchCooperativeKernel((const void*)mega_fwd, dim3(grid), dim3(512), args, LDS_BYTES, stream);
    if (e != hipSuccess) fprintf(stderr, "cooperative launch failed: %s (grid %d)\n", hipGetErrorString(e), grid);
#else
    for (int ph = 0; ph < NPHASE; ++ph) { p.ph_lo = ph; p.ph_hi = ph + 1; hipLaunchKernelGGL(mega_fwd, dim3(grid), dim3(512), LDS_BYTES, stream, p); }
#endif
}
```
